# Optimizing an MI355X kernel written in HIP

```python
import math
import jax, jax.numpy as jnp
from jax import lax
import numpy as np

D_MODEL = 1024
BATCH = 4
SEQ = 4096
DEPTH = 2

Q_BLOCK = 128
EPS = 1e-6
MLA_HEADS = 8
MLA_Q_LORA = 384
MLA_KV_LORA = 256
MLA_NOPE = 128
MLA_ROPE = 64
MLA_V = 128
ROPE_BASE = 10000.0
DSA_HEADS = 8
DSA_HEAD_DIM = 128
IDX_HEADS = 8
IDX_DIM = 64
DSA_TOPK_MAX = 256
NSA_HEADS = 8
NSA_GROUPS = 2
NSA_HEAD_DIM = 128
CMP_STRIDE = 16
CMP_LEN = 2 * CMP_STRIDE
CMP_HIDDEN = 256
SEL_BLOCK = 64
SEL_COUNT = 16
WINDOW = 512
REL_BUCKETS = 32
REL_MAX_DIST = 128
REL_HEADS = DSA_HEADS + NSA_HEADS
MEM_LEN = 256
CROSS_HEADS = 4
CROSS_HEAD_DIM = D_MODEL // CROSS_HEADS
D_FF = 4 * D_MODEL
N_BRANCH = 3
BRANCH_WIDTH = D_MODEL
NORM_PRE_MIX, NORM_POST_MIX, NORM_PRE_CROSS, NORM_MEM, NORM_POST_CROSS, NORM_PRE_MLP, NORM_POST_MLP = 0, 1, 2, 3, 4, 5, 6
N_NORMS = 7
IN_WIDTHS = (
    MLA_Q_LORA, MLA_KV_LORA, MLA_ROPE,
    DSA_HEADS * DSA_HEAD_DIM, DSA_HEADS * DSA_HEAD_DIM, DSA_HEADS * DSA_HEAD_DIM,
    IDX_HEADS * IDX_DIM, IDX_DIM, IDX_HEADS,
    NSA_HEADS * NSA_HEAD_DIM,
    NSA_GROUPS * NSA_HEAD_DIM, NSA_GROUPS * NSA_HEAD_DIM,
    NSA_GROUPS * NSA_HEAD_DIM, NSA_GROUPS * NSA_HEAD_DIM,
    NSA_GROUPS * NSA_HEAD_DIM, NSA_GROUPS * NSA_HEAD_DIM,
    3 * NSA_HEADS,
    N_BRANCH * D_MODEL,
)
D_IN = sum(IN_WIDTHS)

kernel_name = 'hybrid_mla_dsa_nsa_gated_block'


def split_cols(p):
    offs = np.cumsum(IN_WIDTHS)[:-1].tolist()
    return jnp.split(p, offs, axis=-1)


def rmsnorm(x, g):
    xf = x.astype(jnp.float32)
    y = xf * lax.rsqrt(jnp.mean(xf * xf, axis=-1, keepdims=True) + EPS)
    return (y * g.astype(jnp.float32)).astype(x.dtype)


def masked_softmax(s, mask):
    s = jnp.where(mask, s.astype(jnp.float32), -jnp.inf)
    m = jnp.max(s, axis=-1, keepdims=True)
    m = jnp.where(jnp.isfinite(m), m, 0.0)
    p = jnp.exp(s - m)
    d = jnp.sum(p, axis=-1, keepdims=True)
    return p / jnp.where(d > 0, d, 1.0)


def rel_bucket(dist):
    n = jnp.maximum(dist, 0)
    exact = REL_BUCKETS // 2
    nf = jnp.maximum(n, 1).astype(jnp.float32)
    log_b = exact + (jnp.log(nf / exact) / math.log(REL_MAX_DIST / exact) * (REL_BUCKETS - exact)).astype(jnp.int32)
    return jnp.where(n < exact, n, jnp.minimum(log_b, REL_BUCKETS - 1))


def rope(x, cos, sin):
    x1, x2 = jnp.split(x.astype(jnp.float32), 2, axis=-1)
    return jnp.concatenate([x1 * cos - x2 * sin, x2 * cos + x1 * sin], axis=-1).astype(x.dtype)


def sweep_query_blocks(fn, seq):
    out = lax.map(fn, jnp.arange(seq // Q_BLOCK))
    return jax.tree_util.tree_map(
        lambda a: jnp.moveaxis(a, 0, 1).reshape((a.shape[1], seq) + a.shape[3:]), out)


def mla(q_lat, kv_lat, k_rope, positions, q_norm, kv_norm, w_uq, w_ukv):
    B, S, _ = q_lat.shape
    q = (rmsnorm(q_lat, q_norm) @ w_uq).reshape(B, S, MLA_HEADS, MLA_NOPE + MLA_ROPE)
    kv = (rmsnorm(kv_lat, kv_norm) @ w_ukv).reshape(B, S, MLA_HEADS, MLA_NOPE + MLA_V)
    q_nope, q_rope = q[..., :MLA_NOPE], q[..., MLA_NOPE:]
    k_nope, v = kv[..., :MLA_NOPE], kv[..., MLA_NOPE:]
    inv_freq = ROPE_BASE ** (-jnp.arange(0, MLA_ROPE, 2, dtype=jnp.float32) / MLA_ROPE)
    ang = positions.astype(jnp.float32)[..., None] * inv_freq
    cos, sin = jnp.cos(ang), jnp.sin(ang)
    q_rope = rope(q_rope, cos[:, :, None], sin[:, :, None])
    k_rope = rope(k_rope, cos, sin)
    scale = (MLA_NOPE + MLA_ROPE) ** -0.5
    kpos = jnp.arange(S)

    def block(i):
        t0 = i * Q_BLOCK
        qn = lax.dynamic_slice_in_dim(q_nope, t0, Q_BLOCK, axis=1)
        qr = lax.dynamic_slice_in_dim(q_rope, t0, Q_BLOCK, axis=1)
        s = jnp.einsum('bthd,bshd->bhts', qn, k_nope) + jnp.einsum('bthr,bsr->bhts', qr, k_rope)
        t = t0 + jnp.arange(Q_BLOCK)
        p = masked_softmax(s * scale, kpos[None, :] <= t[:, None]).astype(v.dtype)
        return jnp.einsum('bhts,bshd->bthd', p, v)

    return sweep_query_blocks(block, S).reshape(B, S, MLA_HEADS * MLA_V)


def dsa(q, k, v, iq, ik, iw, tab):
    B, S, _ = q.shape
    q = q.reshape(B, S, DSA_HEADS, DSA_HEAD_DIM)
    k = k.reshape(B, S, DSA_HEADS, DSA_HEAD_DIM)
    v = v.reshape(B, S, DSA_HEADS, DSA_HEAD_DIM)
    iq = iq.reshape(B, S, IDX_HEADS, IDX_DIM)
    topk = min(DSA_TOPK_MAX, S // 4)
    scale = DSA_HEAD_DIM ** -0.5
    kpos = jnp.arange(S)
    gather = jax.vmap(lambda arr, ids: arr[ids])

    def block(i):
        t0 = i * Q_BLOCK
        t = t0 + jnp.arange(Q_BLOCK)
        qb = lax.dynamic_slice_in_dim(q, t0, Q_BLOCK, axis=1)
        iqb = lax.dynamic_slice_in_dim(iq, t0, Q_BLOCK, axis=1)
        iwb = lax.dynamic_slice_in_dim(iw, t0, Q_BLOCK, axis=1)
        score = jnp.einsum('bth,bths->bts', iwb, jax.nn.relu(jnp.einsum('bthd,bsd->bths', iqb, ik)))
        score = jnp.where(kpos[None, :] <= t[:, None], score.astype(jnp.float32), -jnp.inf)
        _, idx = lax.top_k(score, topk)
        valid = idx <= t[None, :, None]
        kg = gather(k, idx)
        vg = gather(v, idx)
        bias = tab[rel_bucket(t[None, :, None] - idx)]
        s = jnp.einsum('bthd,btkhd->bhtk', qb, kg) * scale + jnp.transpose(bias, (0, 3, 1, 2))
        p = masked_softmax(s, valid[:, None]).astype(v.dtype)
        return jnp.einsum('bhtk,btkhd->bthd', p, vg)

    return sweep_query_blocks(block, S).reshape(B, S, DSA_HEADS * DSA_HEAD_DIM)


def nsa(q, kc, vc, ks, vs, kw, vw, gate, cmp_pos, cmp_w1, cmp_w2, tab):
    B, S, _ = q.shape
    G, HG, dk = NSA_GROUPS, NSA_HEADS // NSA_GROUPS, NSA_HEAD_DIM
    q = q.reshape(B, S, G, HG, dk)
    scale = dk ** -0.5
    t_all = jnp.arange(S)

    def compress(a, pos, w1, w2):
        a = a.reshape(B, S // CMP_STRIDE, CMP_STRIDE, G, dk)
        blocks = jnp.concatenate([a[:, :-1], a[:, 1:]], axis=2) + pos[None, None, :, None, :]
        nc_ = blocks.shape[1]
        flat = jnp.transpose(blocks, (0, 1, 3, 2, 4)).reshape(B, nc_, G, CMP_LEN * dk)
        return jax.nn.gelu(flat @ w1) @ w2

    k_cmp = compress(kc, cmp_pos[0], cmp_w1[0], cmp_w2[0])
    v_cmp = compress(vc, cmp_pos[1], cmp_w1[1], cmp_w2[1])
    nc = S // CMP_STRIDE - 1
    c_start = jnp.arange(nc) * CMP_STRIDE
    cmask = (c_start + CMP_LEN - 1)[None, :] <= t_all[:, None]
    p_c = masked_softmax(jnp.einsum('btghd,bcgd->bghtc', q, k_cmp) * scale, cmask)
    o_c = jnp.einsum('bghtc,bcgd->btghd', p_c.astype(v_cmp.dtype), v_cmp)

    ns = S // SEL_BLOCK
    j = jnp.arange(ns)
    j_start = j * SEL_BLOCK
    overlap = ((c_start[:, None] < j_start[None, :] + SEL_BLOCK) &
               (c_start[:, None] + CMP_LEN > j_start[None, :])).astype(jnp.float32)
    imp = jnp.einsum('bghtc,cj->bgtj', p_c, overlap)
    blk_t = t_all // SEL_BLOCK
    forced = (j[None, :] == 0) | (j[None, :] == blk_t[:, None]) | (j[None, :] == blk_t[:, None] - 1)
    imp = jnp.where(forced, jnp.inf, imp)
    imp = jnp.where(j_start[None, :] > t_all[:, None], -jnp.inf, imp)
    n_sel = min(SEL_COUNT, ns)
    _, sel_idx = lax.top_k(imp, n_sel)
    ks_blocks = jnp.transpose(ks.reshape(B, ns, SEL_BLOCK, G, dk), (0, 3, 1, 2, 4))
    vs_blocks = jnp.transpose(vs.reshape(B, ns, SEL_BLOCK, G, dk), (0, 3, 1, 2, 4))
    gather_blocks = jax.vmap(jax.vmap(lambda blk, ids: blk[ids]))

    pad = ((0, 0), (WINDOW, 0), (0, 0), (0, 0))
    kw_pad = jnp.pad(kw.reshape(B, S, G, dk), pad)
    vw_pad = jnp.pad(vw.reshape(B, S, G, dk), pad)

    tab_g = jnp.transpose(tab.reshape(REL_BUCKETS, G, HG), (1, 0, 2))
    g_idx = jnp.arange(G)[None, :, None, None]
    n_keys_sel = n_sel * SEL_BLOCK

    def block(i):
        t0 = i * Q_BLOCK
        tq = t0 + jnp.arange(Q_BLOCK)
        qb = lax.dynamic_slice_in_dim(q, t0, Q_BLOCK, axis=1)
        idx = lax.dynamic_slice_in_dim(sel_idx, t0, Q_BLOCK, axis=2)
        kg = gather_blocks(ks_blocks, idx).reshape(B, G, Q_BLOCK, n_keys_sel, dk)
        vg = gather_blocks(vs_blocks, idx).reshape(B, G, Q_BLOCK, n_keys_sel, dk)
        kpos = (idx[..., None] * SEL_BLOCK + jnp.arange(SEL_BLOCK)).reshape(B, G, Q_BLOCK, n_keys_sel)
        dist = tq[None, None, :, None] - kpos
        bias = tab_g[g_idx, rel_bucket(dist)]
        s = jnp.einsum('btghd,bgtkd->bghtk', qb, kg) * scale + jnp.transpose(bias, (0, 1, 4, 2, 3))
        p = masked_softmax(s, (dist >= 0)[:, :, None]).astype(vg.dtype)
        o_s = jnp.einsum('bghtk,bgtkd->btghd', p, vg)
        kwin = lax.dynamic_slice_in_dim(kw_pad, t0, WINDOW + Q_BLOCK, axis=1)
        vwin = lax.dynamic_slice_in_dim(vw_pad, t0, WINDOW + Q_BLOCK, axis=1)
        spos = t0 - WINDOW + jnp.arange(WINDOW + Q_BLOCK)
        wd = tq[:, None] - spos[None, :]
        wmask = (wd >= 0) & (wd < WINDOW) & (spos[None, :] >= 0)
        wbias = jnp.transpose(tab_g[:, rel_bucket(wd)], (0, 3, 1, 2))[None]
        s_w = jnp.einsum('btghd,bsgd->bghts', qb, kwin) * scale + wbias
        p_w = masked_softmax(s_w, wmask).astype(vwin.dtype)
        o_w = jnp.einsum('bghts,bsgd->btghd', p_w, vwin)
        return o_s, o_w

    o_s, o_w = sweep_query_blocks(block, S)
    gt = jax.nn.sigmoid(gate.reshape(B, S, 3, G, HG))[..., None]
    o = gt[:, :, 0] * o_c + gt[:, :, 1] * o_s + gt[:, :, 2] * o_w
    return o.reshape(B, S, NSA_HEADS * dk)


def cross_attn(h, m, wq, wkv, wo):
    B, S, _ = h.shape
    q = (h @ wq).reshape(B, S, CROSS_HEADS, CROSS_HEAD_DIM)
    kv = (m @ wkv).reshape(B, m.shape[1], 2, CROSS_HEADS, CROSS_HEAD_DIM)
    k, v = kv[:, :, 0], kv[:, :, 1]
    s = jnp.einsum('bthd,bmhd->bhtm', q, k) * CROSS_HEAD_DIM ** -0.5
    p = jax.nn.softmax(s.astype(jnp.float32), axis=-1).astype(v.dtype)
    return jnp.einsum('bhtm,bmhd->bthd', p, v).reshape(B, S, D_MODEL) @ wo


def setup_inputs(seed: int = 0) -> dict:
    key = jax.random.key(seed)
    ks = jax.random.split(key, 20)
    f32 = jnp.float32

    def nrm(k, shape):
        return jax.random.normal(k, shape, f32)

    def w(k, shape, fan_in):
        return nrm(k, shape) * fan_in ** -0.5

    dk = NSA_HEAD_DIM
    return {
        'x': nrm(ks[0], (BATCH, SEQ, D_MODEL)),
        'mem': nrm(ks[1], (BATCH, MEM_LEN, D_MODEL)),
        'positions': jnp.tile(jnp.arange(SEQ, dtype=jnp.int32)[None, :], (BATCH, 1)),
        'rel_bias': 0.5 * nrm(ks[2], (REL_BUCKETS, REL_HEADS)),
        'norm_gains': 1.0 + 0.05 * nrm(ks[3], (DEPTH, N_NORMS, D_MODEL)),
        'w_in': w(ks[4], (DEPTH, D_MODEL, D_IN), D_MODEL),
        'mla_q_norm': 1.0 + 0.05 * nrm(ks[5], (DEPTH, MLA_Q_LORA)),
        'mla_kv_norm': 1.0 + 0.05 * nrm(ks[6], (DEPTH, MLA_KV_LORA)),
        'mla_w_uq': w(ks[7], (DEPTH, MLA_Q_LORA, MLA_HEADS * (MLA_NOPE + MLA_ROPE)), MLA_Q_LORA),
        'mla_w_ukv': w(ks[8], (DEPTH, MLA_KV_LORA, MLA_HEADS * (MLA_NOPE + MLA_V)), MLA_KV_LORA),
        'nsa_cmp_pos': 0.5 * nrm(ks[9], (DEPTH, 2, CMP_LEN, dk)),
        'nsa_cmp_w1': w(ks[10], (DEPTH, 2, CMP_LEN * dk, CMP_HIDDEN), CMP_LEN * dk),
        'nsa_cmp_w2': w(ks[11], (DEPTH, 2, CMP_HIDDEN, dk), CMP_HIDDEN),
        'w_branch': w(ks[12], (DEPTH, N_BRANCH, BRANCH_WIDTH, D_MODEL), BRANCH_WIDTH),
        'w_out': w(ks[13], (DEPTH, D_MODEL, D_MODEL), D_MODEL),
        'cross_wq': w(ks[14], (DEPTH, D_MODEL, D_MODEL), D_MODEL),
        'cross_wkv': w(ks[15], (DEPTH, D_MODEL, 2 * D_MODEL), D_MODEL),
        'cross_wo': w(ks[16], (DEPTH, D_MODEL, D_MODEL), D_MODEL),
        'mlp_w1': w(ks[17], (DEPTH, D_MODEL, D_FF), D_MODEL),
        'mlp_w2': w(ks[18], (DEPTH, D_FF, D_MODEL), D_FF),
    }


def reference(x, mem, positions, rel_bias, norm_gains, w_in, mla_q_norm, mla_kv_norm,
              mla_w_uq, mla_w_ukv, nsa_cmp_pos, nsa_cmp_w1, nsa_cmp_w2, w_branch, w_out,
              cross_wq, cross_wkv, cross_wo, mlp_w1, mlp_w2):
    B, S, _ = x.shape
    tab_dsa = rel_bias[:, :DSA_HEADS]
    tab_nsa = rel_bias[:, DSA_HEADS:]
    for l in range(DEPTH):
        g = norm_gains[l]
        h = rmsnorm(x, g[NORM_PRE_MIX])
        (mla_q_lat, mla_kv_lat, mla_k_rope, dsa_q, dsa_k, dsa_v, idx_q, idx_k, idx_w,
         nsa_q, nsa_kc, nsa_vc, nsa_ks, nsa_vs, nsa_kw, nsa_vw, nsa_gate, branch_gate) = split_cols(h @ w_in[l])
        o_a = mla(mla_q_lat, mla_kv_lat, mla_k_rope, positions, mla_q_norm[l], mla_kv_norm[l],
                  mla_w_uq[l], mla_w_ukv[l])
        o_b = dsa(dsa_q, dsa_k, dsa_v, idx_q, idx_k, idx_w, tab_dsa)
        o_c = nsa(nsa_q, nsa_kc, nsa_vc, nsa_ks, nsa_vs, nsa_kw, nsa_vw, nsa_gate,
                  nsa_cmp_pos[l], nsa_cmp_w1[l], nsa_cmp_w2[l], tab_nsa)
        gates = jax.nn.sigmoid(branch_gate.reshape(B, S, N_BRANCH, D_MODEL))
        merged = (gates[:, :, 0] * (o_a @ w_branch[l, 0]) +
                  gates[:, :, 1] * (o_b @ w_branch[l, 1]) +
                  gates[:, :, 2] * (o_c @ w_branch[l, 2]))
        x = x + rmsnorm(merged @ w_out[l], g[NORM_POST_MIX])
        h = rmsnorm(x, g[NORM_PRE_CROSS])
        m = rmsnorm(mem, g[NORM_MEM])
        x = x + rmsnorm(cross_attn(h, m, cross_wq[l], cross_wkv[l], cross_wo[l]), g[NORM_POST_CROSS])
        h = rmsnorm(x, g[NORM_PRE_MLP])
        x = x + rmsnorm(jnp.square(jax.nn.relu(h @ mlp_w1[l])) @ mlp_w2[l], g[NORM_POST_MLP])
    return x
```

```cpp
#include <hip/hip_runtime.h>
#include <cstdio>
#include <cstdint>
#include <cstring>

#ifndef MK_MULTI_LAUNCH
#define MK_MULTI_LAUNCH 1
#endif

typedef unsigned short u16;
typedef unsigned int u32;
typedef unsigned long long u64;
#define DI __device__ __forceinline__
#define LAS __attribute__((address_space(3)))

constexpr int T = 16384, SEQ = 4096, NB = 4, DM = 1024, DEPTH = 2, D_IN = 10016;
constexpr int PP = 7168;
constexpr int C_QLAT = 0, C_KVLAT = 384, C_KROPE = 640, C_IDXK = 704, C_IDXQ = 768, C_DSAQ = 1280, C_DSAK = 2304, C_DSAV = 3328,
              C_NSAQ = 4352, C_NKC = 5376, C_NVC = 5632, C_NKS = 5888, C_NVS = 6144, C_NKW = 6400, C_NVW = 6656, C_IDXW = 6912,
              C_NGATE = 6920, C_END = 6944;
constexpr float EPS = 1e-6f;

constexpr size_t MiB = 1u << 20;
constexpr size_t WS_CTL = 0, CTL_BYTES = 1 * MiB;
constexpr size_t WS_WB = 1 * MiB;
constexpr size_t WS_HB = 38 * MiB;
constexpr size_t WS_MEMN = 70 * MiB;
constexpr size_t WS_CKV = 72 * MiB;
constexpr size_t WS_A = 76 * MiB;
constexpr size_t WS_MERGED = WS_A;
constexpr size_t WS_PROJ = WS_A + 32 * MiB;
constexpr size_t WS_GATES = WS_A + 88 * MiB;
constexpr size_t WS_QNRM = WS_A + 112 * MiB;
constexpr size_t WS_KVNRM = WS_A + 115 * MiB;
constexpr size_t WS_MQN = WS_A + 117 * MiB;
constexpr size_t WS_MQR = WS_A + 125 * MiB;
constexpr size_t WS_MKN = WS_A + 129 * MiB;
constexpr size_t WS_MV = WS_A + 137 * MiB;
constexpr size_t WS_MKR = WS_A + 145 * MiB;
constexpr size_t WS_CBK = WS_A + 146 * MiB;
constexpr size_t WS_CBV = WS_A + 150 * MiB;
constexpr size_t WS_CH = WS_A + 154 * MiB;
constexpr size_t WS_KCMP = WS_A + 155 * MiB;
constexpr size_t WS_VCMP = WS_A + 155 * MiB + 512 * 1024;
constexpr size_t WS_BITM = WS_A + 156 * MiB;
constexpr size_t WS_F32 = WS_A + 32 * MiB;
constexpr size_t WS_CQ = WS_A + 96 * MiB;
constexpr size_t WS_U = WS_A + 96 * MiB;
constexpr size_t WS_END = WS_A + 224 * MiB;

constexpr int LDS_BYTES = 152 * 1024;
constexpr int LDS_MISC = 147456;
constexpr int WSLOT = 18432;

DI float bf2f(u32 h) { return __uint_as_float(h << 16); }
DI u32 f2bf(float f) { u32 u = __float_as_uint(f); return (u + 0x7fffu + ((u >> 16) & 1u)) >> 16; }
DI float wave_sum(float v) { for (int o = 32; o; o >>= 1) v += __shfl_xor(v, o); return v; }
DI float wave_max(float v) { for (int o = 32; o; o >>= 1) v = fmaxf(v, __shfl_xor(v, o)); return v; }
DI float sigmoidf_(float x) { return 1.f / (1.f + __expf(-x)); }
DI float gelu_tanh(float x) { return 0.5f * x * (1.f + tanhf(0.7978845608028654f * (x + 0.044715f * x * x * x))); }

__device__ const unsigned char BUCKET_TAB[128] = {
    0, 1, 2, 3, 4, 5, 6, 7, 8, 9, 10, 11, 12, 13, 14, 15, 16, 16, 16, 17, 17, 18, 18, 18, 19, 19, 19, 20, 20, 20, 20, 21, 21, 21, 21, 22, 22, 22, 22, 22,
    23, 23, 23, 23, 23, 23, 24, 24, 24, 24, 24, 24, 25, 25, 25, 25, 25, 25, 25, 26, 26, 26, 26, 26, 26, 26, 26, 27, 27, 27, 27, 27, 27, 27, 27, 27, 27,
    28, 28, 28, 28, 28, 28, 28, 28, 28, 28, 29, 29, 29, 29, 29, 29, 29, 29, 29, 29, 29, 29, 30, 30, 30, 30, 30, 30, 30, 30, 30, 30, 30, 30, 30, 30,
    31, 31, 31, 31, 31, 31, 31, 31, 31, 31, 31, 31, 31, 31, 31};
DI int relbucket(int n) { return n >= 127 ? 31 : (int)BUCKET_TAB[n < 0 ? 0 : n]; }

DI int proj_src(int n) {
    if (n < 704) return n;
    if (n < 768) return 4288 + (n - 704);
    if (n < 1280) return 3776 + (n - 768);
    if (n < 4352) return 704 + (n - 1280);
    if (n < 5376) return 4360 + (n - 4352);
    if (n < 6912) return 5384 + (n - 5376);
    if (n < 6920) return 4352 + (n - 6912);
    if (n < 6944) return 6920 + (n - 6920);
    return -1;
}

#define XB_TMO      128
#define XB_XCNT(j)  (256  + 64 * (j))
#define XB_XSUB(j)  (1280 + 64 * (j))
#define XB_XGEN(j)  (2304 + 64 * (j))
#define XB_TOP      3328
#define XB_TOPGEN   3392
#define XCD_BAR_WORDS 3456
#define XB_SPIN_CAP (1u << 21)
DI unsigned xb_ld(unsigned* p)              { return __hip_atomic_load(p, __ATOMIC_RELAXED, __HIP_MEMORY_SCOPE_AGENT); }
DI unsigned xb_add(unsigned* p, unsigned v) { return __hip_atomic_fetch_add(p, v, __ATOMIC_RELAXED, __HIP_MEMORY_SCOPE_AGENT); }
DI unsigned xb_xcc_id() { return (unsigned)__builtin_amdgcn_s_getreg((3 << 11) | 20) & 0xFu; }
#define XB_SPIN(cond, bar) do { unsigned _sp = 0; while (cond) { __builtin_amdgcn_s_sleep(1); \
    if ((++_sp & 255u) == 0u) { if (xb_ld(&(bar)[XB_TMO])) break; if (_sp > XB_SPIN_CAP) { atomicAdd(&(bar)[XB_TMO], 1u); break; } } } } while (0)
struct XcdBarrier { unsigned* bar; unsigned x; volatile LAS unsigned* st; };
DI XcdBarrier xcd_barrier_post(unsigned* bar, volatile LAS unsigned* st) {
    XcdBarrier b; b.bar = bar; b.x = xb_xcc_id(); b.st = st;
    if (threadIdx.x == 0) (void)xb_add(&bar[XB_XCNT(b.x)], 1u);
    return b;
}
DI void xcd_barrier_complete(unsigned* bar, unsigned x, unsigned& nloc, unsigned& nx) {
    const unsigned G = gridDim.x * gridDim.y * gridDim.z;
    unsigned sum, cnt, mine, sp = 0u;
    for (;;) {
        sum = 0u; cnt = 0u; mine = 0u;
#pragma unroll
        for (unsigned j = 0; j < 16; ++j) { const unsigned c = xb_ld(&bar[XB_XCNT(j)]); sum += c; cnt += (c > 0u) ? 1u : 0u; mine = (j == x) ? c : mine; }
        if (sum == G) break;
        __builtin_amdgcn_s_sleep(1);
        if ((++sp & 255u) == 0u) { if (xb_ld(&bar[XB_TMO])) break; if (sp > XB_SPIN_CAP) { atomicAdd(&bar[XB_TMO], 1u); break; } }
    }
    nloc = mine > 0u ? mine : 1u; nx = cnt > 0u ? cnt : 1u;
}
DI void xcd_barrier(const XcdBarrier& b) {
    asm volatile("s_waitcnt vmcnt(0)" ::: "memory");
    __syncthreads();
    if (threadIdx.x == 0) {
        unsigned* bar = b.bar;
        __builtin_amdgcn_s_waitcnt(0);
        unsigned nloc = b.st[0], nx = b.st[1];
        if (nloc == 0u) { xcd_barrier_complete(bar, b.x, nloc, nx); b.st[0] = nloc; b.st[1] = nx; }
        const unsigned old = xb_add(&bar[XB_XSUB(b.x)], 1u);
        const unsigned gen = old / nloc;
        if (old + 1u == (gen + 1u) * nloc) {
            __builtin_amdgcn_fence(__ATOMIC_RELEASE, "agent");
            asm volatile("s_waitcnt vmcnt(0)" ::: "memory");
            const unsigned og = xb_add(&bar[XB_TOP], 1u);
            const unsigned tg = og / nx;
            if (og + 1u == (tg + 1u) * nx) xb_add(&bar[XB_TOPGEN], 1u);
            else XB_SPIN(xb_ld(&bar[XB_TOPGEN]) == tg, bar);
            __builtin_amdgcn_fence(__ATOMIC_ACQUIRE, "agent");
            xb_add(&bar[XB_XGEN(b.x)], 1u);
            asm volatile("s_waitcnt vmcnt(0)" ::: "memory");
        } else {
            XB_SPIN(xb_ld(&bar[XB_XGEN(b.x)]) == gen, bar);
            __builtin_amdgcn_fence(__ATOMIC_ACQUIRE, "agent");
            asm volatile("s_waitcnt vmcnt(0)" ::: "memory");
        }
    }
    __syncthreads();
}

struct Params {
    const float* x; const float* mem; const int* pos; const float* rel_bias; const float* gains; const float* w_in;
    const float* qnorm; const float* kvnorm; const float* w_uq; const float* w_ukv; const float* cmp_pos; const float* cmp_w1;
    const float* cmp_w2; const float* w_branch; const float* w_out; const float* cwq; const float* cwkv; const float* cwo;
    const float* w1; const float* w2;
    float* out; unsigned char* ws;
    int ph_lo, ph_hi;
};

DI int opaque_tid() { int t = threadIdx.x; asm volatile("" : "+v"(t)); return t; }
template <class BF, class EF>
DI void ngemm(unsigned char* lds, const u16* A, int lda, int M, int N, int K, BF bfn, EF efn) {
    float* As = (float*)lds;
    float* Bs = As + 16 * 132;
    const int tid = opaque_tid(), tx = tid & 31, ty = tid >> 5;
    const int ntn = N / 128, ntiles = (M / 128) * ntn;
    for (int tile = blockIdx.x; tile < ntiles; tile += gridDim.x) {
        const int m0 = (tile / ntn) * 128, n0 = (tile % ntn) * 128;
        float acc[8][4];
#pragma unroll
        for (int i = 0; i < 8; ++i)
#pragma unroll
            for (int j = 0; j < 4; ++j) acc[i][j] = 0.f;
        for (int k0 = 0; k0 < K; k0 += 16) {
            {
                const int i = tid >> 2, kq = (tid & 3) * 4;
                const uint2 v = *(const uint2*)(A + (size_t)(m0 + i) * lda + k0 + kq);
                As[(kq + 0) * 132 + i] = bf2f(v.x & 0xffffu); As[(kq + 1) * 132 + i] = bf2f(v.x >> 16);
                As[(kq + 2) * 132 + i] = bf2f(v.y & 0xffffu); As[(kq + 3) * 132 + i] = bf2f(v.y >> 16);
                const int kk = tid >> 5, nq = (tid & 31) * 4;
#pragma unroll
                for (int j = 0; j < 4; ++j) Bs[kk * 132 + nq + j] = bfn(k0 + kk, n0 + nq + j);
            }
            __syncthreads();
#pragma unroll 2
            for (int kk = 0; kk < 16; ++kk) {
                float a[8], b[4];
#pragma unroll
                for (int i = 0; i < 8; ++i) a[i] = As[kk * 132 + ty * 8 + i];
#pragma unroll
                for (int j = 0; j < 4; ++j) b[j] = Bs[kk * 132 + tx * 4 + j];
#pragma unroll
                for (int i = 0; i < 8; ++i)
#pragma unroll
                    for (int j = 0; j < 4; ++j) acc[i][j] = fmaf(a[i], b[j], acc[i][j]);
            }
            __syncthreads();
        }
#pragma unroll
        for (int i = 0; i < 8; ++i)
#pragma unroll
            for (int j = 0; j < 4; ++j) efn(m0 + ty * 8 + i, n0 + tx * 4 + j, acc[i][j]);
    }
}

DI void ph_norm_rows(const float* src, const float* g, u16* dst, int rows) {
    const int tid = opaque_tid(), lane = tid & 63, wv = tid >> 6;
    for (int r = blockIdx.x * 8 + wv; r < rows; r += gridDim.x * 8) {
        const float* s = src + (size_t)r * 1024;
        float v[16]; float ss = 0.f;
#pragma unroll
        for (int i = 0; i < 16; ++i) { v[i] = s[lane + 64 * i]; ss += v[i] * v[i]; }
        ss = wave_sum(ss);
        const float rs = rsqrtf(ss * (1.f / 1024.f) + EPS);
#pragma unroll
        for (int i = 0; i < 16; ++i) dst[(size_t)r * 1024 + lane + 64 * i] = (u16)f2bf(v[i] * rs * g[lane + 64 * i]);
    }
}
DI void ph_resid_norm(const float* f, const float* gpost, const float* xin, float* xout, const float* gnext, u16* hb, int rows) {
    const int tid = opaque_tid(), lane = tid & 63, wv = tid >> 6;
    for (int r = blockIdx.x * 8 + wv; r < rows; r += gridDim.x * 8) {
        const float* s = f + (size_t)r * 1024;
        float v[16]; float ss = 0.f;
#pragma unroll
        for (int i = 0; i < 16; ++i) { v[i] = s[lane + 64 * i]; ss += v[i] * v[i]; }
        ss = wave_sum(ss);
        const float rs = rsqrtf(ss * (1.f / 1024.f) + EPS);
        float s2 = 0.f;
#pragma unroll
        for (int i = 0; i < 16; ++i) { v[i] = xin[(size_t)r * 1024 + lane + 64 * i] + v[i] * rs * gpost[lane + 64 * i]; s2 += v[i] * v[i]; }
#pragma unroll
        for (int i = 0; i < 16; ++i) xout[(size_t)r * 1024 + lane + 64 * i] = v[i];
        if (gnext) {
            s2 = wave_sum(s2);
            const float r2 = rsqrtf(s2 * (1.f / 1024.f) + EPS);
#pragma unroll
            for (int i = 0; i < 16; ++i) hb[(size_t)r * 1024 + lane + 64 * i] = (u16)f2bf(v[i] * r2 * gnext[lane + 64 * i]);
        }
    }
}

template <int NV, class SF, class VF>
DI float wave_attn(float* sc, int n, SF scoref, VF vrowf, float (&out)[NV], int lane) {
#pragma unroll
    for (int j = 0; j < NV; ++j) out[j] = 0.f;
    float m = -INFINITY;
#pragma unroll 1
    for (int i = lane; i < n; i += 64) { asm volatile("" ::: "memory"); const float s = scoref(i); sc[i] = s; m = fmaxf(m, s); }
    m = wave_max(m);
    if (!(m > -INFINITY)) return 0.f;
    float sum = 0.f;
    for (int i = lane; i < n; i += 64) { const float p = __expf(sc[i] - m); sc[i] = p; sum += p; }
    sum = wave_sum(sum);
    float acc[NV];
#pragma unroll
    for (int j = 0; j < NV; ++j) acc[j] = 0.f;
#pragma unroll 4
    for (int i = 0; i < n; ++i) {
        const float p = sc[i];
        if (p != 0.f) {
            const u16* v = vrowf(i);
            if constexpr (NV == 2) { const u32 w = *(const u32*)(v + lane * 2); acc[0] = fmaf(p, bf2f(w & 0xffffu), acc[0]); acc[1] = fmaf(p, bf2f(w >> 16), acc[1]); }
            else { const uint2 w = *(const uint2*)(v + lane * 4); acc[0] = fmaf(p, bf2f(w.x & 0xffffu), acc[0]); acc[1] = fmaf(p, bf2f(w.x >> 16), acc[1]);
                   acc[2 % NV] = fmaf(p, bf2f(w.y & 0xffffu), acc[2 % NV]); acc[3 % NV] = fmaf(p, bf2f(w.y >> 16), acc[3 % NV]); }
        }
    }
    const float inv = 1.f / sum;
#pragma unroll
    for (int j = 0; j < NV; ++j) out[j] = acc[j] * inv;
    return sum;
}
DI float dot_q(const float* q, const u16* k, int n) {
    float a = 0.f;
#pragma unroll 4
    for (int d = 0; d < n; d += 8) {
        const uint4 w = *(const uint4*)(k + d);
        a = fmaf(q[d + 0], bf2f(w.x & 0xffffu), a); a = fmaf(q[d + 1], bf2f(w.x >> 16), a);
        a = fmaf(q[d + 2], bf2f(w.y & 0xffffu), a); a = fmaf(q[d + 3], bf2f(w.y >> 16), a);
        a = fmaf(q[d + 4], bf2f(w.z & 0xffffu), a); a = fmaf(q[d + 5], bf2f(w.z >> 16), a);
        a = fmaf(q[d + 6], bf2f(w.w & 0xffffu), a); a = fmaf(q[d + 7], bf2f(w.w >> 16), a);
    }
    return a;
}

__global__ void __launch_bounds__(512, 2) mega(Params p) {
    extern __shared__ __attribute__((aligned(16))) unsigned char lds[];
    volatile LAS unsigned* xbw = (volatile LAS unsigned*)(lds + LDS_MISC);
    if (threadIdx.x == 0) { xbw[0] = 0u; xbw[1] = 0u; xbw[2] = 0u; xbw[3] = 0u; }
    __syncthreads();
    unsigned* ctl = (unsigned*)(p.ws + WS_CTL);
    XcdBarrier bar = xcd_barrier_post(ctl + 4096, xbw);

    unsigned char* ws = p.ws;
    u16* HB = (u16*)(ws + WS_HB); u16* MEMN = (u16*)(ws + WS_MEMN); u16* CKV = (u16*)(ws + WS_CKV);
    u16* MERGED = (u16*)(ws + WS_MERGED); u16* PROJ = (u16*)(ws + WS_PROJ); u16* GATES = (u16*)(ws + WS_GATES);
    u16* QNRM = (u16*)(ws + WS_QNRM); u16* KVNRM = (u16*)(ws + WS_KVNRM);
    u16* MQN = (u16*)(ws + WS_MQN); u16* MQR = (u16*)(ws + WS_MQR); u16* MKN = (u16*)(ws + WS_MKN); u16* MV = (u16*)(ws + WS_MV); u16* MKR = (u16*)(ws + WS_MKR);
    u16* CBK = (u16*)(ws + WS_CBK); u16* CBV = (u16*)(ws + WS_CBV); u16* CH = (u16*)(ws + WS_CH);
    u16* KCMP = (u16*)(ws + WS_KCMP); u16* VCMP = (u16*)(ws + WS_VCMP); u32* BITM = (u32*)(ws + WS_BITM);
    float* F32 = (float*)(ws + WS_F32); u16* CQ = (u16*)(ws + WS_CQ); u16* U = (u16*)(ws + WS_U);

    int ph = 0;
#define PH_BEGIN if (ph >= p.ph_lo && ph < p.ph_hi) { const int tid = opaque_tid(), lane = tid & 63, wv = tid >> 6; float* wsl = (float*)(lds + wv * WSLOT); (void)lane; (void)wsl;
#define PH_END   if (ph + 1 < p.ph_hi) xcd_barrier(bar); } ++ph;

    for (int l = 0; l < DEPTH; ++l) {
        const float* g = p.gains + (size_t)l * 7 * 1024;
        const float* xin = (l == 0) ? p.x : p.out;
        const float* Win = p.w_in + (size_t)l * 1024 * D_IN;
        PH_BEGIN
            ph_norm_rows(xin, g, HB, T);
            ph_norm_rows(p.mem, g + 3 * 1024, MEMN, 1024);
        PH_END
        for (int b = 0; b < NB; ++b) {
            const u16* hb = HB + (size_t)b * SEQ * 1024;
            PH_BEGIN
                ngemm(lds, hb, 1024, SEQ, PP, 1024,
                      [&](int k, int n) { const int s = proj_src(n); return s >= 0 ? Win[(size_t)k * D_IN + s] : 0.f; },
                      [&](int m, int n, float v) { PROJ[(size_t)m * PP + n] = (u16)f2bf(v); });
                ngemm(lds, hb, 1024, SEQ, 3072, 1024,
                      [&](int k, int n) { return Win[(size_t)k * D_IN + 6944 + n]; },
                      [&](int m, int n, float v) { GATES[(size_t)m * 3072 + n] = (u16)f2bf(sigmoidf_(v)); });
                if (b == 0) {
                    const float* Wkv = p.cwkv + (size_t)l * 1024 * 2048;
                    ngemm(lds, MEMN, 1024, 1024, 2048, 1024,
                          [&](int k, int n) { return Wkv[(size_t)k * 2048 + n]; },
                          [&](int m, int n, float v) { CKV[(size_t)m * 2048 + n] = (u16)f2bf(v); });
                }
            PH_END
            PH_BEGIN
                {
                    const float* qg = p.qnorm + l * 384; const float* kg = p.kvnorm + l * 256;
                    for (int r = blockIdx.x * 8 + wv; r < SEQ; r += gridDim.x * 8) {
                        const u16* pr = PROJ + (size_t)r * PP;
                        float v[6]; float ss = 0.f;
#pragma unroll
                        for (int i = 0; i < 6; ++i) { v[i] = bf2f(pr[C_QLAT + lane + 64 * i]); ss += v[i] * v[i]; }
                        ss = wave_sum(ss); float rs = rsqrtf(ss * (1.f / 384.f) + EPS);
#pragma unroll
                        for (int i = 0; i < 6; ++i) QNRM[(size_t)r * 384 + lane + 64 * i] = (u16)f2bf(v[i] * rs * qg[lane + 64 * i]);
                        ss = 0.f;
#pragma unroll
                        for (int i = 0; i < 4; ++i) { v[i] = bf2f(pr[C_KVLAT + lane + 64 * i]); ss += v[i] * v[i]; }
                        ss = wave_sum(ss); rs = rsqrtf(ss * (1.f / 256.f) + EPS);
#pragma unroll
                        for (int i = 0; i < 4; ++i) KVNRM[(size_t)r * 256 + lane + 64 * i] = (u16)f2bf(v[i] * rs * kg[lane + 64 * i]);
                        if (lane < 32) {
                            const float posf = (float)p.pos[b * SEQ + r];
                            const float invf = powf(10000.f, -(float)lane * (1.f / 32.f));
                            float sn, cs; sincosf(posf * invf, &sn, &cs);
                            const float x1 = bf2f(pr[C_KROPE + lane]), x2 = bf2f(pr[C_KROPE + 32 + lane]);
                            MKR[(size_t)r * 64 + lane] = (u16)f2bf(x1 * cs - x2 * sn);
                            MKR[(size_t)r * 64 + 32 + lane] = (u16)f2bf(x2 * cs + x1 * sn);
                        }
                    }
                    const float* cpos = p.cmp_pos + (size_t)l * 2 * 32 * 128;
                    for (size_t e = (size_t)blockIdx.x * 512 + tid; e < (size_t)512 * 4096; e += (size_t)gridDim.x * 512) {
                        const int row = (int)(e >> 12), col = (int)(e & 4095), c = row >> 1, gg = row & 1, ll = col >> 7, d = col & 127;
                        float vk = 0.f, vv = 0.f;
                        if (row < 510) {
                            const u16* pr = PROJ + (size_t)(16 * c + ll) * PP + gg * 128 + d;
                            vk = bf2f(pr[C_NKC]) + cpos[ll * 128 + d];
                            vv = bf2f(pr[C_NVC]) + cpos[32 * 128 + ll * 128 + d];
                        }
                        CBK[e] = (u16)f2bf(vk); CBV[e] = (u16)f2bf(vv);
                    }
                }
            PH_END
            PH_BEGIN
                {
                    const float* Wuq = p.w_uq + (size_t)l * 384 * 1536; const float* Wukv = p.w_ukv + (size_t)l * 256 * 2048;
                    ngemm(lds, QNRM, 384, SEQ, 1536, 384,
                          [&](int k, int n) { const int s = n < 1024 ? (n >> 7) * 192 + (n & 127) : ((n - 1024) >> 6) * 192 + 128 + ((n - 1024) & 63); return Wuq[(size_t)k * 1536 + s]; },
                          [&](int m, int n, float v) { if (n < 1024) MQN[(size_t)m * 1024 + n] = (u16)f2bf(v); else MQR[(size_t)m * 512 + (n - 1024)] = (u16)f2bf(v); });
                    ngemm(lds, KVNRM, 256, SEQ, 2048, 256,
                          [&](int k, int n) { return Wukv[(size_t)k * 2048 + n]; },
                          [&](int m, int n, float v) { const int hh = n >> 8, d = n & 127; if (n & 128) MV[(size_t)m * 1024 + hh * 128 + d] = (u16)f2bf(v); else MKN[(size_t)m * 1024 + hh * 128 + d] = (u16)f2bf(v); });
                    for (int kv = 0; kv < 2; ++kv) {
                        const float* W1 = p.cmp_w1 + ((size_t)l * 2 + kv) * 4096 * 256;
                        ngemm(lds, kv ? CBV : CBK, 4096, 512, 256, 4096,
                              [&](int k, int n) { return W1[(size_t)k * 256 + n]; },
                              [&](int m, int n, float v) { CH[(size_t)kv * 512 * 256 + (size_t)m * 256 + n] = (u16)f2bf(gelu_tanh(v)); });
                    }
                }
            PH_END
            PH_BEGIN
                {
                    for (int kv = 0; kv < 2; ++kv) {
                        const float* W2 = p.cmp_w2 + ((size_t)l * 2 + kv) * 256 * 128;
                        u16* dst = kv ? VCMP : KCMP;
                        ngemm(lds, CH + (size_t)kv * 512 * 256, 256, 512, 128, 256,
                              [&](int k, int n) { return W2[(size_t)k * 128 + n]; },
                              [&](int m, int n, float v) { dst[(size_t)m * 128 + n] = (u16)f2bf(m < 510 ? v : 0.f); });
                    }
                    __syncthreads();
                    for (int r = blockIdx.x * 8 + wv; r < SEQ; r += gridDim.x * 8) {
                        const float posf = (float)p.pos[b * SEQ + r];
#pragma unroll
                        for (int i = 0; i < 4; ++i) {
                            const int e = lane + 64 * i, hh = e >> 5, fi = e & 31;
                            const float invf = powf(10000.f, -(float)fi * (1.f / 32.f));
                            float sn, cs; sincosf(posf * invf, &sn, &cs);
                            u16* q = MQR + (size_t)r * 512 + hh * 64;
                            const float x1 = bf2f(q[fi]), x2 = bf2f(q[32 + fi]);
                            q[fi] = (u16)f2bf(x1 * cs - x2 * sn); q[32 + fi] = (u16)f2bf(x2 * cs + x1 * sn);
                        }
                    }
                    u32* uk = (u32*)wsl;
                    float* iq = wsl + 4096;
                    for (int r = blockIdx.x * 8 + wv; r < SEQ; r += gridDim.x * 8) {
                        const u16* pr = PROJ + (size_t)r * PP;
                        for (int i = lane; i < 512; i += 64) iq[i] = bf2f(pr[C_IDXQ + i]);
                        float iw[8];
#pragma unroll
                        for (int hh = 0; hh < 8; ++hh) iw[hh] = bf2f(pr[C_IDXW + hh]);
                        const int n = r + 1;
                        u32* mrow = BITM + (size_t)r * 128;
                        if (n <= 256) {
                            for (int w = lane; w < 128; w += 64) { const int lo = 32 * w; mrow[w] = (lo + 32 <= n) ? 0xffffffffu : (lo >= n ? 0u : ((1u << (n - lo)) - 1u)); }
                        } else {
#pragma unroll 1
                            for (int i = lane; i < n; i += 64) {
                                asm volatile("" ::: "memory");
                                const u16* kr = PROJ + (size_t)i * PP + C_IDXK;
                                float s = 0.f;
#pragma unroll
                                for (int hh = 0; hh < 8; ++hh) { const float d = dot_q(iq + hh * 64, kr, 64); s = fmaf(iw[hh], fmaxf(d, 0.f), s); }
                                s += 0.f;
                                const u32 bts = __float_as_uint(s);
                                uk[i] = (bts & 0x80000000u) ? ~bts : (bts | 0x80000000u);
                            }
                            const int nr = (n + 63) & ~63;
                            u32 Tv = 0u;
                            for (int bit = 31; bit >= 0; --bit) {
                                const u32 cand = Tv | (1u << bit); int cnt = 0;
                                for (int i = lane; i < nr; i += 64) cnt += __popcll(__ballot(i < n && uk[i] >= cand));
                                if (cnt >= 256) Tv = cand;
                            }
                            int cgt = 0;
                            for (int i = lane; i < nr; i += 64) cgt += __popcll(__ballot(i < n && uk[i] > Tv));
                            const int need = 256 - cgt; int run = 0;
#pragma unroll 1
                            for (int base = 0; base < 4096; base += 64) {
                                const int i = base + lane; const bool v = i < n; const u32 ui = v ? uk[i] : 0u;
                                const bool gt = v && ui > Tv, eq = v && ui == Tv;
                                const u64 beq = __ballot(eq);
                                const int rank = run + __popcll(beq & ((1ull << lane) - 1ull));
                                const bool sel = gt || (eq && rank < need);
                                run += __popcll(beq);
                                const u64 bs = __ballot(sel);
                                if (lane == 0) { mrow[base / 32] = (u32)bs; mrow[base / 32 + 1] = (u32)(bs >> 32); }
                            }
                        }
                    }
                }
            PH_END
            PH_BEGIN
                {
                    float* sc = wsl;
                    float* qs = wsl + 4096;
                    for (int it = blockIdx.x * 8 + wv; it < SEQ * 8; it += gridDim.x * 8) {
                        const int r = it >> 3, hh = it & 7;
                        for (int i = lane; i < 128; i += 64) qs[i] = bf2f(MQN[(size_t)r * 1024 + hh * 128 + i]);
                        qs[128 + lane] = bf2f(MQR[(size_t)r * 512 + hh * 64 + lane]);
                        float o[2];
                        wave_attn<2>(sc, r + 1,
                            [&](int s) { return (dot_q(qs, MKN + (size_t)s * 1024 + hh * 128, 128) + dot_q(qs + 128, MKR + (size_t)s * 64, 64)) * 0.07216878364870322f; },
                            [&](int s) { return MV + (size_t)s * 1024 + hh * 128; }, o, lane);
                        *(u32*)(MQN + (size_t)r * 1024 + hh * 128 + lane * 2) = f2bf(o[0]) | (f2bf(o[1]) << 16);
                    }
                    for (int it = blockIdx.x * 8 + wv; it < SEQ * 8; it += gridDim.x * 8) {
                        const int r = it >> 3, hh = it & 7;
                        u16* qp = PROJ + (size_t)r * PP + C_DSAQ + hh * 128;
                        for (int i = lane; i < 128; i += 64) qs[i] = bf2f(qp[i]);
                        const u32* mrow = BITM + (size_t)r * 128;
                        float o[2];
                        wave_attn<2>(sc, r + 1,
                            [&](int s) { if (!((mrow[s >> 5] >> (s & 31)) & 1u)) return -INFINITY;
                                         return dot_q(qs, PROJ + (size_t)s * PP + C_DSAK + hh * 128, 128) * 0.08838834764831845f + p.rel_bias[relbucket(r - s) * 16 + hh]; },
                            [&](int s) { return PROJ + (size_t)s * PP + C_DSAV + hh * 128; }, o, lane);
                        *(u32*)(qp + lane * 2) = f2bf(o[0]) | (f2bf(o[1]) << 16);
                    }
                    float* qn = wsl + 4096;
                    float* pcs = wsl;
                    int* blist = (int*)(wsl + 1024);
                    for (int it = blockIdx.x * 8 + wv; it < SEQ * 2; it += gridDim.x * 8) {
                        const int r = it >> 1, gg = it & 1, t = r;
                        u16* qp = PROJ + (size_t)r * PP + C_NSAQ + gg * 512;
                        for (int i = lane; i < 512; i += 64) qn[i] = bf2f(qp[i]);
                        const int ncv = t >= 31 ? min((t - 31) / 16 + 1, 255) : 0;
                        float oc[4][2], osl[4][2], ow[4][2];
                        float imp = 0.f;
                        for (int hg = 0; hg < 4; ++hg) {
                            const float sum = wave_attn<2>(pcs, ncv,
                                [&](int c) { return dot_q(qn + hg * 128, KCMP + (size_t)(c * 2 + gg) * 128, 128) * 0.08838834764831845f; },
                                [&](int c) { return VCMP + (size_t)(c * 2 + gg) * 128; }, oc[hg], lane);
                            if (ncv > 0) {
                                const float inv = 1.f / sum;
                                for (int c = 4 * lane - 1; c <= 4 * lane + 3; ++c) if (c >= 0 && c < ncv) imp += pcs[c] * inv;
                            }
                        }
                        const int blk = t >> 6;
                        float v = imp;
                        if (lane == 0 || lane == blk || lane == blk - 1) v = INFINITY;
                        if (lane > blk) v = -INFINITY;
                        int rank = 0;
                        for (int jj = 0; jj < 64; ++jj) { const float vv = __shfl(v, jj); rank += (vv > v || (vv == v && jj < lane)) ? 1 : 0; }
                        const bool sel = rank < 16 && lane <= blk;
                        const u64 smask = __ballot(sel);
                        const int nsel = __popcll(smask);
                        if (sel) blist[__popcll(smask & ((1ull << lane) - 1ull))] = lane;
                        const int nw = min(t + 1, 512);
                        for (int hg = 0; hg < 4; ++hg) {
                            const int hd = 8 + gg * 4 + hg;
                            wave_attn<2>(pcs, nsel * 64,
                                [&](int i) { const int s = blist[i >> 6] * 64 + (i & 63); if (s > t) return -INFINITY;
                                             return dot_q(qn + hg * 128, PROJ + (size_t)s * PP + C_NKS + gg * 128, 128) * 0.08838834764831845f + p.rel_bias[relbucket(t - s) * 16 + hd]; },
                                [&](int i) { const int s = blist[i >> 6] * 64 + (i & 63); return PROJ + (size_t)s * PP + C_NVS + gg * 128; }, osl[hg], lane);
                            wave_attn<2>(pcs, nw,
                                [&](int i) { const int s = t - nw + 1 + i;
                                             return dot_q(qn + hg * 128, PROJ + (size_t)s * PP + C_NKW + gg * 128, 128) * 0.08838834764831845f + p.rel_bias[relbucket(t - s) * 16 + hd]; },
                                [&](int i) { const int s = t - nw + 1 + i; return PROJ + (size_t)s * PP + C_NVW + gg * 128; }, ow[hg], lane);
                        }
                        const u16* gp = PROJ + (size_t)r * PP + C_NGATE;
#pragma unroll
                        for (int hg = 0; hg < 4; ++hg) {
                            const float g0 = sigmoidf_(bf2f(gp[0 * 8 + gg * 4 + hg])), g1 = sigmoidf_(bf2f(gp[1 * 8 + gg * 4 + hg])), g2 = sigmoidf_(bf2f(gp[2 * 8 + gg * 4 + hg]));
                            const float a0 = g0 * oc[hg][0] + g1 * osl[hg][0] + g2 * ow[hg][0], a1 = g0 * oc[hg][1] + g1 * osl[hg][1] + g2 * ow[hg][1];
                            *(u32*)(qp + hg * 128 + lane * 2) = f2bf(a0) | (f2bf(a1) << 16);
                        }
                    }
                }
            PH_END
            PH_BEGIN
                for (int i = 0; i < 3; ++i) {
                    const float* Wb = p.w_branch + ((size_t)l * 3 + i) * 1024 * 1024;
                    const u16* A = i == 0 ? MQN : (i == 1 ? PROJ + C_DSAQ : PROJ + C_NSAQ);
                    const int lda = i == 0 ? 1024 : PP;
                    ngemm(lds, A, lda, SEQ, 1024, 1024,
                          [&](int k, int n) { return Wb[(size_t)k * 1024 + n]; },
                          [&](int m, int n, float v) { u16* gp = GATES + (size_t)m * 3072 + i * 1024 + n; *gp = (u16)f2bf(bf2f(*gp) * v); });
                }
            PH_END
            PH_BEGIN
                for (size_t e = (size_t)blockIdx.x * 512 + tid; e < (size_t)SEQ * 1024; e += (size_t)gridDim.x * 512) {
                    const size_t m = e >> 10, n = e & 1023; const u16* gp = GATES + m * 3072 + n;
                    MERGED[((size_t)b * SEQ + m) * 1024 + n] = (u16)f2bf(bf2f(gp[0]) + bf2f(gp[1024]) + bf2f(gp[2048]));
                }
            PH_END
        }
        PH_BEGIN
            { const float* Wo = p.w_out + (size_t)l * 1024 * 1024;
              ngemm(lds, MERGED, 1024, T, 1024, 1024, [&](int k, int n) { return Wo[(size_t)k * 1024 + n]; },
                    [&](int m, int n, float v) { F32[(size_t)m * 1024 + n] = v; }); }
        PH_END
        PH_BEGIN
            ph_resid_norm(F32, g + 1 * 1024, xin, p.out, g + 2 * 1024, HB, T);
        PH_END
        PH_BEGIN
            { const float* Wq = p.cwq + (size_t)l * 1024 * 1024;
              ngemm(lds, HB, 1024, T, 1024, 1024, [&](int k, int n) { return Wq[(size_t)k * 1024 + n]; },
                    [&](int m, int n, float v) { CQ[(size_t)m * 1024 + n] = (u16)f2bf(v); }); }
        PH_END
        PH_BEGIN
            {
                float* sc = wsl; float* qs = wsl + 4096;
                for (int it = blockIdx.x * 8 + wv; it < T * 4; it += gridDim.x * 8) {
                    const int r = it >> 2, hh = it & 3, bb = r / SEQ;
                    u16* qp = CQ + (size_t)r * 1024 + hh * 256;
                    for (int i = lane; i < 256; i += 64) qs[i] = bf2f(qp[i]);
                    float o[4];
                    wave_attn<4>(sc, 256,
                        [&](int m) { return dot_q(qs, CKV + (size_t)(bb * 256 + m) * 2048 + hh * 256, 256) * 0.0625f; },
                        [&](int m) { return CKV + (size_t)(bb * 256 + m) * 2048 + 1024 + hh * 256; }, o, lane);
                    uint2 w; w.x = f2bf(o[0]) | (f2bf(o[1]) << 16); w.y = f2bf(o[2]) | (f2bf(o[3]) << 16);
                    *(uint2*)(qp + lane * 4) = w;
                }
            }
        PH_END
        PH_BEGIN
            { const float* Wo = p.cwo + (size_t)l * 1024 * 1024;
              ngemm(lds, CQ, 1024, T, 1024, 1024, [&](int k, int n) { return Wo[(size_t)k * 1024 + n]; },
                    [&](int m, int n, float v) { F32[(size_t)m * 1024 + n] = v; }); }
        PH_END
        PH_BEGIN
            ph_resid_norm(F32, g + 4 * 1024, p.out, p.out, g + 5 * 1024, HB, T);
        PH_END
        PH_BEGIN
            { const float* W1 = p.w1 + (size_t)l * 1024 * 4096;
              ngemm(lds, HB, 1024, T, 4096, 1024, [&](int k, int n) { return W1[(size_t)k * 4096 + n]; },
                    [&](int m, int n, float v) { const float rr = fmaxf(v, 0.f); U[(size_t)m * 4096 + n] = (u16)f2bf(rr * rr); }); }
        PH_END
        PH_BEGIN
            { const float* W2 = p.w2 + (size_t)l * 4096 * 1024;
              ngemm(lds, U, 4096, T, 1024, 4096, [&](int k, int n) { return W2[(size_t)k * 1024 + n]; },
                    [&](int m, int n, float v) { F32[(size_t)m * 1024 + n] = v; }); }
        PH_END
        PH_BEGIN
            ph_resid_norm(F32, g + 6 * 1024, p.out, p.out, nullptr, HB, T);
        PH_END
    }
}

constexpr int NPHASES = DEPTH * (1 + NB * 7 + 9);

extern "C" void kernel_launch(void* const* d_in, const int* in_sizes, int n_in, void* d_out, int out_size, void* d_ws, size_t ws_size,
                              hipStream_t stream) {
    (void)in_sizes; (void)out_size;
    if (n_in != 20 || ws_size < WS_END) { fprintf(stderr, "kernel_launch: bad n_in %d or ws_size %zu < %zu\n", n_in, ws_size, (size_t)WS_END); return; }
    static int grid = 0;
    if (!grid) {
        hipError_t e = hipFuncSetAttribute((const void*)mega, hipFuncAttributeMaxDynamicSharedMemorySize, LDS_BYTES);
        if (e != hipSuccess) fprintf(stderr, "hipFuncSetAttribute: %s\n", hipGetErrorString(e));
        int dev = 0, cus = 0, per_cu = 0;
        (void)hipGetDevice(&dev);
        (void)hipDeviceGetAttribute(&cus, hipDeviceAttributeMultiprocessorCount, dev);
        (void)hipOccupancyMaxActiveBlocksPerMultiprocessor(&per_cu, mega, 512, LDS_BYTES);
        if (cus <= 0) cus = 256;
        if (per_cu < 1) { fprintf(stderr, "occupancy query says %d blocks per CU\n", per_cu); per_cu = 1; }
        grid = cus;
    }
    (void)hipMemsetAsync((unsigned char*)d_ws + WS_CTL, 0, CTL_BYTES, stream);
    Params p; memset(&p, 0, sizeof(p));
    p.x = (const float*)d_in[0]; p.mem = (const float*)d_in[1]; p.pos = (const int*)d_in[2]; p.rel_bias = (const float*)d_in[3];
    p.gains = (const float*)d_in[4]; p.w_in = (const float*)d_in[5]; p.qnorm = (const float*)d_in[6]; p.kvnorm = (const float*)d_in[7];
    p.w_uq = (const float*)d_in[8]; p.w_ukv = (const float*)d_in[9]; p.cmp_pos = (const float*)d_in[10]; p.cmp_w1 = (const float*)d_in[11];
    p.cmp_w2 = (const float*)d_in[12]; p.w_branch = (const float*)d_in[13]; p.w_out = (const float*)d_in[14]; p.cwq = (const float*)d_in[15];
    p.cwkv = (const float*)d_in[16]; p.cwo = (const float*)d_in[17]; p.w1 = (const float*)d_in[18]; p.w2 = (const float*)d_in[19];
    p.out = (float*)d_out; p.ws = (unsigned char*)d_ws;
#if MK_MULTI_LAUNCH
    for (int ph = 0; ph < NPHASES; ++ph) { p.ph_lo = ph; p.ph_hi = ph + 1; hipLaunchKernelGGL(mega, dim3(grid), dim3(512), LDS_BYTES, stream, p); }
#else
    p.ph_lo = 0; p.ph_hi = NPHASES;
    hipLaunchKernelGGL(mega, dim3(grid), dim3(512), LDS_BYTES, stream, p);
#endif
}
```

```cpp
#include <hip/hip_runtime.h>
#include <cstdio>
#include <cstdint>
#include <cstring>

#ifndef MK_MULTI_LAUNCH
#define MK_MULTI_LAUNCH 0
#endif

typedef unsigned short u16;
typedef unsigned int u32;
typedef unsigned long long u64;
#define DI __device__ __forceinline__
#define LAS __attribute__((address_space(3)))

constexpr int T = 16384, SEQ = 4096, NB = 4, DM = 1024, DEPTH = 2, D_IN = 10016;
constexpr int PP = 7168;
constexpr int C_QLAT = 0, C_KVLAT = 384, C_KROPE = 640, C_IDXK = 704, C_IDXQ = 768, C_DSAQ = 1280, C_DSAK = 2304, C_DSAV = 3328,
              C_NSAQ = 4352, C_NKC = 5376, C_NVC = 5632, C_NKS = 5888, C_NVS = 6144, C_NKW = 6400, C_NVW = 6656, C_IDXW = 6912,
              C_NGATE = 6920, C_END = 6944;
constexpr float EPS = 1e-6f;

constexpr size_t MiB = 1u << 20;
constexpr size_t WS_CTL = 0, CTL_BYTES = 1 * MiB;
constexpr size_t WS_WB = 1 * MiB;
constexpr size_t WS_HB = 38 * MiB;
constexpr size_t WS_MEMN = 70 * MiB;
constexpr size_t WS_CKV = 72 * MiB;
constexpr size_t WS_A = 76 * MiB;
constexpr size_t WS_MERGED = WS_A;
constexpr size_t WS_PROJ = WS_A + 32 * MiB;
constexpr size_t WS_GATES = WS_A + 88 * MiB;
constexpr size_t WS_QNRM = WS_A + 112 * MiB;
constexpr size_t WS_KVNRM = WS_A + 115 * MiB;
constexpr size_t WS_MQN = WS_A + 117 * MiB;
constexpr size_t WS_MQR = WS_A + 125 * MiB;
constexpr size_t WS_MKN = WS_A + 129 * MiB;
constexpr size_t WS_MV = WS_A + 137 * MiB;
constexpr size_t WS_MKR = WS_A + 145 * MiB;
constexpr size_t WS_CBK = WS_A + 146 * MiB;
constexpr size_t WS_CBV = WS_A + 150 * MiB;
constexpr size_t WS_CH = WS_A + 154 * MiB;
constexpr size_t WS_KCMP = WS_A + 155 * MiB;
constexpr size_t WS_VCMP = WS_A + 155 * MiB + 512 * 1024;
constexpr size_t WS_BITM = WS_A + 156 * MiB;
constexpr size_t WS_F32 = WS_A + 32 * MiB;
constexpr size_t WS_CQ = WS_A + 96 * MiB;
constexpr size_t WS_U = WS_A + 96 * MiB;
constexpr size_t WS_END = WS_A + 224 * MiB;

constexpr int LDS_BYTES = 152 * 1024;
constexpr int LDS_MISC = 147456;
constexpr int WSLOT = 18432;

DI float bf2f(u32 h) { return __uint_as_float(h << 16); }
DI u32 f2bf(float f) { u32 u = __float_as_uint(f); return (u + 0x7fffu + ((u >> 16) & 1u)) >> 16; }
DI float wave_sum(float v) { for (int o = 32; o; o >>= 1) v += __shfl_xor(v, o); return v; }
DI float wave_max(float v) { for (int o = 32; o; o >>= 1) v = fmaxf(v, __shfl_xor(v, o)); return v; }
DI float sigmoidf_(float x) { return 1.f / (1.f + __expf(-x)); }
DI float gelu_tanh(float x) { return 0.5f * x * (1.f + tanhf(0.7978845608028654f * (x + 0.044715f * x * x * x))); }

__device__ const unsigned char BUCKET_TAB[128] = {
    0, 1, 2, 3, 4, 5, 6, 7, 8, 9, 10, 11, 12, 13, 14, 15, 16, 16, 16, 17, 17, 18, 18, 18, 19, 19, 19, 20, 20, 20, 20, 21, 21, 21, 21, 22, 22, 22, 22, 22,
    23, 23, 23, 23, 23, 23, 24, 24, 24, 24, 24, 24, 25, 25, 25, 25, 25, 25, 25, 26, 26, 26, 26, 26, 26, 26, 26, 27, 27, 27, 27, 27, 27, 27, 27, 27, 27,
    28, 28, 28, 28, 28, 28, 28, 28, 28, 28, 29, 29, 29, 29, 29, 29, 29, 29, 29, 29, 29, 29, 30, 30, 30, 30, 30, 30, 30, 30, 30, 30, 30, 30, 30, 30,
    31, 31, 31, 31, 31, 31, 31, 31, 31, 31, 31, 31, 31, 31, 31};
DI int relbucket(int n) { return n >= 127 ? 31 : (int)BUCKET_TAB[n < 0 ? 0 : n]; }

DI int proj_src(int n) {
    if (n < 704) return n;
    if (n < 768) return 4288 + (n - 704);
    if (n < 1280) return 3776 + (n - 768);
    if (n < 4352) return 704 + (n - 1280);
    if (n < 5376) return 4360 + (n - 4352);
    if (n < 6912) return 5384 + (n - 5376);
    if (n < 6920) return 4352 + (n - 6912);
    if (n < 6944) return 6920 + (n - 6920);
    return -1;
}

#define XB_TMO      128
#define XB_XCNT(j)  (256  + 64 * (j))
#define XB_XSUB(j)  (1280 + 64 * (j))
#define XB_XGEN(j)  (2304 + 64 * (j))
#define XB_TOP      3328
#define XB_TOPGEN   3392
#define XCD_BAR_WORDS 3456
#define XB_SPIN_CAP (1u << 21)
DI unsigned xb_ld(unsigned* p)              { return __hip_atomic_load(p, __ATOMIC_RELAXED, __HIP_MEMORY_SCOPE_AGENT); }
DI unsigned xb_add(unsigned* p, unsigned v) { return __hip_atomic_fetch_add(p, v, __ATOMIC_RELAXED, __HIP_MEMORY_SCOPE_AGENT); }
DI unsigned xb_xcc_id() { return (unsigned)__builtin_amdgcn_s_getreg((3 << 11) | 20) & 0xFu; }
#define XB_SPIN(cond, bar) do { unsigned _sp = 0; while (cond) { __builtin_amdgcn_s_sleep(1); \
    if ((++_sp & 255u) == 0u) { if (xb_ld(&(bar)[XB_TMO])) break; if (_sp > XB_SPIN_CAP) { atomicAdd(&(bar)[XB_TMO], 1u); break; } } } } while (0)
struct XcdBarrier { unsigned* bar; unsigned x; volatile LAS unsigned* st; };
DI XcdBarrier xcd_barrier_post(unsigned* bar, volatile LAS unsigned* st) {
    XcdBarrier b; b.bar = bar; b.x = xb_xcc_id(); b.st = st;
    if (threadIdx.x == 0) (void)xb_add(&bar[XB_XCNT(b.x)], 1u);
    return b;
}
DI void xcd_barrier_complete(unsigned* bar, unsigned x, unsigned& nloc, unsigned& nx) {
    const unsigned G = gridDim.x * gridDim.y * gridDim.z;
    unsigned sum, cnt, mine, sp = 0u;
    for (;;) {
        sum = 0u; cnt = 0u; mine = 0u;
#pragma unroll
        for (unsigned j = 0; j < 16; ++j) { const unsigned c = xb_ld(&bar[XB_XCNT(j)]); sum += c; cnt += (c > 0u) ? 1u : 0u; mine = (j == x) ? c : mine; }
        if (sum == G) break;
        __builtin_amdgcn_s_sleep(1);
        if ((++sp & 255u) == 0u) { if (xb_ld(&bar[XB_TMO])) break; if (sp > XB_SPIN_CAP) { atomicAdd(&bar[XB_TMO], 1u); break; } }
    }
    nloc = mine > 0u ? mine : 1u; nx = cnt > 0u ? cnt : 1u;
}
DI void xcd_barrier(const XcdBarrier& b) {
    asm volatile("s_waitcnt vmcnt(0)" ::: "memory");
    __syncthreads();
    if (threadIdx.x == 0) {
        unsigned* bar = b.bar;
        __builtin_amdgcn_s_waitcnt(0);
        unsigned nloc = b.st[0], nx = b.st[1];
        if (nloc == 0u) { xcd_barrier_complete(bar, b.x, nloc, nx); b.st[0] = nloc; b.st[1] = nx; }
        const unsigned old = xb_add(&bar[XB_XSUB(b.x)], 1u);
        const unsigned gen = old / nloc;
        if (old + 1u == (gen + 1u) * nloc) {
            __builtin_amdgcn_fence(__ATOMIC_RELEASE, "agent");
            asm volatile("s_waitcnt vmcnt(0)" ::: "memory");
            const unsigned og = xb_add(&bar[XB_TOP], 1u);
            const unsigned tg = og / nx;
            if (og + 1u == (tg + 1u) * nx) xb_add(&bar[XB_TOPGEN], 1u);
            else XB_SPIN(xb_ld(&bar[XB_TOPGEN]) == tg, bar);
            __builtin_amdgcn_fence(__ATOMIC_ACQUIRE, "agent");
            xb_add(&bar[XB_XGEN(b.x)], 1u);
            asm volatile("s_waitcnt vmcnt(0)" ::: "memory");
        } else {
            XB_SPIN(xb_ld(&bar[XB_XGEN(b.x)]) == gen, bar);
            __builtin_amdgcn_fence(__ATOMIC_ACQUIRE, "agent");
            asm volatile("s_waitcnt vmcnt(0)" ::: "memory");
        }
    }
    __syncthreads();
}

struct Params {
    const float* x; const float* mem; const int* pos; const float* rel_bias; const float* gains; const float* w_in;
    const float* qnorm; const float* kvnorm; const float* w_uq; const float* w_ukv; const float* cmp_pos; const float* cmp_w1;
    const float* cmp_w2; const float* w_branch; const float* w_out; const float* cwq; const float* cwkv; const float* cwo;
    const float* w1; const float* w2;
    float* out; unsigned char* ws;
    int ph_lo, ph_hi;
};

DI int opaque_tid() { int t = threadIdx.x; asm volatile("" : "+v"(t)); return t; }
template <class BF, class EF>
DI void ngemm(unsigned char* lds, const u16* A, int lda, int M, int N, int K, BF bfn, EF efn) {
    float* As = (float*)lds;
    float* Bs = As + 16 * 132;
    const int tid = opaque_tid(), tx = tid & 31, ty = tid >> 5;
    const int ntn = N / 128, ntiles = (M / 128) * ntn;
    for (int tile = blockIdx.x; tile < ntiles; tile += gridDim.x) {
        const int m0 = (tile / ntn) * 128, n0 = (tile % ntn) * 128;
        float acc[8][4];
#pragma unroll
        for (int i = 0; i < 8; ++i)
#pragma unroll
            for (int j = 0; j < 4; ++j) acc[i][j] = 0.f;
        for (int k0 = 0; k0 < K; k0 += 16) {
            {
                const int i = tid >> 2, kq = (tid & 3) * 4;
                const uint2 v = *(const uint2*)(A + (size_t)(m0 + i) * lda + k0 + kq);
                As[(kq + 0) * 132 + i] = bf2f(v.x & 0xffffu); As[(kq + 1) * 132 + i] = bf2f(v.x >> 16);
                As[(kq + 2) * 132 + i] = bf2f(v.y & 0xffffu); As[(kq + 3) * 132 + i] = bf2f(v.y >> 16);
                const int kk = tid >> 5, nq = (tid & 31) * 4;
#pragma unroll
                for (int j = 0; j < 4; ++j) Bs[kk * 132 + nq + j] = bfn(k0 + kk, n0 + nq + j);
            }
            __syncthreads();
#pragma unroll 2
            for (int kk = 0; kk < 16; ++kk) {
                float a[8], b[4];
#pragma unroll
                for (int i = 0; i < 8; ++i) a[i] = As[kk * 132 + ty * 8 + i];
#pragma unroll
                for (int j = 0; j < 4; ++j) b[j] = Bs[kk * 132 + tx * 4 + j];
#pragma unroll
                for (int i = 0; i < 8; ++i)
#pragma unroll
                    for (int j = 0; j < 4; ++j) acc[i][j] = fmaf(a[i], b[j], acc[i][j]);
            }
            __syncthreads();
        }
#pragma unroll
        for (int i = 0; i < 8; ++i)
#pragma unroll
            for (int j = 0; j < 4; ++j) efn(m0 + ty * 8 + i, n0 + tx * 4 + j, acc[i][j]);
    }
}

DI void ph_norm_rows(const float* src, const float* g, u16* dst, int rows) {
    const int tid = opaque_tid(), lane = tid & 63, wv = tid >> 6;
    for (int r = blockIdx.x * 8 + wv; r < rows; r += gridDim.x * 8) {
        const float* s = src + (size_t)r * 1024;
        float v[16]; float ss = 0.f;
#pragma unroll
        for (int i = 0; i < 16; ++i) { v[i] = s[lane + 64 * i]; ss += v[i] * v[i]; }
        ss = wave_sum(ss);
        const float rs = rsqrtf(ss * (1.f / 1024.f) + EPS);
#pragma unroll
        for (int i = 0; i < 16; ++i) dst[(size_t)r * 1024 + lane + 64 * i] = (u16)f2bf(v[i] * rs * g[lane + 64 * i]);
    }
}
DI void ph_resid_norm(const float* f, const float* gpost, const float* xin, float* xout, const float* gnext, u16* hb, int rows) {
    const int tid = opaque_tid(), lane = tid & 63, wv = tid >> 6;
    for (int r = blockIdx.x * 8 + wv; r < rows; r += gridDim.x * 8) {
        const float* s = f + (size_t)r * 1024;
        float v[16]; float ss = 0.f;
#pragma unroll
        for (int i = 0; i < 16; ++i) { v[i] = s[lane + 64 * i]; ss += v[i] * v[i]; }
        ss = wave_sum(ss);
        const float rs = rsqrtf(ss * (1.f / 1024.f) + EPS);
        float s2 = 0.f;
#pragma unroll
        for (int i = 0; i < 16; ++i) { v[i] = xin[(size_t)r * 1024 + lane + 64 * i] + v[i] * rs * gpost[lane + 64 * i]; s2 += v[i] * v[i]; }
#pragma unroll
        for (int i = 0; i < 16; ++i) xout[(size_t)r * 1024 + lane + 64 * i] = v[i];
        if (gnext) {
            s2 = wave_sum(s2);
            const float r2 = rsqrtf(s2 * (1.f / 1024.f) + EPS);
#pragma unroll
            for (int i = 0; i < 16; ++i) hb[(size_t)r * 1024 + lane + 64 * i] = (u16)f2bf(v[i] * r2 * gnext[lane + 64 * i]);
        }
    }
}

template <int NV, class SF, class VF>
DI float wave_attn(float* sc, int n, SF scoref, VF vrowf, float (&out)[NV], int lane) {
#pragma unroll
    for (int j = 0; j < NV; ++j) out[j] = 0.f;
    float m = -INFINITY;
#pragma unroll 1
    for (int i = lane; i < n; i += 64) { asm volatile("" ::: "memory"); const float s = scoref(i); sc[i] = s; m = fmaxf(m, s); }
    m = wave_max(m);
    if (!(m > -INFINITY)) return 0.f;
    float sum = 0.f;
    for (int i = lane; i < n; i += 64) { const float p = __expf(sc[i] - m); sc[i] = p; sum += p; }
    sum = wave_sum(sum);
    float acc[NV];
#pragma unroll
    for (int j = 0; j < NV; ++j) acc[j] = 0.f;
#pragma unroll 4
    for (int i = 0; i < n; ++i) {
        const float p = sc[i];
        if (p != 0.f) {
            const u16* v = vrowf(i);
            if constexpr (NV == 2) { const u32 w = *(const u32*)(v + lane * 2); acc[0] = fmaf(p, bf2f(w & 0xffffu), acc[0]); acc[1] = fmaf(p, bf2f(w >> 16), acc[1]); }
            else { const uint2 w = *(const uint2*)(v + lane * 4); acc[0] = fmaf(p, bf2f(w.x & 0xffffu), acc[0]); acc[1] = fmaf(p, bf2f(w.x >> 16), acc[1]);
                   acc[2 % NV] = fmaf(p, bf2f(w.y & 0xffffu), acc[2 % NV]); acc[3 % NV] = fmaf(p, bf2f(w.y >> 16), acc[3 % NV]); }
        }
    }
    const float inv = 1.f / sum;
#pragma unroll
    for (int j = 0; j < NV; ++j) out[j] = acc[j] * inv;
    return sum;
}
DI float dot_q(const float* q, const u16* k, int n) {
    float a = 0.f;
#pragma unroll 4
    for (int d = 0; d < n; d += 8) {
        const uint4 w = *(const uint4*)(k + d);
        a = fmaf(q[d + 0], bf2f(w.x & 0xffffu), a); a = fmaf(q[d + 1], bf2f(w.x >> 16), a);
        a = fmaf(q[d + 2], bf2f(w.y & 0xffffu), a); a = fmaf(q[d + 3], bf2f(w.y >> 16), a);
        a = fmaf(q[d + 4], bf2f(w.z & 0xffffu), a); a = fmaf(q[d + 5], bf2f(w.z >> 16), a);
        a = fmaf(q[d + 6], bf2f(w.w & 0xffffu), a); a = fmaf(q[d + 7], bf2f(w.w >> 16), a);
    }
    return a;
}

__global__ void __launch_bounds__(512, 2) mega(Params p) {
    extern __shared__ __attribute__((aligned(16))) unsigned char lds[];
    volatile LAS unsigned* xbw = (volatile LAS unsigned*)(lds + LDS_MISC);
    if (threadIdx.x == 0) { xbw[0] = 0u; xbw[1] = 0u; xbw[2] = 0u; xbw[3] = 0u; }
    __syncthreads();
    unsigned* ctl = (unsigned*)(p.ws + WS_CTL);
    XcdBarrier bar = xcd_barrier_post(ctl + 4096, xbw);

    unsigned char* ws = p.ws;
    u16* HB = (u16*)(ws + WS_HB); u16* MEMN = (u16*)(ws + WS_MEMN); u16* CKV = (u16*)(ws + WS_CKV);
    u16* MERGED = (u16*)(ws + WS_MERGED); u16* PROJ = (u16*)(ws + WS_PROJ); u16* GATES = (u16*)(ws + WS_GATES);
    u16* QNRM = (u16*)(ws + WS_QNRM); u16* KVNRM = (u16*)(ws + WS_KVNRM);
    u16* MQN = (u16*)(ws + WS_MQN); u16* MQR = (u16*)(ws + WS_MQR); u16* MKN = (u16*)(ws + WS_MKN); u16* MV = (u16*)(ws + WS_MV); u16* MKR = (u16*)(ws + WS_MKR);
    u16* CBK = (u16*)(ws + WS_CBK); u16* CBV = (u16*)(ws + WS_CBV); u16* CH = (u16*)(ws + WS_CH);
    u16* KCMP = (u16*)(ws + WS_KCMP); u16* VCMP = (u16*)(ws + WS_VCMP); u32* BITM = (u32*)(ws + WS_BITM);
    float* F32 = (float*)(ws + WS_F32); u16* CQ = (u16*)(ws + WS_CQ); u16* U = (u16*)(ws + WS_U);

    int ph = 0;
#define PH_BEGIN if (ph >= p.ph_lo && ph < p.ph_hi) { const int tid = opaque_tid(), lane = tid & 63, wv = tid >> 6; float* wsl = (float*)(lds + wv * WSLOT); (void)lane; (void)wsl;
#define PH_END   if (ph + 1 < p.ph_hi) xcd_barrier(bar); } ++ph;

    for (int l = 0; l < DEPTH; ++l) {
        const float* g = p.gains + (size_t)l * 7 * 1024;
        const float* xin = (l == 0) ? p.x : p.out;
        const float* Win = p.w_in + (size_t)l * 1024 * D_IN;
        PH_BEGIN
            ph_norm_rows(xin, g, HB, T);
            ph_norm_rows(p.mem, g + 3 * 1024, MEMN, 1024);
        PH_END
        for (int b = 0; b < NB; ++b) {
            const u16* hb = HB + (size_t)b * SEQ * 1024;
            PH_BEGIN
                ngemm(lds, hb, 1024, SEQ, PP, 1024,
                      [&](int k, int n) { const int s = proj_src(n); return s >= 0 ? Win[(size_t)k * D_IN + s] : 0.f; },
                      [&](int m, int n, float v) { PROJ[(size_t)m * PP + n] = (u16)f2bf(v); });
                ngemm(lds, hb, 1024, SEQ, 3072, 1024,
                      [&](int k, int n) { return Win[(size_t)k * D_IN + 6944 + n]; },
                      [&](int m, int n, float v) { GATES[(size_t)m * 3072 + n] = (u16)f2bf(sigmoidf_(v)); });
                if (b == 0) {
                    const float* Wkv = p.cwkv + (size_t)l * 1024 * 2048;
                    ngemm(lds, MEMN, 1024, 1024, 2048, 1024,
                          [&](int k, int n) { return Wkv[(size_t)k * 2048 + n]; },
                          [&](int m, int n, float v) { CKV[(size_t)m * 2048 + n] = (u16)f2bf(v); });
                }
            PH_END
            PH_BEGIN
                {
                    const float* qg = p.qnorm + l * 384; const float* kg = p.kvnorm + l * 256;
                    for (int r = blockIdx.x * 8 + wv; r < SEQ; r += gridDim.x * 8) {
                        const u16* pr = PROJ + (size_t)r * PP;
                        float v[6]; float ss = 0.f;
#pragma unroll
                        for (int i = 0; i < 6; ++i) { v[i] = bf2f(pr[C_QLAT + lane + 64 * i]); ss += v[i] * v[i]; }
                        ss = wave_sum(ss); float rs = rsqrtf(ss * (1.f / 384.f) + EPS);
#pragma unroll
                        for (int i = 0; i < 6; ++i) QNRM[(size_t)r * 384 + lane + 64 * i] = (u16)f2bf(v[i] * rs * qg[lane + 64 * i]);
                        ss = 0.f;
#pragma unroll
                        for (int i = 0; i < 4; ++i) { v[i] = bf2f(pr[C_KVLAT + lane + 64 * i]); ss += v[i] * v[i]; }
                        ss = wave_sum(ss); rs = rsqrtf(ss * (1.f / 256.f) + EPS);
#pragma unroll
                        for (int i = 0; i < 4; ++i) KVNRM[(size_t)r * 256 + lane + 64 * i] = (u16)f2bf(v[i] * rs * kg[lane + 64 * i]);
                        if (lane < 32) {
                            const float posf = (float)p.pos[b * SEQ + r];
                            const float invf = powf(10000.f, -(float)lane * (1.f / 32.f));
                            float sn, cs; sincosf(posf * invf, &sn, &cs);
                            const float x1 = bf2f(pr[C_KROPE + lane]), x2 = bf2f(pr[C_KROPE + 32 + lane]);
                            MKR[(size_t)r * 64 + lane] = (u16)f2bf(x1 * cs - x2 * sn);
                            MKR[(size_t)r * 64 + 32 + lane] = (u16)f2bf(x2 * cs + x1 * sn);
                        }
                    }
                    const float* cpos = p.cmp_pos + (size_t)l * 2 * 32 * 128;
                    for (size_t e = (size_t)blockIdx.x * 512 + tid; e < (size_t)512 * 4096; e += (size_t)gridDim.x * 512) {
                        const int row = (int)(e >> 12), col = (int)(e & 4095), c = row >> 1, gg = row & 1, ll = col >> 7, d = col & 127;
                        float vk = 0.f, vv = 0.f;
                        if (row < 510) {
                            const u16* pr = PROJ + (size_t)(16 * c + ll) * PP + gg * 128 + d;
                            vk = bf2f(pr[C_NKC]) + cpos[ll * 128 + d];
                            vv = bf2f(pr[C_NVC]) + cpos[32 * 128 + ll * 128 + d];
                        }
                        CBK[e] = (u16)f2bf(vk); CBV[e] = (u16)f2bf(vv);
                    }
                }
            PH_END
            PH_BEGIN
                {
                    const float* Wuq = p.w_uq + (size_t)l * 384 * 1536; const float* Wukv = p.w_ukv + (size_t)l * 256 * 2048;
                    ngemm(lds, QNRM, 384, SEQ, 1536, 384,
                          [&](int k, int n) { const int s = n < 1024 ? (n >> 7) * 192 + (n & 127) : ((n - 1024) >> 6) * 192 + 128 + ((n - 1024) & 63); return Wuq[(size_t)k * 1536 + s]; },
                          [&](int m, int n, float v) { if (n < 1024) MQN[(size_t)m * 1024 + n] = (u16)f2bf(v); else MQR[(size_t)m * 512 + (n - 1024)] = (u16)f2bf(v); });
                    ngemm(lds, KVNRM, 256, SEQ, 2048, 256,
                          [&](int k, int n) { return Wukv[(size_t)k * 2048 + n]; },
                          [&](int m, int n, float v) { const int hh = n >> 8, d = n & 127; if (n & 128) MV[(size_t)m * 1024 + hh * 128 + d] = (u16)f2bf(v); else MKN[(size_t)m * 1024 + hh * 128 + d] = (u16)f2bf(v); });
                    for (int kv = 0; kv < 2; ++kv) {
                        const float* W1 = p.cmp_w1 + ((size_t)l * 2 + kv) * 4096 * 256;
                        ngemm(lds, kv ? CBV : CBK, 4096, 512, 256, 4096,
                              [&](int k, int n) { return W1[(size_t)k * 256 + n]; },
                              [&](int m, int n, float v) { CH[(size_t)kv * 512 * 256 + (size_t)m * 256 + n] = (u16)f2bf(gelu_tanh(v)); });
                    }
                }
            PH_END
            PH_BEGIN
                {
                    for (int kv = 0; kv < 2; ++kv) {
                        const float* W2 = p.cmp_w2 + ((size_t)l * 2 + kv) * 256 * 128;
                        u16* dst = kv ? VCMP : KCMP;
                        ngemm(lds, CH + (size_t)kv * 512 * 256, 256, 512, 128, 256,
                              [&](int k, int n) { return W2[(size_t)k * 128 + n]; },
                              [&](int m, int n, float v) { dst[(size_t)m * 128 + n] = (u16)f2bf(m < 510 ? v : 0.f); });
                    }
                    __syncthreads();
                    for (int r = blockIdx.x * 8 + wv; r < SEQ; r += gridDim.x * 8) {
                        const float posf = (float)p.pos[b * SEQ + r];
#pragma unroll
                        for (int i = 0; i < 4; ++i) {
                            const int e = lane + 64 * i, hh = e >> 5, fi = e & 31;
                            const float invf = powf(10000.f, -(float)fi * (1.f / 32.f));
                            float sn, cs; sincosf(posf * invf, &sn, &cs);
                            u16* q = MQR + (size_t)r * 512 + hh * 64;
                            const float x1 = bf2f(q[fi]), x2 = bf2f(q[32 + fi]);
                            q[fi] = (u16)f2bf(x1 * cs - x2 * sn); q[32 + fi] = (u16)f2bf(x2 * cs + x1 * sn);
                        }
                    }
                    u32* uk = (u32*)wsl;
                    float* iq = wsl + 4096;
                    for (int r = blockIdx.x * 8 + wv; r < SEQ; r += gridDim.x * 8) {
                        const u16* pr = PROJ + (size_t)r * PP;
                        for (int i = lane; i < 512; i += 64) iq[i] = bf2f(pr[C_IDXQ + i]);
                        float iw[8];
#pragma unroll
                        for (int hh = 0; hh < 8; ++hh) iw[hh] = bf2f(pr[C_IDXW + hh]);
                        const int n = r + 1;
                        u32* mrow = BITM + (size_t)r * 128;
                        if (n <= 256) {
                            for (int w = lane; w < 128; w += 64) { const int lo = 32 * w; mrow[w] = (lo + 32 <= n) ? 0xffffffffu : (lo >= n ? 0u : ((1u << (n - lo)) - 1u)); }
                        } else {
#pragma unroll 1
                            for (int i = lane; i < n; i += 64) {
                                asm volatile("" ::: "memory");
                                const u16* kr = PROJ + (size_t)i * PP + C_IDXK;
                                float s = 0.f;
#pragma unroll
                                for (int hh = 0; hh < 8; ++hh) { const float d = dot_q(iq + hh * 64, kr, 64); s = fmaf(iw[hh], fmaxf(d, 0.f), s); }
                                s += 0.f;
                                const u32 bts = __float_as_uint(s);
                                uk[i] = (bts & 0x80000000u) ? ~bts : (bts | 0x80000000u);
                            }
                            const int nr = (n + 63) & ~63;
                            u32 Tv = 0u;
                            for (int bit = 31; bit >= 0; --bit) {
                                const u32 cand = Tv | (1u << bit); int cnt = 0;
                                for (int i = lane; i < nr; i += 64) cnt += __popcll(__ballot(i < n && uk[i] >= cand));
                                if (cnt >= 256) Tv = cand;
                            }
                            int cgt = 0;
                            for (int i = lane; i < nr; i += 64) cgt += __popcll(__ballot(i < n && uk[i] > Tv));
                            const int need = 256 - cgt; int run = 0;
#pragma unroll 1
                            for (int base = 0; base < 4096; base += 64) {
                                const int i = base + lane; const bool v = i < n; const u32 ui = v ? uk[i] : 0u;
                                const bool gt = v && ui > Tv, eq = v && ui == Tv;
                                const u64 beq = __ballot(eq);
                                const int rank = run + __popcll(beq & ((1ull << lane) - 1ull));
                                const bool sel = gt || (eq && rank < need);
                                run += __popcll(beq);
                                const u64 bs = __ballot(sel);
                                if (lane == 0) { mrow[base / 32] = (u32)bs; mrow[base / 32 + 1] = (u32)(bs >> 32); }
                            }
                        }
                    }
                }
            PH_END
            PH_BEGIN
                {
                    float* sc = wsl;
                    float* qs = wsl + 4096;
                    for (int it = blockIdx.x * 8 + wv; it < SEQ * 8; it += gridDim.x * 8) {
                        const int r = it >> 3, hh = it & 7;
                        for (int i = lane; i < 128; i += 64) qs[i] = bf2f(MQN[(size_t)r * 1024 + hh * 128 + i]);
                        qs[128 + lane] = bf2f(MQR[(size_t)r * 512 + hh * 64 + lane]);
                        float o[2];
                        wave_attn<2>(sc, r + 1,
                            [&](int s) { return (dot_q(qs, MKN + (size_t)s * 1024 + hh * 128, 128) + dot_q(qs + 128, MKR + (size_t)s * 64, 64)) * 0.07216878364870322f; },
                            [&](int s) { return MV + (size_t)s * 1024 + hh * 128; }, o, lane);
                        *(u32*)(MQN + (size_t)r * 1024 + hh * 128 + lane * 2) = f2bf(o[0]) | (f2bf(o[1]) << 16);
                    }
                    for (int it = blockIdx.x * 8 + wv; it < SEQ * 8; it += gridDim.x * 8) {
                        const int r = it >> 3, hh = it & 7;
                        u16* qp = PROJ + (size_t)r * PP + C_DSAQ + hh * 128;
                        for (int i = lane; i < 128; i += 64) qs[i] = bf2f(qp[i]);
                        const u32* mrow = BITM + (size_t)r * 128;
                        float o[2];
                        wave_attn<2>(sc, r + 1,
                            [&](int s) { if (!((mrow[s >> 5] >> (s & 31)) & 1u)) return -INFINITY;
                                         return dot_q(qs, PROJ + (size_t)s * PP + C_DSAK + hh * 128, 128) * 0.08838834764831845f + p.rel_bias[relbucket(r - s) * 16 + hh]; },
                            [&](int s) { return PROJ + (size_t)s * PP + C_DSAV + hh * 128; }, o, lane);
                        *(u32*)(qp + lane * 2) = f2bf(o[0]) | (f2bf(o[1]) << 16);
                    }
                    float* qn = wsl + 4096;
                    float* pcs = wsl;
                    int* blist = (int*)(wsl + 1024);
                    for (int it = blockIdx.x * 8 + wv; it < SEQ * 2; it += gridDim.x * 8) {
                        const int r = it >> 1, gg = it & 1, t = r;
                        u16* qp = PROJ + (size_t)r * PP + C_NSAQ + gg * 512;
                        for (int i = lane; i < 512; i += 64) qn[i] = bf2f(qp[i]);
                        const int ncv = t >= 31 ? min((t - 31) / 16 + 1, 255) : 0;
                        float oc[4][2], osl[4][2], ow[4][2];
                        float imp = 0.f;
                        for (int hg = 0; hg < 4; ++hg) {
                            const float sum = wave_attn<2>(pcs, ncv,
                                [&](int c) { return dot_q(qn + hg * 128, KCMP + (size_t)(c * 2 + gg) * 128, 128) * 0.08838834764831845f; },
                                [&](int c) { return VCMP + (size_t)(c * 2 + gg) * 128; }, oc[hg], lane);
                            if (ncv > 0) {
                                const float inv = 1.f / sum;
                                for (int c = 4 * lane - 1; c <= 4 * lane + 3; ++c) if (c >= 0 && c < ncv) imp += pcs[c] * inv;
                            }
                        }
                        const int blk = t >> 6;
                        float v = imp;
                        if (lane == 0 || lane == blk || lane == blk - 1) v = INFINITY;
                        if (lane > blk) v = -INFINITY;
                        int rank = 0;
                        for (int jj = 0; jj < 64; ++jj) { const float vv = __shfl(v, jj); rank += (vv > v || (vv == v && jj < lane)) ? 1 : 0; }
                        const bool sel = rank < 16 && lane <= blk;
                        const u64 smask = __ballot(sel);
                        const int nsel = __popcll(smask);
                        if (sel) blist[__popcll(smask & ((1ull << lane) - 1ull))] = lane;
                        const int nw = min(t + 1, 512);
                        for (int hg = 0; hg < 4; ++hg) {
                            const int hd = 8 + gg * 4 + hg;
                            wave_attn<2>(pcs, nsel * 64,
                                [&](int i) { const int s = blist[i >> 6] * 64 + (i & 63); if (s > t) return -INFINITY;
                                             return dot_q(qn + hg * 128, PROJ + (size_t)s * PP + C_NKS + gg * 128, 128) * 0.08838834764831845f + p.rel_bias[relbucket(t - s) * 16 + hd]; },
                                [&](int i) { const int s = blist[i >> 6] * 64 + (i & 63); return PROJ + (size_t)s * PP + C_NVS + gg * 128; }, osl[hg], lane);
                            wave_attn<2>(pcs, nw,
                                [&](int i) { const int s = t - nw + 1 + i;
                                             return dot_q(qn + hg * 128, PROJ + (size_t)s * PP + C_NKW + gg * 128, 128) * 0.08838834764831845f + p.rel_bias[relbucket(t - s) * 16 + hd]; },
                                [&](int i) { const int s = t - nw + 1 + i; return PROJ + (size_t)s * PP + C_NVW + gg * 128; }, ow[hg], lane);
                        }
                        const u16* gp = PROJ + (size_t)r * PP + C_NGATE;
#pragma unroll
                        for (int hg = 0; hg < 4; ++hg) {
                            const float g0 = sigmoidf_(bf2f(gp[0 * 8 + gg * 4 + hg])), g1 = sigmoidf_(bf2f(gp[1 * 8 + gg * 4 + hg])), g2 = sigmoidf_(bf2f(gp[2 * 8 + gg * 4 + hg]));
                            const float a0 = g0 * oc[hg][0] + g1 * osl[hg][0] + g2 * ow[hg][0], a1 = g0 * oc[hg][1] + g1 * osl[hg][1] + g2 * ow[hg][1];
                            *(u32*)(qp + hg * 128 + lane * 2) = f2bf(a0) | (f2bf(a1) << 16);
                        }
                    }
                }
            PH_END
            PH_BEGIN
                for (int i = 0; i < 3; ++i) {
                    const float* Wb = p.w_branch + ((size_t)l * 3 + i) * 1024 * 1024;
                    const u16* A = i == 0 ? MQN : (i == 1 ? PROJ + C_DSAQ : PROJ + C_NSAQ);
                    const int lda = i == 0 ? 1024 : PP;
                    ngemm(lds, A, lda, SEQ, 1024, 1024,
                          [&](int k, int n) { return Wb[(size_t)k * 1024 + n]; },
                          [&](int m, int n, float v) { u16* gp = GATES + (size_t)m * 3072 + i * 1024 + n; *gp = (u16)f2bf(bf2f(*gp) * v); });
                }
            PH_END
            PH_BEGIN
                for (size_t e = (size_t)blockIdx.x * 512 + tid; e < (size_t)SEQ * 1024; e += (size_t)gridDim.x * 512) {
                    const size_t m = e >> 10, n = e & 1023; const u16* gp = GATES + m * 3072 + n;
                    MERGED[((size_t)b * SEQ + m) * 1024 + n] = (u16)f2bf(bf2f(gp[0]) + bf2f(gp[1024]) + bf2f(gp[2048]));
                }
            PH_END
        }
        PH_BEGIN
            { const float* Wo = p.w_out + (size_t)l * 1024 * 1024;
              ngemm(lds, MERGED, 1024, T, 1024, 1024, [&](int k, int n) { return Wo[(size_t)k * 1024 + n]; },
                    [&](int m, int n, float v) { F32[(size_t)m * 1024 + n] = v; }); }
        PH_END
        PH_BEGIN
            ph_resid_norm(F32, g + 1 * 1024, xin, p.out, g + 2 * 1024, HB, T);
        PH_END
        PH_BEGIN
            { const float* Wq = p.cwq + (size_t)l * 1024 * 1024;
              ngemm(lds, HB, 1024, T, 1024, 1024, [&](int k, int n) { return Wq[(size_t)k * 1024 + n]; },
                    [&](int m, int n, float v) { CQ[(size_t)m * 1024 + n] = (u16)f2bf(v); }); }
        PH_END
        PH_BEGIN
            {
                float* sc = wsl; float* qs = wsl + 4096;
                for (int it = blockIdx.x * 8 + wv; it < T * 4; it += gridDim.x * 8) {
                    const int r = it >> 2, hh = it & 3, bb = r / SEQ;
                    u16* qp = CQ + (size_t)r * 1024 + hh * 256;
                    for (int i = lane; i < 256; i += 64) qs[i] = bf2f(qp[i]);
                    float o[4];
                    wave_attn<4>(sc, 256,
                        [&](int m) { return dot_q(qs, CKV + (size_t)(bb * 256 + m) * 2048 + hh * 256, 256) * 0.0625f; },
                        [&](int m) { return CKV + (size_t)(bb * 256 + m) * 2048 + 1024 + hh * 256; }, o, lane);
                    uint2 w; w.x = f2bf(o[0]) | (f2bf(o[1]) << 16); w.y = f2bf(o[2]) | (f2bf(o[3]) << 16);
                    *(uint2*)(qp + lane * 4) = w;
                }
            }
        PH_END
        PH_BEGIN
            { const float* Wo = p.cwo + (size_t)l * 1024 * 1024;
              ngemm(lds, CQ, 1024, T, 1024, 1024, [&](int k, int n) { return Wo[(size_t)k * 1024 + n]; },
                    [&](int m, int n, float v) { F32[(size_t)m * 1024 + n] = v; }); }
        PH_END
        PH_BEGIN
            ph_resid_norm(F32, g + 4 * 1024, p.out, p.out, g + 5 * 1024, HB, T);
        PH_END
        PH_BEGIN
            { const float* W1 = p.w1 + (size_t)l * 1024 * 4096;
              ngemm(lds, HB, 1024, T, 4096, 1024, [&](int k, int n) { return W1[(size_t)k * 4096 + n]; },
                    [&](int m, int n, float v) { const float rr = fmaxf(v, 0.f); U[(size_t)m * 4096 + n] = (u16)f2bf(rr * rr); }); }
        PH_END
        PH_BEGIN
            { const float* W2 = p.w2 + (size_t)l * 4096 * 1024;
              ngemm(lds, U, 4096, T, 1024, 4096, [&](int k, int n) { return W2[(size_t)k * 1024 + n]; },
                    [&](int m, int n, float v) { F32[(size_t)m * 1024 + n] = v; }); }
        PH_END
        PH_BEGIN
            ph_resid_norm(F32, g + 6 * 1024, p.out, p.out, nullptr, HB, T);
        PH_END
    }
}

constexpr int NPHASES = DEPTH * (1 + NB * 7 + 9);

extern "C" void kernel_launch(void* const* d_in, const int* in_sizes, int n_in, void* d_out, int out_size, void* d_ws, size_t ws_size,
                              hipStream_t stream) {
    (void)in_sizes; (void)out_size;
    if (n_in != 20 || ws_size < WS_END) { fprintf(stderr, "kernel_launch: bad n_in %d or ws_size %zu < %zu\n", n_in, ws_size, (size_t)WS_END); return; }
    static int grid = 0;
    if (!grid) {
        hipError_t e = hipFuncSetAttribute((const void*)mega, hipFuncAttributeMaxDynamicSharedMemorySize, LDS_BYTES);
        if (e != hipSuccess) fprintf(stderr, "hipFuncSetAttribute: %s\n", hipGetErrorString(e));
        int dev = 0, cus = 0, per_cu = 0;
        (void)hipGetDevice(&dev);
        (void)hipDeviceGetAttribute(&cus, hipDeviceAttributeMultiprocessorCount, dev);
        (void)hipOccupancyMaxActiveBlocksPerMultiprocessor(&per_cu, mega, 512, LDS_BYTES);
        if (cus <= 0) cus = 256;
        if (per_cu < 1) { fprintf(stderr, "occupancy query says %d blocks per CU\n", per_cu); per_cu = 1; }
        grid = cus;
    }
    (void)hipMemsetAsync((unsigned char*)d_ws + WS_CTL, 0, CTL_BYTES, stream);
    Params p; memset(&p, 0, sizeof(p));
    p.x = (const float*)d_in[0]; p.mem = (const float*)d_in[1]; p.pos = (const int*)d_in[2]; p.rel_bias = (const float*)d_in[3];
    p.gains = (const float*)d_in[4]; p.w_in = (const float*)d_in[5]; p.qnorm = (const float*)d_in[6]; p.kvnorm = (const float*)d_in[7];
    p.w_uq = (const float*)d_in[8]; p.w_ukv = (const float*)d_in[9]; p.cmp_pos = (const float*)d_in[10]; p.cmp_w1 = (const float*)d_in[11];
    p.cmp_w2 = (const float*)d_in[12]; p.w_branch = (const float*)d_in[13]; p.w_out = (const float*)d_in[14]; p.cwq = (const float*)d_in[15];
    p.cwkv = (const float*)d_in[16]; p.cwo = (const float*)d_in[17]; p.w1 = (const float*)d_in[18]; p.w2 = (const float*)d_in[19];
    p.out = (float*)d_out; p.ws = (unsigned char*)d_ws;
#if MK_MULTI_LAUNCH
    for (int ph = 0; ph < NPHASES; ++ph) { p.ph_lo = ph; p.ph_hi = ph + 1; hipLaunchKernelGGL(mega, dim3(grid), dim3(512), LDS_BYTES, stream, p); }
#else
    p.ph_lo = 0; p.ph_hi = NPHASES;
    hipLaunchKernelGGL(mega, dim3(grid), dim3(512), LDS_BYTES, stream, p);
#endif
}
```

```cpp
#include <hip/hip_runtime.h>
#include <cstdio>
#include <cstdint>
#include <cstring>

#ifndef MK_MULTI_LAUNCH
#define MK_MULTI_LAUNCH 0
#endif

typedef unsigned short u16;
typedef unsigned int u32;
typedef unsigned long long u64;
#define DI __device__ __forceinline__
#define LAS __attribute__((address_space(3)))
#define GAS __attribute__((address_space(1)))

constexpr int T = 16384, SEQ = 4096, NB = 4, DM = 1024, DEPTH = 2, D_IN = 10016;
constexpr int PP = 7168;
constexpr int C_QLAT = 0, C_KVLAT = 384, C_KROPE = 640, C_IDXK = 704, C_IDXQ = 768, C_DSAQ = 1280, C_DSAK = 2304, C_DSAV = 3328,
              C_NSAQ = 4352, C_NKC = 5376, C_NVC = 5632, C_NKS = 5888, C_NVS = 6144, C_NKW = 6400, C_NVW = 6656, C_IDXW = 6912,
              C_NGATE = 6920, C_END = 6944, C_NSAO = 0;
constexpr float EPS = 1e-6f;

constexpr size_t MiB = 1u << 20;
constexpr size_t WS_CTL = 0, CTL_BYTES = 1 * MiB;
constexpr size_t WS_WB = 1 * MiB;
constexpr size_t WT_IN = WS_WB, WT_UQ = WS_WB + 20 * MiB, WT_UKV = WS_WB + 21 * MiB + 256 * 1024, WT_C1 = WS_WB + 22 * MiB + 256 * 1024,
                 WT_BR = WS_WB + 26 * MiB + 256 * 1024, WT_OUT = WS_WB + 32 * MiB + 256 * 1024, WT_CKV = WS_WB + 34 * MiB + 256 * 1024;
constexpr size_t WT_CQ = WS_WB, WT_CO = WS_WB + 2 * MiB, WT_W1 = WS_WB + 4 * MiB, WT_W2 = WS_WB + 12 * MiB;
constexpr size_t WS_HB = 41 * MiB;
constexpr size_t WS_MEMN = 73 * MiB;
constexpr size_t WS_CKV = 75 * MiB;
constexpr size_t WS_ROPE = 79 * MiB;
constexpr size_t WS_A = 83 * MiB;
constexpr size_t WS_MERGED = WS_A;
constexpr size_t WS_PROJ = WS_A + 32 * MiB;
constexpr size_t WS_GATES = WS_A + 88 * MiB;
constexpr size_t WS_QNRM = WS_A + 112 * MiB;
constexpr size_t WS_KVNRM = WS_A + 115 * MiB;
constexpr size_t WS_MQN = WS_A + 117 * MiB;
constexpr size_t WS_MQR = WS_A + 125 * MiB;
constexpr size_t WS_MKN = WS_A + 129 * MiB;
constexpr size_t WS_MV = WS_A + 137 * MiB;
constexpr size_t WS_MKR = WS_A + 145 * MiB;
constexpr size_t WS_CBK = WS_A + 146 * MiB;
constexpr size_t WS_CH = WS_A + 154 * MiB;
constexpr size_t WS_KCMP = WS_A + 155 * MiB;
constexpr size_t WS_VCMP = WS_A + 155 * MiB + 512 * 1024;
constexpr size_t WS_BITM = WS_A + 156 * MiB;
constexpr size_t WS_CPART = WS_A + 158 * MiB;
constexpr size_t WS_SCORE = WS_A + 166 * MiB;
constexpr size_t WS_PART = WS_A + 200 * MiB;
constexpr size_t PART_BYTES = 65536 + 2048;
constexpr size_t WS_SELX = WS_PART + (size_t)192 * 2 * PART_BYTES;
constexpr size_t WS_F32 = WS_A + 32 * MiB;
constexpr size_t WS_CQ = WS_A + 96 * MiB;
constexpr size_t WS_U = WS_A + 96 * MiB;
constexpr size_t WS_END = WS_A + 226 * MiB;

constexpr int PROBE_REP_H[17] = {1, 1, 1, 1, 1, 1, 1, 1, 1, 1, 1, 1, 1, 1, 1, 1, 1};
constexpr int LDS_BYTES = 152 * 1024;
constexpr int LDS_MISC = 147456;
constexpr int WSLOT = 18432;

DI float bf2f(u32 h) { return __uint_as_float(h << 16); }
DI u32 f2bf(float f) { u32 u = __float_as_uint(f); return (u + 0x7fffu + ((u >> 16) & 1u)) >> 16; }
typedef float f32x2_g __attribute__((ext_vector_type(2)));
typedef __bf16 bf16x2_g __attribute__((ext_vector_type(2)));
DI u32 pg8_pk2(float lo, float hi) { f32x2_g v = {lo, hi}; bf16x2_g b = __builtin_convertvector(v, bf16x2_g); return __builtin_bit_cast(u32, b); }
DI float wave_sum(float v) { for (int o = 32; o; o >>= 1) v += __shfl_xor(v, o); return v; }
DI float wave_max(float v) { for (int o = 32; o; o >>= 1) v = fmaxf(v, __shfl_xor(v, o)); return v; }
DI float sigmoidf_(float x) { return 1.f / (1.f + __expf(-x)); }
DI float gelu_tanh(float x) { return 0.5f * x * (1.f + tanhf(0.7978845608028654f * (x + 0.044715f * x * x * x))); }

__device__ const unsigned char BUCKET_TAB[128] = {
    0, 1, 2, 3, 4, 5, 6, 7, 8, 9, 10, 11, 12, 13, 14, 15, 16, 16, 16, 17, 17, 18, 18, 18, 19, 19, 19, 20, 20, 20, 20, 21, 21, 21, 21, 22, 22, 22, 22, 22,
    23, 23, 23, 23, 23, 23, 24, 24, 24, 24, 24, 24, 25, 25, 25, 25, 25, 25, 25, 26, 26, 26, 26, 26, 26, 26, 26, 27, 27, 27, 27, 27, 27, 27, 27, 27, 27,
    28, 28, 28, 28, 28, 28, 28, 28, 28, 28, 29, 29, 29, 29, 29, 29, 29, 29, 29, 29, 29, 29, 30, 30, 30, 30, 30, 30, 30, 30, 30, 30, 30, 30, 30, 30,
    31, 31, 31, 31, 31, 31, 31, 31, 31, 31, 31, 31, 31, 31, 31};
DI int relbucket(int n) { return n >= 127 ? 31 : (int)BUCKET_TAB[n < 0 ? 0 : n]; }

DI int proj_src(int n) {
    if (n < 704) return n;
    if (n < 768) return 4288 + (n - 704);
    if (n < 1280) return 3776 + (n - 768);
    if (n < 4352) return 704 + (n - 1280);
    if (n < 5376) return 4360 + (n - 4352);
    if (n < 6912) return 5384 + (n - 5376);
    if (n < 6920) return 4352 + (n - 6912);
    if (n < 6944) return 6920 + (n - 6920);
    return -1;
}

#define XB_TMO      128
#define XB_XCNT(j)  (256  + 64 * (j))
#define XB_XSUB(j)  (1280 + 64 * (j))
#define XB_XGEN(j)  (2304 + 64 * (j))
#define XB_TOP      3328
#define XB_TOPGEN   3392
#define XCD_BAR_WORDS 3456
#define XB_SPIN_CAP (1u << 21)
DI unsigned xb_ld(unsigned* p)              { return __hip_atomic_load(p, __ATOMIC_RELAXED, __HIP_MEMORY_SCOPE_AGENT); }
DI unsigned xb_add(unsigned* p, unsigned v) { return __hip_atomic_fetch_add(p, v, __ATOMIC_RELAXED, __HIP_MEMORY_SCOPE_AGENT); }
DI unsigned xb_xcc_id() { return (unsigned)__builtin_amdgcn_s_getreg((3 << 11) | 20) & 0xFu; }
#define XB_SPIN(cond, bar) do { unsigned _sp = 0; while (cond) { __builtin_amdgcn_s_sleep(1); \
    if ((++_sp & 255u) == 0u) { if (xb_ld(&(bar)[XB_TMO])) break; if (_sp > XB_SPIN_CAP) { atomicAdd(&(bar)[XB_TMO], 1u); break; } } } } while (0)
struct XcdBarrier { unsigned* bar; unsigned x; volatile LAS unsigned* st; };
DI XcdBarrier xcd_barrier_post(unsigned* bar, volatile LAS unsigned* st) {
    XcdBarrier b; b.bar = bar; b.x = xb_xcc_id(); b.st = st;
    if (threadIdx.x == 0) (void)xb_add(&bar[XB_XCNT(b.x)], 1u);
    return b;
}
DI void xcd_barrier_complete(unsigned* bar, unsigned x, unsigned& nloc, unsigned& nx) {
    const unsigned G = gridDim.x * gridDim.y * gridDim.z;
    unsigned sum, cnt, mine, sp = 0u;
    for (;;) {
        sum = 0u; cnt = 0u; mine = 0u;
#pragma unroll
        for (unsigned j = 0; j < 16; ++j) { const unsigned c = xb_ld(&bar[XB_XCNT(j)]); sum += c; cnt += (c > 0u) ? 1u : 0u; mine = (j == x) ? c : mine; }
        if (sum == G) break;
        __builtin_amdgcn_s_sleep(1);
        if ((++sp & 255u) == 0u) { if (xb_ld(&bar[XB_TMO])) break; if (sp > XB_SPIN_CAP) { atomicAdd(&bar[XB_TMO], 1u); break; } }
    }
    nloc = mine > 0u ? mine : 1u; nx = cnt > 0u ? cnt : 1u;
}
DI void xcd_barrier(const XcdBarrier& b) {
    asm volatile("s_waitcnt vmcnt(0)" ::: "memory");
    __syncthreads();
    if (threadIdx.x == 0) {
        unsigned* bar = b.bar;
        __builtin_amdgcn_s_waitcnt(0);
        unsigned nloc = b.st[0], nx = b.st[1];
        if (nloc == 0u) { xcd_barrier_complete(bar, b.x, nloc, nx); b.st[0] = nloc; b.st[1] = nx; }
        const unsigned old = xb_add(&bar[XB_XSUB(b.x)], 1u);
        const unsigned gen = old / nloc;
        if (old + 1u == (gen + 1u) * nloc) {
            __builtin_amdgcn_fence(__ATOMIC_RELEASE, "agent");
            asm volatile("s_waitcnt vmcnt(0)" ::: "memory");
            const unsigned og = xb_add(&bar[XB_TOP], 1u);
            const unsigned tg = og / nx;
            if (og + 1u == (tg + 1u) * nx) xb_add(&bar[XB_TOPGEN], 1u);
            else XB_SPIN(xb_ld(&bar[XB_TOPGEN]) == tg, bar);
            __builtin_amdgcn_fence(__ATOMIC_ACQUIRE, "agent");
            xb_add(&bar[XB_XGEN(b.x)], 1u);
            asm volatile("s_waitcnt vmcnt(0)" ::: "memory");
        } else {
            XB_SPIN(xb_ld(&bar[XB_XGEN(b.x)]) == gen, bar);
            __builtin_amdgcn_fence(__ATOMIC_ACQUIRE, "agent");
            asm volatile("s_waitcnt vmcnt(0)" ::: "memory");
        }
    }
    __syncthreads();
}

struct Params {
    const float* x; const float* mem; const int* pos; const float* rel_bias; const float* gains; const float* w_in;
    const float* qnorm; const float* kvnorm; const float* w_uq; const float* w_ukv; const float* cmp_pos; const float* cmp_w1;
    const float* cmp_w2; const float* w_branch; const float* w_out; const float* cwq; const float* cwkv; const float* cwo;
    const float* w1; const float* w2;
    float* out; unsigned char* ws;
    int ph_lo, ph_hi;
};

DI u64 ldp(unsigned char* lds, int idx) {
    volatile LAS u32* t = (volatile LAS u32*)(lds + LDS_MISC + 64);
    const u32 lo = __builtin_amdgcn_readfirstlane(t[2 * idx]), hi = __builtin_amdgcn_readfirstlane(t[2 * idx + 1]);
    return ((u64)hi << 32) | lo;
}
DI int opaque_tid(int wid_s) { int t; asm volatile("v_mbcnt_lo_u32_b32 %0, -1, 0\n\tv_mbcnt_hi_u32_b32 %0, -1, %0" : "=v"(t)); return (wid_s << 6) | t; }
template <class BF, class EF>
DI void ngemm(unsigned char* lds, const u16* A, int lda, int M, int N, int K, BF bfn, EF efn, int tid) {
    float* As = (float*)lds;
    float* Bs = As + 16 * 132;
    const int tx = tid & 31, ty = tid >> 5;
    const int ntn = N / 128, ntiles = (M / 128) * ntn;
    for (int tile = blockIdx.x; tile < ntiles; tile += gridDim.x) {
        const int m0 = (tile / ntn) * 128, n0 = (tile % ntn) * 128;
        float acc[8][4];
#pragma unroll
        for (int i = 0; i < 8; ++i)
#pragma unroll
            for (int j = 0; j < 4; ++j) acc[i][j] = 0.f;
        for (int k0 = 0; k0 < K; k0 += 16) {
            {
                const int i = tid >> 2, kq = (tid & 3) * 4;
                const uint2 v = *(const uint2*)(A + (size_t)(m0 + i) * lda + k0 + kq);
                As[(kq + 0) * 132 + i] = bf2f(v.x & 0xffffu); As[(kq + 1) * 132 + i] = bf2f(v.x >> 16);
                As[(kq + 2) * 132 + i] = bf2f(v.y & 0xffffu); As[(kq + 3) * 132 + i] = bf2f(v.y >> 16);
                const int kk = tid >> 5, nq = (tid & 31) * 4;
#pragma unroll
                for (int j = 0; j < 4; ++j) Bs[kk * 132 + nq + j] = bfn(k0 + kk, n0 + nq + j);
            }
            __syncthreads();
#pragma unroll 2
            for (int kk = 0; kk < 16; ++kk) {
                float a[8], b[4];
#pragma unroll
                for (int i = 0; i < 8; ++i) a[i] = As[kk * 132 + ty * 8 + i];
#pragma unroll
                for (int j = 0; j < 4; ++j) b[j] = Bs[kk * 132 + tx * 4 + j];
#pragma unroll
                for (int i = 0; i < 8; ++i)
#pragma unroll
                    for (int j = 0; j < 4; ++j) acc[i][j] = fmaf(a[i], b[j], acc[i][j]);
            }
            __syncthreads();
        }
#pragma unroll
        for (int i = 0; i < 8; ++i)
#pragma unroll
            for (int j = 0; j < 4; ++j) efn(m0 + ty * 8 + i, n0 + tx * 4 + j, acc[i][j]);
    }
}

DI void ph_norm_rows(const float* src, const float* g, u16* dst, int rows, int tid) {
    typedef float f4 __attribute__((ext_vector_type(4)));
    const int lane = tid & 63, wv = tid >> 6;
    for (int r = blockIdx.x * 8 + wv; r < rows; r += gridDim.x * 8) {
        const f4* s = (const f4*)(src + (size_t)r * 1024) + lane;
        f4 v[4]; float ss = 0.f;
#pragma unroll
        for (int i = 0; i < 4; ++i) { v[i] = s[64 * i]; ss += (v[i][0] * v[i][0] + v[i][1] * v[i][1]) + (v[i][2] * v[i][2] + v[i][3] * v[i][3]); }
        ss = wave_sum(ss);
        const float rs = rsqrtf(ss * (1.f / 1024.f) + EPS);
        uint2* d = (uint2*)(dst + (size_t)r * 1024) + lane;
#pragma unroll
        for (int i = 0; i < 4; ++i) { const f4 gg = ((const f4*)g)[lane + 64 * i]; uint2 w; w.x = pg8_pk2(v[i][0] * rs * gg[0], v[i][1] * rs * gg[1]); w.y = pg8_pk2(v[i][2] * rs * gg[2], v[i][3] * rs * gg[3]); d[64 * i] = w; }
    }
}
DI void ph_resid_norm(const float* f, const float* gpost, const float* xin, float* xout, const float* gnext, u16* hb, int rows, int tid) {
    typedef float f4 __attribute__((ext_vector_type(4)));
    const int lane = tid & 63, wv = tid >> 6;
    for (int r = blockIdx.x * 8 + wv; r < rows; r += gridDim.x * 8) {
        const f4* s = (const f4*)(f + (size_t)r * 1024) + lane;
        const f4* xi = (const f4*)(xin + (size_t)r * 1024) + lane;
        f4 v[4], x[4]; float ss = 0.f;
#pragma unroll
        for (int i = 0; i < 4; ++i) { v[i] = s[64 * i]; x[i] = xi[64 * i]; ss += (v[i][0] * v[i][0] + v[i][1] * v[i][1]) + (v[i][2] * v[i][2] + v[i][3] * v[i][3]); }
        ss = wave_sum(ss);
        const float rs = rsqrtf(ss * (1.f / 1024.f) + EPS);
        float s2 = 0.f;
        f4* xo = (f4*)(xout + (size_t)r * 1024) + lane;
#pragma unroll
        for (int i = 0; i < 4; ++i) { const f4 gg = ((const f4*)gpost)[lane + 64 * i]; x[i] = x[i] + v[i] * rs * gg; xo[64 * i] = x[i];
            s2 += (x[i][0] * x[i][0] + x[i][1] * x[i][1]) + (x[i][2] * x[i][2] + x[i][3] * x[i][3]); }
        if (gnext) {
            s2 = wave_sum(s2);
            const float r2 = rsqrtf(s2 * (1.f / 1024.f) + EPS);
            uint2* d = (uint2*)(hb + (size_t)r * 1024) + lane;
#pragma unroll
            for (int i = 0; i < 4; ++i) { const f4 gg = ((const f4*)gnext)[lane + 64 * i]; uint2 w; w.x = pg8_pk2(x[i][0] * r2 * gg[0], x[i][1] * r2 * gg[1]); w.y = pg8_pk2(x[i][2] * r2 * gg[2], x[i][3] * r2 * gg[3]); d[64 * i] = w; }
        }
    }
}

template <int NV, class SF, class VF>
DI float wave_attn(float* sc, int n, SF scoref, VF vrowf, float (&out)[NV], int lane) {
#pragma unroll
    for (int j = 0; j < NV; ++j) out[j] = 0.f;
    float m = -INFINITY;
#pragma unroll 1
    for (int i = lane; i < n; i += 64) { asm volatile("" ::: "memory"); const float s = scoref(i); sc[i] = s; m = fmaxf(m, s); }
    m = wave_max(m);
    if (!(m > -INFINITY)) return 0.f;
    float sum = 0.f;
    for (int i = lane; i < n; i += 64) { const float p = __expf(sc[i] - m); sc[i] = p; sum += p; }
    sum = wave_sum(sum);
    float acc[NV];
#pragma unroll
    for (int j = 0; j < NV; ++j) acc[j] = 0.f;
#pragma unroll 4
    for (int i = 0; i < n; ++i) {
        const float p = sc[i];
        if (p != 0.f) {
            const u16* v = vrowf(i);
            if constexpr (NV == 2) { const u32 w = *(const u32*)(v + lane * 2); acc[0] = fmaf(p, bf2f(w & 0xffffu), acc[0]); acc[1] = fmaf(p, bf2f(w >> 16), acc[1]); }
            else { const uint2 w = *(const uint2*)(v + lane * 4); acc[0] = fmaf(p, bf2f(w.x & 0xffffu), acc[0]); acc[1] = fmaf(p, bf2f(w.x >> 16), acc[1]);
                   acc[2 % NV] = fmaf(p, bf2f(w.y & 0xffffu), acc[2 % NV]); acc[3 % NV] = fmaf(p, bf2f(w.y >> 16), acc[3 % NV]); }
        }
    }
    const float inv = 1.f / sum;
#pragma unroll
    for (int j = 0; j < NV; ++j) out[j] = acc[j] * inv;
    return sum;
}
DI float dot_q(const float* q, const u16* k, int n) {
    float a = 0.f;
#pragma unroll 4
    for (int d = 0; d < n; d += 8) {
        const uint4 w = *(const uint4*)(k + d);
        a = fmaf(q[d + 0], bf2f(w.x & 0xffffu), a); a = fmaf(q[d + 1], bf2f(w.x >> 16), a);
        a = fmaf(q[d + 2], bf2f(w.y & 0xffffu), a); a = fmaf(q[d + 3], bf2f(w.y >> 16), a);
        a = fmaf(q[d + 4], bf2f(w.z & 0xffffu), a); a = fmaf(q[d + 5], bf2f(w.z >> 16), a);
        a = fmaf(q[d + 6], bf2f(w.w & 0xffffu), a); a = fmaf(q[d + 7], bf2f(w.w >> 16), a);
    }
    return a;
}

namespace pg8 {
typedef short bf16x8 __attribute__((ext_vector_type(8)));
typedef float f32x4 __attribute__((ext_vector_type(4)));
typedef unsigned u32x4 __attribute__((ext_vector_type(4)));
typedef float f32x2_t __attribute__((ext_vector_type(2)));
typedef __bf16 bf16x2_t __attribute__((ext_vector_type(2)));
constexpr int BM = 256, BK = 64, HALF = 128, HTB = HALF * BK * 2, STAGE_BYTES = 8 * HTB, NXCD = 8, WGM = 8;
DI u32 pk2(float lo, float hi) { f32x2_t v = {lo, hi}; bf16x2_t b = __builtin_convertvector(v, bf16x2_t); return __builtin_bit_cast(u32, b); }
__host__ __device__ __forceinline__ int lds_byte(int r, int c) { const int st = (r >> 4) * 2 + (c >> 5), rr = r & 15, cc = c & 31, ob = rr * 64 + cc * 2; return st * 1024 + (ob ^ (((ob >> 9) & 1) << 5)); }
__host__ __device__ __forceinline__ void stage_rc(int b, int& R, int& C) { const int st = b / 1024, sb = b % 1024, swz = sb ^ (((sb >> 9) & 1) << 5); R = (st >> 1) * 16 + swz / 64; C = (st & 1) * 32 + (swz % 64) / 2; }
__host__ __device__ __forceinline__ int perm32(int rho) { const int n = rho >> 4, i = rho & 15; return 8 * (i >> 2) + 4 * n + (i & 3); }

struct Unit { const char* A; const char* B; int pm, pn; };

struct Sched1 {
    const char* A; const char* B; size_t sA, sB; int nM, nN, nwg, G, c;
    DI void init(const void* A_, int lda, const void* B_, int ldb, int M, int N, int rot) {
        A = (const char*)A_; B = (const char*)B_; sA = (size_t)BM * lda * 2; sB = (size_t)BM * ldb * 2; nM = M / BM; nN = N / BM; nwg = nM * nN; G = gridDim.x;
        c = (int)((blockIdx.x + G - (rot % G)) % G);
    }
    DI bool next(int i, Unit& u) const {
        const long L = (long)i * G + c; if (L >= nwg) return false;
        int wgid = (int)L; { const int q = nwg / NXCD, r = nwg % NXCD, xcd = wgid % NXCD, off = wgid / NXCD; wgid = (xcd < r ? xcd * (q + 1) : r * (q + 1) + (xcd - r) * q) + off; }
        const int nig = WGM * nN, gid = wgid / nig, fm = gid * WGM, gsz = (nM - fm) < WGM ? (nM - fm) : WGM;
        u.pm = fm + ((wgid % nig) % gsz); u.pn = (wgid % nig) / gsz; u.A = A + (size_t)u.pm * sA; u.B = B + (size_t)u.pn * sB; return true;
    }
};
struct SchedOne { const char* A; const char* B; int pm, pn; DI bool next(int i, Unit& u) const { if (i) return false; u.pm = pm; u.pn = pn; u.A = A; u.B = B; return true; } };
struct SchedCmp {
    const char* A; const char* B; int G, c;
    DI void init(const void* A_, const void* B_, int rot) { A = (const char*)A_; B = (const char*)B_; G = gridDim.x; c = (int)((blockIdx.x + G - (rot % G)) % G); }
    DI bool next(int i, Unit& u) const {
        const int L = i * G + c; if (L >= 32) return false;
        u.pm = L; u.pn = 0; u.A = A + (size_t)L * 256 * 512 * 2; u.B = B + (size_t)(L >> 1) * 256 * 512 * 2; return true;
    }
};

template <class F> struct EpiB16 {
    static constexpr bool PERM = true; F f;
    DI void operator()(const f32x4 (&acc)[2][2][4][2], const Unit& u, int wr, int wc, int fr, int fq) const {
        const int row0 = u.pm * BM + wr * 64 + fr, col0 = u.pn * BM + wc * 32 + 8 * fq;
#pragma unroll
        for (int ai = 0; ai < 2; ++ai)
#pragma unroll
            for (int m = 0; m < 4; ++m)
#pragma unroll
                for (int bj = 0; bj < 2; ++bj) f(row0 + ai * HALF + m * 16, col0 + bj * HALF, acc[ai][bj][m][0], acc[ai][bj][m][1]);
    }
};
template <class F> struct EpiF32 {
    static constexpr bool PERM = false; F f;
    DI void operator()(const f32x4 (&acc)[2][2][4][2], const Unit& u, int wr, int wc, int fr, int fq) const {
        const int row0 = u.pm * BM + wr * 64 + fr, col0 = u.pn * BM + wc * 32 + 4 * fq;
#pragma unroll
        for (int ai = 0; ai < 2; ++ai)
#pragma unroll
            for (int m = 0; m < 4; ++m)
#pragma unroll
                for (int bj = 0; bj < 2; ++bj)
#pragma unroll
                    for (int n = 0; n < 2; ++n) f(row0 + ai * HALF + m * 16, col0 + bj * HALF + n * 16, acc[ai][bj][m][n]);
    }
};
template <class F> DI EpiB16<F> epi_b16(F f) { return EpiB16<F>{f}; }
template <class F> DI EpiF32<F> epi_f32(F f) { return EpiF32<F>{f}; }
DI u32x4 pack8(f32x4 a, f32x4 b) { u32x4 w; w.x = pk2(a[0], a[1]); w.y = pk2(a[2], a[3]); w.z = pk2(b[0], b[1]); w.w = pk2(b[2], b[3]); return w; }

template <class Epi, class Sched, bool ALIGN_EPI = true, bool SP2 = true>
DI void gemm_phase(LAS unsigned char* lds, const int K, const int lda, const int ldb, const Sched& S, const Epi& E, const int wid_s) {
    const int tid = opaque_tid(wid_s);
    const int wid = __builtin_amdgcn_readfirstlane(tid >> 6), lane = tid & 63, wr = wid >> 2, wc = wid & 3, fr = lane & 15, fq = lane >> 4;
    const int nt = K / BK;
    unsigned voffA[2], voffB[2];
#pragma unroll
    for (int i = 0; i < 2; ++i) { int R, C; stage_rc(tid * 16 + i * 8192, R, C); const int Rb = Epi::PERM ? ((R & ~31) + perm32(R & 31)) : R;
        voffA[i] = (unsigned)(R * lda + C) * 2u; voffB[i] = (unsigned)(Rb * ldb + C) * 2u; }
    const size_t kstep = (size_t)(BK * 2);
    const size_t hstepA = (size_t)HALF * lda * 2, hstepB = (size_t)HALF * ldb * 2;
    const unsigned ldsw = (unsigned)wid * 1024u;
    const int aoff = lds_byte(wr * 64 + fr, fq * 8), boff = lds_byte(wc * 32 + fr, fq * 8);
#define PG8_SA(b, h) (((b) * 2 + (h)) * HTB)
#define PG8_SB(b, h) ((4 + (b) * 2 + (h)) * HTB)
#define PG8_STAGE(bufoff, gbase, voff) do { _Pragma("unroll") for (int _i = 0; _i < 2; ++_i) \
        __builtin_amdgcn_global_load_lds((const unsigned*)((const char*)(gbase) + (voff)[_i]), (LAS unsigned*)(lds + (bufoff) + ldsw + _i * 8192), 16, 0, 0); } while (0)
#define PG8_LDA(dst, b, h) do { _Pragma("unroll") for (int m = 0; m < 4; ++m) _Pragma("unroll") for (int k = 0; k < 2; ++k) dst[m][k] = *(const LAS bf16x8*)(lds + PG8_SA(b, h) + aoff + m * 2048 + k * 1024); } while (0)
#define PG8_LDB(dst, b, h) do { _Pragma("unroll") for (int n = 0; n < 2; ++n) _Pragma("unroll") for (int k = 0; k < 2; ++k) dst[n][k] = *(const LAS bf16x8*)(lds + PG8_SB(b, h) + boff + n * 2048 + k * 1024); } while (0)
#define PG8_MMA(ai, bj, At, Bt) do { __builtin_amdgcn_s_setprio(1); _Pragma("unroll") for (int m = 0; m < 4; ++m) _Pragma("unroll") for (int n = 0; n < 2; ++n) _Pragma("unroll") for (int k = 0; k < 2; ++k) \
        acc[ai][bj][m][n] = __builtin_amdgcn_mfma_f32_16x16x32_bf16(Bt[n][k], At[m][k], acc[ai][bj][m][n], 0, 0, 0); __builtin_amdgcn_s_setprio(0); } while (0)
#define PG8_WAIT_V(n) asm volatile("s_waitcnt vmcnt(" #n ")" ::: "memory")
#define PG8_WAIT_L(n) asm volatile("s_waitcnt lgkmcnt(" #n ")" ::: "memory")
#define PG8_BAR __builtin_amdgcn_s_barrier()
#define PG8_SCHED __builtin_amdgcn_sched_barrier(0)
    Unit cur, nxt; int ui = 0;
    if (!S.next(0, cur)) return;
    f32x4 acc[2][2][4][2];
#pragma unroll
    for (int a = 0; a < 2; ++a)
#pragma unroll
        for (int b = 0; b < 2; ++b)
#pragma unroll
            for (int m = 0; m < 4; ++m)
#pragma unroll
                for (int n = 0; n < 2; ++n) acc[a][b][m][n] = (f32x4){0.f, 0.f, 0.f, 0.f};
    bf16x8 At[4][2], B0[2][2], B1[2][2];
    const char* cA = cur.A; const char* cB = cur.B;
    if constexpr (SP2) {
        PG8_STAGE(PG8_SB(0, 0), cB, voffB); PG8_STAGE(PG8_SB(0, 1), cB + hstepB, voffB); PG8_STAGE(PG8_SA(0, 0), cA, voffA); PG8_STAGE(PG8_SA(0, 1), cA + hstepA, voffA);
        if (wr == 1) PG8_BAR;
        PG8_WAIT_V(2); PG8_BAR;
        PG8_STAGE(PG8_SB(1, 0), cB + kstep, voffB); PG8_STAGE(PG8_SA(1, 0), cA + kstep, voffA); PG8_STAGE(PG8_SB(1, 1), cB + hstepB + kstep, voffB);
        PG8_WAIT_V(6); PG8_BAR;
    } else {
        PG8_STAGE(PG8_SB(0, 0), cB, voffB); PG8_STAGE(PG8_SA(0, 0), cA, voffA); PG8_STAGE(PG8_SB(0, 1), cB + hstepB, voffB); PG8_STAGE(PG8_SA(0, 1), cA + hstepA, voffA);
        if (wr == 1) PG8_BAR;
        PG8_WAIT_V(4); PG8_BAR;
        PG8_STAGE(PG8_SB(1, 0), cB + kstep, voffB); PG8_STAGE(PG8_SA(1, 0), cA + kstep, voffA); PG8_STAGE(PG8_SB(1, 1), cB + hstepB + kstep, voffB);
        PG8_WAIT_V(6); PG8_BAR;
    }
    for (;;) {
        const bool has_next = S.next(ui + 1, nxt);
        const char* nA = has_next ? nxt.A : cA; const char* nB = has_next ? nxt.B : cB;
#pragma unroll 1
        for (int t = 0; t < nt; t += 2) {
            const bool last = (t == nt - 2);
            const char* a1 = cA + (size_t)(t + 1) * kstep;
            const char* a2 = last ? nA : cA + (size_t)(t + 2) * kstep; const char* b2 = last ? nB : cB + (size_t)(t + 2) * kstep;
            const char* a3 = a2 + kstep; const char* b3 = b2 + kstep;
            if constexpr (SP2) {
            PG8_LDB(B0, 0, 0); PG8_LDB(B1, 0, 1); PG8_SCHED; PG8_LDA(At, 0, 0); PG8_STAGE(PG8_SA(1, 1), a1 + hstepA, voffA);
            PG8_WAIT_V(8); PG8_WAIT_L(0); PG8_BAR; PG8_MMA(0, 0, At, B0); PG8_MMA(0, 1, At, B1); PG8_BAR; PG8_SCHED;
            PG8_LDA(At, 0, 1); PG8_STAGE(PG8_SB(0, 0), b2, voffB); PG8_STAGE(PG8_SB(0, 1), b2 + hstepB, voffB); PG8_STAGE(PG8_SA(0, 0), a2, voffA);
            PG8_WAIT_V(8); PG8_WAIT_L(0); PG8_BAR; PG8_MMA(1, 0, At, B0); PG8_MMA(1, 1, At, B1); PG8_BAR; PG8_SCHED;
            PG8_LDB(B0, 1, 0); PG8_LDB(B1, 1, 1); PG8_SCHED; PG8_LDA(At, 1, 0); PG8_STAGE(PG8_SA(0, 1), a2 + hstepA, voffA);
            PG8_WAIT_V(8); PG8_WAIT_L(0); PG8_BAR; PG8_MMA(0, 0, At, B0); PG8_MMA(0, 1, At, B1); PG8_BAR; PG8_SCHED;
            PG8_LDA(At, 1, 1); PG8_STAGE(PG8_SB(1, 0), b3, voffB); PG8_STAGE(PG8_SB(1, 1), b3 + hstepB, voffB); PG8_STAGE(PG8_SA(1, 0), a3, voffA);
            PG8_WAIT_V(8); PG8_WAIT_L(0); PG8_BAR; PG8_MMA(1, 0, At, B0); PG8_MMA(1, 1, At, B1); PG8_BAR; PG8_SCHED;
            } else {
            PG8_LDB(B0, 0, 0); PG8_SCHED; PG8_LDA(At, 0, 0); PG8_STAGE(PG8_SA(1, 1), a1 + hstepA, voffA);
            PG8_WAIT_L(8); PG8_BAR; PG8_WAIT_L(0); PG8_MMA(0, 0, At, B0); PG8_BAR; PG8_SCHED;
            PG8_LDB(B1, 0, 1); PG8_STAGE(PG8_SB(0, 0), b2, voffB);
            PG8_BAR; PG8_WAIT_L(0); PG8_MMA(0, 1, At, B1); PG8_BAR;
            PG8_LDA(At, 0, 1); PG8_STAGE(PG8_SA(0, 0), a2, voffA);
            PG8_BAR; PG8_WAIT_L(0); PG8_MMA(1, 0, At, B0); PG8_BAR; PG8_SCHED;
            PG8_STAGE(PG8_SB(0, 1), b2 + hstepB, voffB);
            PG8_WAIT_V(6); PG8_BAR; PG8_MMA(1, 1, At, B1); PG8_BAR;
            PG8_LDB(B0, 1, 0); PG8_SCHED; PG8_LDA(At, 1, 0); PG8_STAGE(PG8_SA(0, 1), a2 + hstepA, voffA);
            PG8_WAIT_L(8); PG8_BAR; PG8_WAIT_L(0); PG8_MMA(0, 0, At, B0); PG8_BAR; PG8_SCHED;
            PG8_LDB(B1, 1, 1); PG8_STAGE(PG8_SB(1, 0), b3, voffB);
            PG8_BAR; PG8_WAIT_L(0); PG8_MMA(0, 1, At, B1); PG8_BAR;
            PG8_LDA(At, 1, 1); PG8_STAGE(PG8_SA(1, 0), a3, voffA);
            PG8_BAR; PG8_WAIT_L(0); PG8_MMA(1, 0, At, B0); PG8_BAR; PG8_SCHED;
            PG8_STAGE(PG8_SB(1, 1), b3 + hstepB, voffB);
            PG8_WAIT_V(6); PG8_BAR; PG8_MMA(1, 1, At, B1); PG8_BAR;
            }
        }
        if constexpr (ALIGN_EPI) { if (wr == 0) PG8_BAR; }
        E(acc, cur, wr, wc, fr, fq);
        if (!has_next) break;
#pragma unroll
        for (int a = 0; a < 2; ++a)
#pragma unroll
            for (int b = 0; b < 2; ++b)
#pragma unroll
                for (int m = 0; m < 4; ++m)
#pragma unroll
                    for (int n = 0; n < 2; ++n) acc[a][b][m][n] = (f32x4){0.f, 0.f, 0.f, 0.f};
        cur = nxt; cA = nA; cB = nB; ++ui;
        if constexpr (ALIGN_EPI) { if (wr == 1) PG8_BAR; }
    }
    PG8_WAIT_V(0);
    if constexpr (!ALIGN_EPI) { if (wr == 0) PG8_BAR; }
    PG8_BAR;
#undef PG8_SA
#undef PG8_SB
#undef PG8_STAGE
#undef PG8_LDA
#undef PG8_LDB
#undef PG8_MMA
#undef PG8_WAIT_V
#undef PG8_WAIT_L
#undef PG8_BAR
#undef PG8_SCHED
}

template <class SF, class DF>
DI void conv_tile(const float* W, int ldw, int k0, int n0, SF srccol, DF dstp, float* scr, int lane) {
    const int sc = srccol(n0 + lane);
    float tv[64];
#pragma unroll
    for (int kk = 0; kk < 64; ++kk) tv[kk] = sc >= 0 ? W[(size_t)(k0 + kk) * ldw + sc] : 0.f;
#pragma unroll
    for (int kk = 0; kk < 64; ++kk) scr[kk * 65 + lane] = tv[kk];
    asm volatile("s_waitcnt lgkmcnt(0)" ::: "memory");
    const int c = lane & 7;
#pragma unroll
    for (int j = 0; j < 8; ++j) { const int n = (lane >> 3) + 8 * j; const float* s = scr + (8 * c) * 65 + n;
        u32x4 o; o.x = pk2(s[0 * 65], s[1 * 65]); o.y = pk2(s[2 * 65], s[3 * 65]); o.z = pk2(s[4 * 65], s[5 * 65]); o.w = pk2(s[6 * 65], s[7 * 65]);
        *(u32x4*)dstp(n0 + n, k0 + 8 * c) = o; }
    asm volatile("s_waitcnt lgkmcnt(0)" ::: "memory");
}
template <class SF, class DF>
DI int conv_matrix(const float* W, int ldw, int Kd, int Nd, SF srccol, DF dstp, float* scr, int lane, int gw, int ngw, int it0) {
    const int nblk = Nd / 64, nitems = (Kd / 64) * nblk;
    int first = gw - (it0 % ngw); if (first < 0) first += ngw;
    for (int it = first; it < nitems; it += ngw) conv_tile(W, ldw, (it / nblk) * 64, (it % nblk) * 64, srccol, dstp, scr, lane);
    return it0 + nitems;
}
}

namespace fa {
typedef short bf16x8 __attribute__((ext_vector_type(8)));
typedef short s16x4 __attribute__((ext_vector_type(4)));
typedef float f32x16 __attribute__((ext_vector_type(16)));
typedef float f32x4 __attribute__((ext_vector_type(4)));
typedef unsigned u32x4 __attribute__((ext_vector_type(4)));
constexpr int SHM_V = 16384;
constexpr int LDS_V = 0, LDS_K = 65536, LDS_TAB = 114688;
constexpr float LOG2E = 1.4426950408889634f;
DI int v_st(int k, int c) { return ((k >> 3) * 4 + (c >> 5)) * 512 + ((k & 7) * 32 + (c & 31)) * 2; }
DI int v_rd_base(int lane) { return ((lane & 3) << 3) | (((lane >> 2) & 3) << 6) | (((lane >> 4) & 1) << 5) | (((lane >> 5) & 1) << 8); }
constexpr int v_rd_off(int d0, int ks, int half) { return d0 * 512 + ks * 4096 + half * 2048; }
DI u32 pk2(float lo, float hi) { return pg8::pk2(lo, hi); }

struct KSrc { const u16* p; int pitch; const u16* p2; int pitch2; };
struct VSrc { const u16* p; int pitch; };
template <int DQK> DI void stage_dma(LAS unsigned char* lds, int buf, const KSrc& ks, const VSrc& vs, int kb, int wid, int lane) {
    constexpr int CPR = DQK / 8, PITCH = DQK * 2, KBYTES = 64 * PITCH;
#pragma unroll
    for (int i = 0; i < DQK / 64; ++i) {
        const int q = (i * 8 + wid) * 64 + lane, row = q / CPR, pc = q % CPR, cc = (pc & ~7) | ((pc & 7) ^ (row & 7));
        const u16* src = (DQK == 192 && cc >= 16) ? ks.p2 + (size_t)(kb + row) * ks.pitch2 + (cc - 16) * 8 : ks.p + (size_t)(kb + row) * ks.pitch + cc * 8;
        __builtin_amdgcn_global_load_lds((const unsigned*)src, (LAS unsigned*)(lds + LDS_K + buf * KBYTES + (i * 8 + wid) * 1024), 16, 0, 0);
    }
#pragma unroll
    for (int i = 0; i < 2; ++i) {
        const int q = (i * 8 + wid) * 64 + lane, st = q >> 5, key = (st >> 2) * 8 + ((q >> 2) & 7), col = (st & 3) * 32 + (q & 3) * 8;
        __builtin_amdgcn_global_load_lds((const unsigned*)(vs.p + (size_t)(kb + key) * vs.pitch + col), (LAS unsigned*)(lds + LDS_V + buf * SHM_V + (i * 8 + wid) * 1024), 16, 0, 0);
    }
}
template <int DQK> DI void qkt(f32x16& p0, f32x16& p1, LAS unsigned char* lds, int buf, int r32, int hi, const bf16x8 (&qr)[DQK / 16]) {
    constexpr int PITCH = DQK * 2, KBYTES = 64 * PITCH;
#pragma unroll
    for (int i = 0; i < 16; ++i) { p0[i] = 0.f; p1[i] = 0.f; }
    LAS unsigned char* kb[4];
#pragma unroll
    for (int dd = 0; dd < 4; ++dd) kb[dd] = lds + LDS_K + buf * KBYTES + r32 * PITCH + (((dd * 16 + hi * 8) * 2) ^ ((r32 & 7) << 4));
#pragma unroll
    for (int d0 = 0; d0 < DQK / 16; ++d0) {
        LAS unsigned char* a = kb[d0 & 3] + (d0 >> 2) * 128;
        const bf16x8 b0 = *(const LAS bf16x8*)a;
        const bf16x8 b1 = *(const LAS bf16x8*)(a + 32 * PITCH);
        p0 = __builtin_amdgcn_mfma_f32_32x32x16_bf16(b0, qr[d0], p0, 0, 0, 0);
        p1 = __builtin_amdgcn_mfma_f32_32x32x16_bf16(b1, qr[d0], p1, 0, 0, 0);
        if ((d0 & 3) == 3) __builtin_amdgcn_sched_barrier(0);
    }
}
DI float xhalf_max(float v) { auto rr = __builtin_amdgcn_permlane32_swap(__float_as_uint(v), __float_as_uint(v), false, false); return fmaxf(__uint_as_float(rr[0]), __uint_as_float(rr[1])); }
DI float xhalf_sum(float v) { auto rr = __builtin_amdgcn_permlane32_swap(__float_as_uint(v), __float_as_uint(v), false, false); return __uint_as_float(rr[0]) + __uint_as_float(rr[1]); }
DI void softmax_tile(f32x16& p0, f32x16& p1, float& m, float& l, f32x16 (&o)[4], bf16x8 (&pa)[4]) {
    float pmax = p0[0];
#pragma unroll
    for (int r = 1; r < 16; ++r) pmax = fmaxf(pmax, p0[r]);
#pragma unroll
    for (int r = 0; r < 16; ++r) pmax = fmaxf(pmax, p1[r]);
    pmax = xhalf_max(pmax);
    const float mn = fmaxf(m, pmax);
    const float alpha = __builtin_amdgcn_exp2f(m - mn);
    m = mn;
    float ps = 0.f;
#pragma unroll
    for (int r = 0; r < 16; ++r) { p0[r] = __builtin_amdgcn_exp2f(p0[r] - mn); ps += p0[r]; }
#pragma unroll
    for (int r = 0; r < 16; ++r) { p1[r] = __builtin_amdgcn_exp2f(p1[r] - mn); ps += p1[r]; }
    ps = xhalf_sum(ps);
    l = l * alpha + ps;
    if (__any(alpha < 1.f)) {
#pragma unroll
        for (int d = 0; d < 4; ++d)
#pragma unroll
            for (int r = 0; r < 16; ++r) o[d][r] *= alpha;
    }
#pragma unroll
    for (int s = 0; s < 2; ++s) {
        u32x4 w0 = {pk2(p0[8 * s + 0], p0[8 * s + 1]), pk2(p0[8 * s + 2], p0[8 * s + 3]), pk2(p0[8 * s + 4], p0[8 * s + 5]), pk2(p0[8 * s + 6], p0[8 * s + 7])};
        u32x4 w1 = {pk2(p1[8 * s + 0], p1[8 * s + 1]), pk2(p1[8 * s + 2], p1[8 * s + 3]), pk2(p1[8 * s + 4], p1[8 * s + 5]), pk2(p1[8 * s + 6], p1[8 * s + 7])};
        pa[s] = __builtin_bit_cast(bf16x8, w0); pa[2 + s] = __builtin_bit_cast(bf16x8, w1);
    }
}
DI void softmax_tile2(f32x16& p0, f32x16& p1, float cb, float& m, float& l, f32x16 (&o)[4], bf16x8 (&pa)[4]) {
    float pmax = p0[0];
#pragma unroll
    for (int r = 1; r < 16; ++r) pmax = fmaxf(pmax, p0[r]);
#pragma unroll
    for (int r = 0; r < 16; ++r) pmax = fmaxf(pmax, p1[r]);
    pmax = xhalf_max(pmax) + cb;
    const float mn = fmaxf(m, pmax);
    const float alpha = __builtin_amdgcn_exp2f(m - mn);
    m = mn;
    const float sh = mn - cb;
    float ps = 0.f;
#pragma unroll
    for (int r = 0; r < 16; ++r) { p0[r] = __builtin_amdgcn_exp2f(p0[r] - sh); ps += p0[r]; }
#pragma unroll
    for (int r = 0; r < 16; ++r) { p1[r] = __builtin_amdgcn_exp2f(p1[r] - sh); ps += p1[r]; }
    ps = xhalf_sum(ps);
    l = l * alpha + ps;
    if (__any(alpha < 1.f)) {
#pragma unroll
        for (int d = 0; d < 4; ++d)
#pragma unroll
            for (int r = 0; r < 16; ++r) o[d][r] *= alpha;
    }
#pragma unroll
    for (int s = 0; s < 2; ++s) {
        u32x4 w0 = {pk2(p0[8 * s + 0], p0[8 * s + 1]), pk2(p0[8 * s + 2], p0[8 * s + 3]), pk2(p0[8 * s + 4], p0[8 * s + 5]), pk2(p0[8 * s + 6], p0[8 * s + 7])};
        u32x4 w1 = {pk2(p1[8 * s + 0], p1[8 * s + 1]), pk2(p1[8 * s + 2], p1[8 * s + 3]), pk2(p1[8 * s + 4], p1[8 * s + 5]), pk2(p1[8 * s + 6], p1[8 * s + 7])};
        pa[s] = __builtin_bit_cast(bf16x8, w0); pa[2 + s] = __builtin_bit_cast(bf16x8, w1);
    }
}
DI bf16x8 scale_frag(bf16x8 q, float c) {
    u32x4 w = __builtin_bit_cast(u32x4, q);
#pragma unroll
    for (int i = 0; i < 4; ++i) w[i] = pk2(__uint_as_float(w[i] << 16) * c, __uint_as_float(w[i] & 0xffff0000u) * c);
    return __builtin_bit_cast(bf16x8, w);
}
#define FA_TRRD(dst, off) asm volatile("ds_read_b64_tr_b16 %0, %1 offset:%2" : "=&v"(dst) : "v"(vb), "i"(off) : "memory")
DI void pv_tile(f32x16 (&o)[4], int vb, const bf16x8 (&pa)[4]) {
#define FA_PV_D0(d0) do { s16x4 l0, l1, l2, l3, h0, h1, h2, h3; constexpr int b_ = v_rd_off(d0, 0, 0); \
        FA_TRRD(l0, b_); FA_TRRD(h0, b_ + 2048); FA_TRRD(l1, b_ + 4096); FA_TRRD(h1, b_ + 6144); FA_TRRD(l2, b_ + 8192); FA_TRRD(h2, b_ + 10240); FA_TRRD(l3, b_ + 12288); FA_TRRD(h3, b_ + 14336); \
        asm volatile("s_waitcnt lgkmcnt(0)" ::: "memory"); __builtin_amdgcn_sched_barrier(0); \
        o[d0] = __builtin_amdgcn_mfma_f32_32x32x16_bf16((bf16x8){l0[0], l0[1], l0[2], l0[3], h0[0], h0[1], h0[2], h0[3]}, pa[0], o[d0], 0, 0, 0); \
        o[d0] = __builtin_amdgcn_mfma_f32_32x32x16_bf16((bf16x8){l1[0], l1[1], l1[2], l1[3], h1[0], h1[1], h1[2], h1[3]}, pa[1], o[d0], 0, 0, 0); \
        o[d0] = __builtin_amdgcn_mfma_f32_32x32x16_bf16((bf16x8){l2[0], l2[1], l2[2], l2[3], h2[0], h2[1], h2[2], h2[3]}, pa[2], o[d0], 0, 0, 0); \
        o[d0] = __builtin_amdgcn_mfma_f32_32x32x16_bf16((bf16x8){l3[0], l3[1], l3[2], l3[3], h3[0], h3[1], h3[2], h3[3]}, pa[3], o[d0], 0, 0, 0); } while (0)
    FA_PV_D0(0); FA_PV_D0(1); FA_PV_D0(2); FA_PV_D0(3);
#undef FA_PV_D0
}
DI void mask_tile(f32x16& p0, f32x16& p1, int dq, unsigned W) {
    const float NEG = -__builtin_inff();
#pragma unroll
    for (int r = 0; r < 16; ++r) {
        const int c = (r & 3) + 8 * (r >> 2);
        if ((unsigned)(dq - c) >= W) p0[r] = NEG;
        if ((unsigned)(dq - c - 32) >= W) p1[r] = NEG;
    }
}
DI void bias_tile(f32x16& p0, f32x16& p1, int dq, const LAS float* tab) {
#pragma unroll
    for (int r = 0; r < 16; ++r) {
        const int c = (r & 3) + 8 * (r >> 2);
        int d0 = dq - c, d1 = dq - c - 32;
        d0 = d0 < 0 ? 0 : (d0 > 127 ? 127 : d0); d1 = d1 < 0 ? 0 : (d1 > 127 ? 127 : d1);
        p0[r] += tab[d0]; p1[r] += tab[d1];
    }
}
#ifndef FA_PROBE
#define FA_PROBE 0
#endif
template <int DQK, int NBUF, class TF, class AF, class PF, class MF>
DI void fa_pass_simple(LAS unsigned char* lds, int wid_s, const bf16x8 (&qr)[DQK / 16], f32x16 (&o)[4], float& m, float& l, int nt, TF tilef, const KSrc& ks, const VSrc& vs, AF activef, PF pref, MF postf) {
    constexpr int NL = (DQK / 64 + 2) * (FA_PROBE == 1 ? 2 : 1);
    const int lane = opaque_tid(0), r32 = lane & 31, hi = lane >> 5, wid = wid_s;
    const int vb0 = (int)(unsigned)(size_t)lds + LDS_V + v_rd_base(lane);
    if (nt <= 0) return;
#pragma unroll
    for (int d0 = 0; d0 < DQK / 16; ++d0) asm volatile("" :: "v"(qr[d0]));
    stage_dma<DQK>(lds, 0, ks, vs, __builtin_amdgcn_readfirstlane(tilef(0)) * 64, wid, lane);
    if (NBUF == 3 && nt > 1) { stage_dma<DQK>(lds, 1, ks, vs, __builtin_amdgcn_readfirstlane(tilef(1)) * 64, wid, lane); asm volatile("s_waitcnt vmcnt(%0) lgkmcnt(0)\n\ts_barrier" :: "n"(NL) : "memory"); }
    else asm volatile("s_waitcnt vmcnt(0) lgkmcnt(0)\n\ts_barrier" ::: "memory");
    int buf = 0;
#pragma unroll 1
    for (int tt = 0; tt < nt; ++tt) {
        const int j = __builtin_amdgcn_readfirstlane(tilef(tt));
        const bool act = activef(j);
        const auto aux = pref(j);
        const int nb = (NBUF == 3) ? (buf == 0 ? 2 : buf - 1) : (buf ^ 1);
        const bool more = tt + (NBUF - 1) < nt;
        if (more) stage_dma<DQK>(lds, nb, ks, vs, __builtin_amdgcn_readfirstlane(tilef(tt + NBUF - 1)) * 64, wid, lane);
        if (FA_PROBE == 1 && more) stage_dma<DQK>(lds, nb, ks, vs, tilef(tt + NBUF - 1) * 64, wid, lane);
        if (act) {
            f32x16 p0, p1; bf16x8 pa[4];
            if (FA_PROBE == 3) { float m2 = m, l2 = l; f32x16 o2[4]; for (int d = 0; d < 4; ++d) o2[d] = o[d]; qkt<DQK>(p0, p1, lds, buf, r32, hi, qr); postf(p0, p1, j, aux); softmax_tile(p0, p1, m2, l2, o2, pa); asm volatile("" :: "v"(pa[0]), "v"(pa[1]), "v"(pa[2]), "v"(pa[3]), "v"(m2), "v"(l2)); }
            qkt<DQK>(p0, p1, lds, buf, r32, hi, qr);
            postf(p0, p1, j, aux);
            softmax_tile(p0, p1, m, l, o, pa);
            pv_tile(o, vb0 + buf * SHM_V, pa);
            if (FA_PROBE == 4) { f32x16 o2[4]; for (int d = 0; d < 4; ++d) o2[d] = o[d]; pv_tile(o2, vb0 + buf * SHM_V, pa); asm volatile("" :: "v"(o2[0]), "v"(o2[1]), "v"(o2[2]), "v"(o2[3])); }
        }
        if (FA_PROBE == 2) asm volatile("s_barrier" ::: "memory");
        if (NBUF == 3 && more) asm volatile("s_waitcnt vmcnt(%0) lgkmcnt(0)\n\ts_barrier" :: "n"(NL) : "memory");
        else asm volatile("s_waitcnt vmcnt(0) lgkmcnt(0)\n\ts_barrier" ::: "memory");
        buf = (NBUF == 3) ? (buf == 2 ? 0 : buf + 1) : (buf ^ 1);
    }
}
#define FA_TRRD2(dst, off) asm volatile("ds_read_b64_tr_b16 %0, %1 offset:%2" : "=&v"(dst) : "v"(vb), "i"(off) : "memory")
#define FA_KRD(dst, base, off) asm volatile("ds_read_b128 %0, %1 offset:%2" : "=&v"(dst) : "v"(base), "i"(off) : "memory")
#define FA_LGKM(n) do { asm volatile("s_waitcnt lgkmcnt(%0)" :: "n"(n) : "memory"); __builtin_amdgcn_sched_barrier(0); } while (0)
struct VFrag { s16x4 l0, h0, l1, h1, l2, h2, l3, h3; };
template <int D0> DI void pv_read(VFrag& f, int vb) { constexpr int b_ = v_rd_off(D0, 0, 0);
    FA_TRRD2(f.l0, b_); FA_TRRD2(f.h0, b_ + 2048); FA_TRRD2(f.l1, b_ + 4096); FA_TRRD2(f.h1, b_ + 6144); FA_TRRD2(f.l2, b_ + 8192); FA_TRRD2(f.h2, b_ + 10240); FA_TRRD2(f.l3, b_ + 12288); FA_TRRD2(f.h3, b_ + 14336); }
DI void pv_mma(f32x16& od, const VFrag& f, const bf16x8 (&pa)[4]) {
    od = __builtin_amdgcn_mfma_f32_32x32x16_bf16((bf16x8){f.l0[0], f.l0[1], f.l0[2], f.l0[3], f.h0[0], f.h0[1], f.h0[2], f.h0[3]}, pa[0], od, 0, 0, 0);
    od = __builtin_amdgcn_mfma_f32_32x32x16_bf16((bf16x8){f.l1[0], f.l1[1], f.l1[2], f.l1[3], f.h1[0], f.h1[1], f.h1[2], f.h1[3]}, pa[1], od, 0, 0, 0);
    od = __builtin_amdgcn_mfma_f32_32x32x16_bf16((bf16x8){f.l2[0], f.l2[1], f.l2[2], f.l2[3], f.h2[0], f.h2[1], f.h2[2], f.h2[3]}, pa[2], od, 0, 0, 0);
    od = __builtin_amdgcn_mfma_f32_32x32x16_bf16((bf16x8){f.l3[0], f.l3[1], f.l3[2], f.l3[3], f.h3[0], f.h3[1], f.h3[2], f.h3[3]}, pa[3], od, 0, 0, 0);
}
DI void pv_pipe(f32x16 (&o)[4], int vb, const bf16x8 (&pa)[4]) {
    VFrag f0, f1, f2;
    pv_read<0>(f0, vb); pv_read<1>(f1, vb);
    FA_LGKM(8); pv_mma(o[0], f0, pa); __builtin_amdgcn_sched_barrier(0); pv_read<2>(f2, vb);
    FA_LGKM(8); pv_mma(o[1], f1, pa); __builtin_amdgcn_sched_barrier(0); pv_read<3>(f0, vb);
    FA_LGKM(8); pv_mma(o[2], f2, pa); __builtin_amdgcn_sched_barrier(0);
    FA_LGKM(0); pv_mma(o[3], f0, pa); __builtin_amdgcn_sched_barrier(0);
}
struct KFrag { bf16x8 a0, a1, b0, b1; };
template <int S> DI void qk_read(KFrag& f, const int (&kbm)[4], const int (&kbe)[4]) {
    if constexpr (S < 4) { constexpr int dA = 2 * S, dB = 2 * S + 1;
        FA_KRD(f.a0, kbm[dA & 3], (dA >> 2) * 128); FA_KRD(f.a1, kbm[dA & 3], (dA >> 2) * 128 + 32 * 256);
        FA_KRD(f.b0, kbm[dB & 3], (dB >> 2) * 128); FA_KRD(f.b1, kbm[dB & 3], (dB >> 2) * 128 + 32 * 256); }
    else { constexpr int eA = 2 * S - 8, eB = 2 * S - 7;
        FA_KRD(f.a0, kbe[eA], 0); FA_KRD(f.a1, kbe[eA], 32 * 128);
        FA_KRD(f.b0, kbe[eB], 0); FA_KRD(f.b1, kbe[eB], 32 * 128); }
}
template <int S, int NQ> DI void qk_mma(f32x16& p0, f32x16& p1, const KFrag& f, const bf16x8 (&qr)[NQ]) {
    p0 = __builtin_amdgcn_mfma_f32_32x32x16_bf16(f.a0, qr[2 * S], p0, 0, 0, 0); p1 = __builtin_amdgcn_mfma_f32_32x32x16_bf16(f.a1, qr[2 * S], p1, 0, 0, 0);
    p0 = __builtin_amdgcn_mfma_f32_32x32x16_bf16(f.b0, qr[2 * S + 1], p0, 0, 0, 0); p1 = __builtin_amdgcn_mfma_f32_32x32x16_bf16(f.b1, qr[2 * S + 1], p1, 0, 0, 0);
}
template <int DQK> DI void qk_pipe(f32x16& p0, f32x16& p1, int ldsK, int r32, int hi, const bf16x8 (&qr)[DQK / 16]) {
    constexpr int NS = DQK / 32;
    int kbm[4], kbe[4];
#pragma unroll
    for (int dd = 0; dd < 4; ++dd) { kbm[dd] = ldsK + r32 * 256 + (((dd * 2 + hi) ^ (r32 & 7)) << 4); kbe[dd] = ldsK + 16384 + r32 * 128 + (((dd * 2 + hi) ^ (r32 & 7)) << 4); }
#pragma unroll
    for (int i = 0; i < 16; ++i) { p0[i] = 0.f; p1[i] = 0.f; }
    KFrag f0, f1, f2;
    qk_read<0>(f0, kbm, kbe); qk_read<1>(f1, kbm, kbe);
    FA_LGKM(4); qk_mma<0>(p0, p1, f0, qr); __builtin_amdgcn_sched_barrier(0); qk_read<2>(f2, kbm, kbe);
    FA_LGKM(4); qk_mma<1>(p0, p1, f1, qr); __builtin_amdgcn_sched_barrier(0); qk_read<3>(f0, kbm, kbe);
    if constexpr (NS == 4) {
        FA_LGKM(4); qk_mma<2>(p0, p1, f2, qr); __builtin_amdgcn_sched_barrier(0);
        FA_LGKM(0); qk_mma<3>(p0, p1, f0, qr); __builtin_amdgcn_sched_barrier(0);
    } else {
        FA_LGKM(4); qk_mma<2>(p0, p1, f2, qr); __builtin_amdgcn_sched_barrier(0); qk_read<4>(f1, kbm, kbe);
        FA_LGKM(4); qk_mma<3>(p0, p1, f0, qr); __builtin_amdgcn_sched_barrier(0); qk_read<5>(f2, kbm, kbe);
        FA_LGKM(4); qk_mma<4>(p0, p1, f1, qr); __builtin_amdgcn_sched_barrier(0);
        FA_LGKM(0); qk_mma<5>(p0, p1, f2, qr); __builtin_amdgcn_sched_barrier(0);
    }
}
DI void fa_pin(int&) {}
DI void fa_pin(u64& a) { asm volatile("" : "+v"(a)); }
template <int DQK, class TF, class AF, class PF, class MF>
DI void fa_pass(LAS unsigned char* lds, int wid_s, const bf16x8 (&qr)[DQK / 16], f32x16 (&o)[4], float& m, float& l, int nt, TF tilef, const KSrc& ks, const VSrc& vs, AF activef, PF pref, MF postf) {
    static_assert(DQK == 128 || DQK == 192, "fa_pass: DQK 128 or 192");
    constexpr int NL = DQK / 64 + 2, KBYTES = 64 * DQK * 2;
    const int lane = opaque_tid(0), r32 = lane & 31, hi = lane >> 5, wid = wid_s;
    const int vb0 = (int)(unsigned)(size_t)lds + LDS_V + v_rd_base(lane);
    if (nt <= 0) return;
#pragma unroll
    for (int d0 = 0; d0 < DQK / 16; ++d0) asm volatile("" :: "v"(qr[d0]));
    unsigned offK[2], offE = 0u, offV[2];
#pragma unroll
    for (int i = 0; i < 2; ++i) {
        { const int q = (i * 8 + wid) * 64 + lane, row = q >> 4, pc = q & 15, cc = (pc & 8) | ((pc & 7) ^ (row & 7)); offK[i] = (unsigned)(row * ks.pitch + cc * 8) * 2u; }
        { const int q = (i * 8 + wid) * 64 + lane, st = q >> 5, key = (st >> 2) * 8 + ((q >> 2) & 7), col = (st & 3) * 32 + (q & 3) * 8; offV[i] = (unsigned)(key * vs.pitch + col) * 2u; }
    }
    if (DQK == 192) { const int q = wid * 64 + lane, row = q >> 3, pc = q & 7, cc = pc ^ (row & 7); offE = (unsigned)(row * ks.pitch2 + cc * 8) * 2u; }
#define FA_DMA(tau, kb_, vb_) do { const int kbase_ = __builtin_amdgcn_readfirstlane(tilef(tau)) * 64; \
        const char* kp_ = (const char*)(ks.p + (size_t)kbase_ * ks.pitch); const char* vp_ = (const char*)(vs.p + (size_t)kbase_ * vs.pitch); \
        _Pragma("unroll") for (int i_ = 0; i_ < 2; ++i_) __builtin_amdgcn_global_load_lds((const unsigned*)(kp_ + offK[i_]), (LAS unsigned*)(lds + LDS_K + (kb_) * KBYTES + (i_ * 8 + wid) * 1024), 16, 0, 0); \
        if (DQK == 192) { const char* ep_ = (const char*)(ks.p2 + (size_t)kbase_ * ks.pitch2); __builtin_amdgcn_global_load_lds((const unsigned*)(ep_ + offE), (LAS unsigned*)(lds + LDS_K + (kb_) * KBYTES + 16384 + wid * 1024), 16, 0, 0); } \
        _Pragma("unroll") for (int i_ = 0; i_ < 2; ++i_) __builtin_amdgcn_global_load_lds((const unsigned*)(vp_ + offV[i_]), (LAS unsigned*)(lds + LDS_V + (vb_) * SHM_V + (i_ * 8 + wid) * 1024), 16, 0, 0); } while (0)
#define FA_BAR() asm volatile("s_waitcnt lgkmcnt(0)\n\ts_barrier" ::: "memory")
    FA_DMA(0, 0, 0);
    if (nt > 1) { FA_DMA(1, 1, 1); asm volatile("s_waitcnt vmcnt(%0)" :: "n"(NL) : "memory"); } else asm volatile("s_waitcnt vmcnt(0)" ::: "memory");
    FA_BAR();
    if (wid >= 4) FA_BAR();
    int kb = 0, vb = 0;
    bool act_prev = false; bf16x8 pa[4];
    int vb_prev = 0;
#pragma unroll 1
    for (int tt = 0; tt < nt; ++tt) {
        const int j = __builtin_amdgcn_readfirstlane(tilef(tt));
        const bool act = activef(j);
        auto aux = pref(j);
        const bool more = tt + 2 < nt;
        __builtin_amdgcn_s_setprio(1);
        if (act_prev) pv_pipe(o, vb0 + vb_prev * SHM_V, pa);
        f32x16 p0, p1;
        if (act) qk_pipe<DQK>(p0, p1, (int)(unsigned)(size_t)lds + LDS_K + kb * KBYTES, r32, hi, qr);
        __builtin_amdgcn_s_setprio(0);
        asm volatile("s_waitcnt vmcnt(0)" ::: "memory");
        fa_pin(aux);
        FA_BAR();
        if (more) { const int kb2 = kb == 0 ? 2 : kb - 1, vb2 = (vb + 2) & 3; FA_DMA(tt + 2, kb2, vb2); }
        if (act) { const float cb = postf(p0, p1, j, aux); softmax_tile2(p0, p1, cb, m, l, o, pa); }
        FA_BAR();
        act_prev = act; vb_prev = vb;
        kb = kb == 2 ? 0 : kb + 1; vb = (vb + 1) & 3;
    }
    if (act_prev) pv_pipe(o, vb0 + vb_prev * SHM_V, pa);
    FA_BAR();
    if (wid < 4) FA_BAR();
#undef FA_DMA
#undef FA_BAR
}
DI void write_o(const f32x16 (&o)[4], float l, u16* dst, int pitch) {
    const float inv = l > 0.f ? 1.f / l : 0.f;
    const int lane = opaque_tid(0), rr = lane & 31, hi = lane >> 5;
    u16* rowp = dst + (size_t)rr * pitch + 4 * hi;
#pragma unroll
    for (int d0 = 0; d0 < 4; ++d0)
#pragma unroll
        for (int g4 = 0; g4 < 4; ++g4) {
            uint2 w; w.x = pk2(o[d0][4 * g4 + 0] * inv, o[d0][4 * g4 + 1] * inv); w.y = pk2(o[d0][4 * g4 + 2] * inv, o[d0][4 * g4 + 3] * inv);
            *(uint2*)(rowp + d0 * 32 + 8 * g4) = w;
        }
}
}


DI bool split_arrive_merge(unsigned char* glds, int wid_s, unsigned char* ws, int pslot, int chunk, unsigned* cntb, fa::f32x16 (&o)[4], float& m, float& l) {
    using namespace fa;
    const int lane = opaque_tid(0), rr = lane & 31, hi = lane >> 5, row = wid_s * 32 + rr;
    unsigned char* mine = ws + WS_PART + (size_t)(pslot * 2 + chunk) * PART_BYTES;
    const unsigned char* other = ws + WS_PART + (size_t)(pslot * 2 + (chunk ^ 1)) * PART_BYTES;
    {
        const float inv = l > 0.f ? 1.f / l : 0.f;
        u64* po = (u64*)(mine + (size_t)row * 256 + 8 * hi);
#pragma unroll
        for (int d0 = 0; d0 < 4; ++d0)
#pragma unroll
            for (int g4 = 0; g4 < 4; ++g4) {
                const u64 w = (u64)pk2(o[d0][4 * g4 + 0] * inv, o[d0][4 * g4 + 1] * inv) | ((u64)pk2(o[d0][4 * g4 + 2] * inv, o[d0][4 * g4 + 3] * inv) << 32);
                po[d0 * 8 + 2 * g4] = w;
            }
        if (hi == 0) *(u64*)(mine + 65536 + (size_t)row * 8) = (u64)__float_as_uint(m) | ((u64)__float_as_uint(l) << 32);
    }
    asm volatile("s_waitcnt vmcnt(0)" ::: "memory");
    __syncthreads();
    volatile LAS unsigned* flag = (volatile LAS unsigned*)(glds + LDS_MISC + 24);
    if (wid_s == 0 && lane == 0) {
        __builtin_amdgcn_fence(__ATOMIC_RELEASE, "agent");
        asm volatile("s_waitcnt vmcnt(0)" ::: "memory");
        *flag = __hip_atomic_fetch_add(cntb + pslot, 1u, __ATOMIC_RELAXED, __HIP_MEMORY_SCOPE_AGENT);
    }
    __syncthreads();
    if (__builtin_amdgcn_readfirstlane(*flag) == 0u) return false;
    __builtin_amdgcn_fence(__ATOMIC_ACQUIRE, "agent");
    asm volatile("s_waitcnt vmcnt(0)" ::: "memory");
    const u64 ml = *(const u64*)(other + 65536 + (size_t)row * 8);
    const float m2 = __uint_as_float((u32)ml), l2 = __uint_as_float((u32)(ml >> 32));
    const float M = fmaxf(m, m2);
    const float a1 = __fmul_rn(__builtin_amdgcn_exp2f(m - M), l), a2 = __fmul_rn(__builtin_amdgcn_exp2f(m2 - M), l2), den = __fadd_rn(a1, a2);
    const float r1 = den > 0.f ? a1 / den : 0.f, r2 = den > 0.f ? a2 / den : 0.f;
    const float inv = l > 0.f ? 1.f / l : 0.f;
    const u64* qo = (const u64*)(other + (size_t)row * 256 + 8 * hi);
#pragma unroll
    for (int d0 = 0; d0 < 4; ++d0)
#pragma unroll
        for (int g4 = 0; g4 < 4; ++g4) {
            const u64 w = qo[d0 * 8 + 2 * g4];
            const u32 s0 = pk2(o[d0][4 * g4 + 0] * inv, o[d0][4 * g4 + 1] * inv), s1 = pk2(o[d0][4 * g4 + 2] * inv, o[d0][4 * g4 + 3] * inv);
            o[d0][4 * g4 + 0] = __fadd_rn(__fmul_rn(bf2f(s0 & 0xffffu), r1), __fmul_rn(bf2f((u32)w & 0xffffu), r2));
            o[d0][4 * g4 + 1] = __fadd_rn(__fmul_rn(bf2f(s0 >> 16), r1), __fmul_rn(bf2f(((u32)w) >> 16), r2));
            o[d0][4 * g4 + 2] = __fadd_rn(__fmul_rn(bf2f(s1 & 0xffffu), r1), __fmul_rn(bf2f((u32)(w >> 32) & 0xffffu), r2));
            o[d0][4 * g4 + 3] = __fadd_rn(__fmul_rn(bf2f(s1 >> 16), r1), __fmul_rn(bf2f((u32)(w >> 48)), r2));
        }
    m = M; l = den > 0.f ? 1.f : 0.f;
    return true;
}

DI void mla_unit(unsigned char* glds, int wid_s, int h, int qb, int chunk, unsigned* cnt) {
    using namespace fa;
    LAS unsigned char* lds = (LAS unsigned char*)glds; const int tid = opaque_tid(wid_s); unsigned char* const ws = (unsigned char*)(GAS unsigned char*)ldp(glds, 21);
    const int lane = tid & 63, wid = wid_s, r32 = lane & 31, hi = lane >> 5;
    const int row0 = qb * 256 + wid * 32, row = row0 + r32;
    u16* mqn = (u16*)(ws + WS_MQN); const u16* mqr = (const u16*)(ws + WS_MQR);
    bf16x8 qr[12];
#pragma unroll
    for (int d0 = 0; d0 < 8; ++d0) qr[d0] = *(const bf16x8*)(mqn + (size_t)row * 1024 + h * 128 + d0 * 16 + hi * 8);
#pragma unroll
    for (int d0 = 0; d0 < 4; ++d0) qr[8 + d0] = *(const bf16x8*)(mqr + (size_t)row * 512 + h * 64 + d0 * 16 + hi * 8);
    f32x16 o[4];
#pragma unroll
    for (int d = 0; d < 4; ++d)
#pragma unroll
        for (int r = 0; r < 16; ++r) o[d][r] = 0.f;
    float m = -1e30f, l = 0.f;
    const KSrc ks{(const u16*)(ws + WS_MKN) + h * 128, 1024, (const u16*)(ws + WS_MKR), 64};
    const VSrc vs{(const u16*)(ws + WS_MV) + h * 128, 1024};
    constexpr float C2 = 0.07216878364870322f * LOG2E;
#pragma unroll
    for (int d0 = 0; d0 < 12; ++d0) qr[d0] = scale_frag(qr[d0], C2);
    const int ntt = 4 * (qb + 1), t_lo = chunk == 1 ? ntt / 2 : 0, t_hi = chunk == 0 ? ntt / 2 : ntt;
    fa_pass<192>(lds, wid_s, qr, o, m, l, t_hi - t_lo, [&](int t) { return t_lo + t; }, ks, vs,
        [&](int j) { return j * 64 <= row0 + 31; },
        [](int) { return 0; },
        [&](f32x16& p0, f32x16& p1, int j, int) {
            if (j * 64 + 63 > row0) mask_tile(p0, p1, row - j * 64 - 4 * hi, 0x80000000u);
            return 0.f;
        });
    if (chunk >= 0 && !split_arrive_merge(glds, wid_s, ws, h * 8 + (qb & 7), chunk, cnt, o, m, l)) return;
    write_o(o, l, mqn + (size_t)row0 * 1024 + h * 128, 1024);
}
DI void dsa_unit(unsigned char* glds, int wid_s, int h, int qb, int chunk, unsigned* cnt) {
    using namespace fa;
    LAS unsigned char* lds = (LAS unsigned char*)glds; const int tid = opaque_tid(wid_s); unsigned char* const ws = (unsigned char*)(GAS unsigned char*)ldp(glds, 21); const float* relb = (const float*)(GAS unsigned char*)ldp(glds, 3);
    const int lane = tid & 63, wid = wid_s, r32 = lane & 31, hi = lane >> 5;
    const int row0 = qb * 256 + wid * 32, row = row0 + r32;
    u16* proj = (u16*)(ws + WS_PROJ);
    LAS float* tab = (LAS float*)(lds + LDS_TAB);
    if (tid < 128) tab[tid] = relb[relbucket(tid) * 16 + h] * LOG2E;
    bf16x8 qr[8];
#pragma unroll
    for (int d0 = 0; d0 < 8; ++d0) qr[d0] = *(const bf16x8*)(proj + (size_t)row * PP + C_DSAQ + h * 128 + d0 * 16 + hi * 8);
    f32x16 o[4];
#pragma unroll
    for (int d = 0; d < 4; ++d)
#pragma unroll
        for (int r = 0; r < 16; ++r) o[d][r] = 0.f;
    float m = -1e30f, l = 0.f;
    const KSrc ks{proj + C_DSAK + h * 128, PP, nullptr, 0};
    const VSrc vs{proj + C_DSAV + h * 128, PP};
    const u32* mrow = (const u32*)(ws + WS_BITM) + (size_t)row * 128;
    constexpr float C2 = 0.08838834764831845f * LOG2E;
#pragma unroll
    for (int d0 = 0; d0 < 8; ++d0) qr[d0] = scale_frag(qr[d0], C2);
    const int ntt = 4 * (qb + 1), t_lo = chunk == 1 ? ntt / 2 : 0, t_hi = chunk == 0 ? ntt / 2 : ntt;
    fa_pass<128>(lds, wid_s, qr, o, m, l, t_hi - t_lo, [&](int t) { return t_lo + t; }, ks, vs,
        [&](int j) { return j * 64 <= row0 + 31; },
        [&](int j) { u64 w; const u32* ap = mrow + 2 * j; asm volatile("global_load_dwordx2 %0, %1, off" : "=v"(w) : "v"(ap) : "memory"); return w; },
        [&](f32x16& p0, f32x16& p1, int j, u64 mw64) {
            uint2 mw; mw.x = (u32)mw64; mw.y = (u32)(mw64 >> 32);
            float cb = 0.f;
            if (row0 - (j * 64 + 63) >= 127) cb = tab[127];
            else bias_tile(p0, p1, row - j * 64 - 4 * hi, tab);
            const u32 w0 = mw.x >> (4 * hi), w1 = mw.y >> (4 * hi);
            const float NEG = -__builtin_inff();
#pragma unroll
            for (int r = 0; r < 16; ++r) { const int c = (r & 3) + 8 * (r >> 2); if (!((w0 >> c) & 1u)) p0[r] = NEG; if (!((w1 >> c) & 1u)) p1[r] = NEG; }
            return cb;
        });
    if (chunk >= 0 && !split_arrive_merge(glds, wid_s, ws, 64 + h * 8 + (qb & 7), chunk, cnt, o, m, l)) return;
    write_o(o, l, proj + (size_t)row0 * PP + C_DSAQ + h * 128, PP);
}

DI void cross_unit(unsigned char* glds, int wid_s, int bb, int h, int qb) {
    using namespace fa;
    LAS unsigned char* lds = (LAS unsigned char*)glds; const int tid = opaque_tid(wid_s); unsigned char* const ws = (unsigned char*)(GAS unsigned char*)ldp(glds, 21);
    const int lane = tid & 63, wid = wid_s, r32 = lane & 31, hi = lane >> 5;
    const int row0 = bb * SEQ + qb * 256 + wid * 32, row = row0 + r32;
    u16* cq = (u16*)(ws + WS_CQ); const u16* ckv = (const u16*)(ws + WS_CKV) + (size_t)bb * 256 * 2048;
    bf16x8 qr[16];
#pragma unroll
    for (int d0 = 0; d0 < 16; ++d0) qr[d0] = *(const bf16x8*)(cq + (size_t)row * 1024 + h * 256 + d0 * 16 + hi * 8);
    constexpr float C2 = 0.0625f * LOG2E;
    const KSrc ks{ckv + h * 256, 2048, nullptr, 0};
#pragma unroll 1
    for (int half = 0; half < 2; ++half) {
        f32x16 o[4];
#pragma unroll
        for (int d = 0; d < 4; ++d)
#pragma unroll
            for (int r = 0; r < 16; ++r) o[d][r] = 0.f;
        float m = -1e30f, l = 0.f;
        const VSrc vs{ckv + 1024 + h * 256 + half * 128, 2048};
        fa_pass_simple<256, 2>(lds, wid_s, qr, o, m, l, 4, [](int t) { return t; }, ks, vs,
            [](int) { return true; }, [](int) { return 0; },
            [&](f32x16& p0, f32x16& p1, int, int) {
#pragma unroll
                for (int r = 0; r < 16; ++r) { p0[r] *= C2; p1[r] *= C2; } });
        write_o(o, l, cq + (size_t)row0 * 1024 + h * 256 + half * 128, 1024);
    }
}

template <bool FIRST> DI void nsa_accum(const fa::f32x16 (&o)[4], float l, u16* proj, int t0w, int g, int hg, int gi, u16* dst, int dpitch) {
    const int lane = opaque_tid(0), rr = lane & 31, hh = lane >> 5;
    const u16* gp = proj + (size_t)(t0w + rr) * PP + C_NGATE + gi * 8 + g * 4 + hg;
    const float gate = sigmoidf_(bf2f(*gp));
    const float inv = l > 0.f ? gate / l : 0.f;
    u64* orow = (u64*)(dst + (size_t)(t0w + rr) * dpitch + (g * 4 + hg) * 128 + 4 * hh);
#pragma unroll
    for (int d = 0; d < 4; ++d)
#pragma unroll
        for (int g4 = 0; g4 < 4; ++g4) {
            float a0 = 0.f, a1 = 0.f, a2 = 0.f, a3 = 0.f;
            if (!FIRST) { const u64 w = orow[d * 8 + 2 * g4]; a0 = bf2f((u32)w & 0xffffu); a1 = bf2f(((u32)w) >> 16); a2 = bf2f((u32)(w >> 32) & 0xffffu); a3 = bf2f((u32)(w >> 48)); }
            const u64 w2 = (u64)fa::pk2(a0 + o[d][4 * g4] * inv, a1 + o[d][4 * g4 + 1] * inv) | ((u64)fa::pk2(a2 + o[d][4 * g4 + 2] * inv, a3 + o[d][4 * g4 + 3] * inv) << 32);
            orow[d * 8 + 2 * g4] = w2;
        }
}
DI void nsa_final(const fa::f32x16 (&o)[4], float l, u16* proj, int t0w, int g, int hg, const u16* ow, int owpitch) {
    const int lane = opaque_tid(0), rr = lane & 31, hh = lane >> 5;
    const u16* gp = proj + (size_t)(t0w + rr) * PP + C_NGATE + 1 * 8 + g * 4 + hg;
    const float gate = sigmoidf_(bf2f(*gp));
    const float inv = l > 0.f ? gate / l : 0.f;
    u64* orow = (u64*)(proj + (size_t)(t0w + rr) * PP + C_NSAO + (g * 4 + hg) * 128 + 4 * hh);
    const u64* wrow = (const u64*)(ow + (size_t)(t0w + rr) * owpitch + (g * 4 + hg) * 128 + 4 * hh);
#pragma unroll
    for (int d = 0; d < 4; ++d)
#pragma unroll
        for (int g4 = 0; g4 < 4; ++g4) {
            const u64 a = orow[d * 8 + 2 * g4], c = wrow[d * 8 + 2 * g4];
            const float s0 = bf2f((u32)a & 0xffffu) + bf2f((u32)c & 0xffffu), s1 = bf2f(((u32)a) >> 16) + bf2f(((u32)c) >> 16);
            const float s2 = bf2f((u32)(a >> 32) & 0xffffu) + bf2f((u32)(c >> 32) & 0xffffu), s3 = bf2f((u32)(a >> 48)) + bf2f((u32)(c >> 48));
            orow[d * 8 + 2 * g4] = (u64)fa::pk2(s0 + o[d][4 * g4] * inv, s1 + o[d][4 * g4 + 1] * inv) | ((u64)fa::pk2(s2 + o[d][4 * g4 + 2] * inv, s3 + o[d][4 * g4 + 3] * inv) << 32);
        }
}

DI void nsa_unit(unsigned char* glds, int wid_s, int g, int n, int chunk, unsigned* cntb, unsigned* selfb) {
    using namespace fa;
    LAS unsigned char* lds = (LAS unsigned char*)glds; const int tid = opaque_tid(wid_s); unsigned char* const ws = (unsigned char*)(GAS unsigned char*)ldp(glds, 21); const float* relb = (const float*)(GAS unsigned char*)ldp(glds, 3);
    const int lane = tid & 63, r32 = lane & 31, hi = lane >> 5, hg = wid_s >> 1, qh = wid_s & 1;
    const int q = qh * 32 + r32, t = 64 * n + q, t0w = 64 * n + 32 * qh;
    u16* proj = (u16*)(ws + WS_PROJ);
    LAS float* tab = (LAS float*)(lds + LDS_TAB);
    LAS u32* imp = (LAS u32*)(lds + LDS_TAB + 2048);
    LAS u32* selm = (LAS u32*)(lds + LDS_TAB + 2048 + 16384);
    LAS int* tlist = (LAS int*)(lds + LDS_TAB + 2048 + 16384 + 512);
    tab[tid] = relb[relbucket(tid & 127) * 16 + 8 + g * 4 + (tid >> 7)] * LOG2E;
#pragma unroll
    for (int k = 0; k < 8; ++k) imp[tid + 512 * k] = 0u;
    if (tid < 128) selm[tid] = 0u;
    u16* qrow = proj + (size_t)t * PP + C_NSAQ + (g * 4 + hg) * 128;
    bf16x8 qr[8];
#pragma unroll
    for (int d0 = 0; d0 < 8; ++d0) qr[d0] = *(const bf16x8*)(qrow + d0 * 16 + hi * 8);
    constexpr float C2 = 0.08838834764831845f * LOG2E;
#pragma unroll
    for (int d0 = 0; d0 < 8; ++d0) qr[d0] = scale_frag(qr[d0], C2);
    const LAS float* mytab = tab + hg * 128;
    f32x16 o[4];
#define NSA_ZERO_O() do { _Pragma("unroll") for (int d = 0; d < 4; ++d) _Pragma("unroll") for (int r = 0; r < 16; ++r) o[d][r] = 0.f; } while (0)
    float m = -1e30f, l = 0.f; int nts = 0;
    if (chunk != 1) {
    const int cmaxq = t >= 31 ? ((t - 31) >> 4) : -1;
    const int ntc = (4 * n + 3 + 63) >> 6;
    const KSrc kc{(const u16*)(ws + WS_KCMP) + g * 128, 256, nullptr, 0};
    const VSrc vc{(const u16*)(ws + WS_VCMP) + g * 128, 256};
    m = -1e30f; l = 0.f;
    NSA_ZERO_O();
    fa_pass<128>(lds, wid_s, qr, o, m, l, ntc, [](int tt) { return tt; }, kc, vc,
        [](int) { return true; }, [](int) { return 0; },
        [&](f32x16& p0, f32x16& p1, int j, int) {
            mask_tile(p0, p1, cmaxq - 64 * j - 4 * hi, 0x80000000u);
            return 0.f;
        });
    nsa_accum<true>(o, l, proj, t0w, g, hg, 0, proj + C_NSAO, PP);
    {
        const float mA = m, invl = l > 0.f ? 1.f / l : 0.f;
        const unsigned impb = (unsigned)(size_t)imp;
        fa_pass<128>(lds, wid_s, qr, o, m, l, ntc, [](int tt) { return tt; }, kc, vc,
            [](int) { return true; }, [](int) { return 0; },
            [&](f32x16& p0, f32x16& p1, int j, int) {
                mask_tile(p0, p1, cmaxq - 64 * j - 4 * hi, 0x80000000u);
#pragma unroll
                for (int r = 0; r < 16; ++r) { p0[r] = __builtin_amdgcn_exp2f(p0[r] - mA) * invl; p1[r] = __builtin_amdgcn_exp2f(p1[r] - mA) * invl; }
#pragma unroll
                for (int gi = 0; gi < 4; ++gi) {
                    const int jj0 = 16 * j + 2 * gi + hi, jj1 = jj0 + 8;
                    const float G0 = (p0[4 * gi] + p0[4 * gi + 1]) + (p0[4 * gi + 2] + p0[4 * gi + 3]), G1 = (p1[4 * gi] + p1[4 * gi + 1]) + (p1[4 * gi + 2] + p1[4 * gi + 3]);
                    constexpr float FX = 67108864.f;
#define NSA_LADD(idx, val) asm volatile("ds_add_u32 %0, %1" :: "v"(impb + (unsigned)(idx) * 4u), "v"((u32)(val)) : "memory")
                    if (G0 != 0.f) { NSA_LADD(jj0 * 64 + q, G0 * FX + 0.5f);
                                     if (p0[4 * gi + 3] != 0.f) NSA_LADD((jj0 + 1) * 64 + q, p0[4 * gi + 3] * FX + 0.5f); }
                    if (G1 != 0.f) { NSA_LADD(jj1 * 64 + q, G1 * FX + 0.5f);
                                     if (jj1 + 1 < 64 && p1[4 * gi + 3] != 0.f) NSA_LADD((jj1 + 1) * 64 + q, p1[4 * gi + 3] * FX + 0.5f); }
#undef NSA_LADD
                }
                const float NEG = -__builtin_inff();
#pragma unroll
                for (int r = 0; r < 16; ++r) { p0[r] = NEG; p1[r] = NEG; }
                return 0.f;
            });
    }
    {
#pragma unroll
        for (int k = 0; k < 8; ++k) {
            const int id = tid + 512 * k, jj = id >> 6;
            u32 key = 0u;
            if (jj <= n) { const u32 v = (jj == 0 || jj == n || jj == n - 1) ? 0x3ffffffu : min(imp[id] >> 5, 0x3fffffeu); key = (v << 6) | (u32)(63 - jj); }
            imp[id] = key;
        }
        __syncthreads();
        u32 tk[8]; int cn[8];
#pragma unroll
        for (int e = 0; e < 8; ++e) { tk[e] = imp[(wid_s + 8 * e) * 64 + lane]; cn[e] = 0; }
#pragma unroll 8
        for (int j2 = 0; j2 < 64; ++j2) {
            const u32 x = imp[j2 * 64 + lane];
#pragma unroll
            for (int e = 0; e < 8; ++e) cn[e] += (x > tk[e]) ? 1 : 0;
        }
#pragma unroll
        for (int e = 0; e < 8; ++e) { const int jj = wid_s + 8 * e;
            if (tk[e] != 0u && cn[e] < 16) __hip_atomic_fetch_or(selm + lane * 2 + (jj >> 5), 1u << (jj & 31), __ATOMIC_RELAXED, __HIP_MEMORY_SCOPE_WORKGROUP); }
    }
    __syncthreads();
    {
        u32 u0 = selm[lane * 2], u1 = selm[lane * 2 + 1];
#pragma unroll
        for (int off = 32; off; off >>= 1) { u0 |= __shfl_xor(u0, off); u1 |= __shfl_xor(u1, off); }
        const u64 un = ((u64)u1 << 32) | u0;
        nts = __builtin_amdgcn_readfirstlane(__popcll(un));
        if (wid_s == 0 && ((un >> lane) & 1ull)) tlist[__popcll(un & ((1ull << lane) - 1ull))] = lane;
    }
    __syncthreads();
    if (chunk == 0) {
        u32* sx = (u32*)(ws + WS_SELX) + (size_t)(g * 32 + (n & 31)) * 256;
        if (tid < 128) __hip_atomic_store(sx + tid, selm[tid], __ATOMIC_RELAXED, __HIP_MEMORY_SCOPE_AGENT);
        else if (tid < 192) __hip_atomic_store(sx + tid, (u32)tlist[tid - 128], __ATOMIC_RELAXED, __HIP_MEMORY_SCOPE_AGENT);
        else if (tid == 192) __hip_atomic_store(sx + 192, (u32)nts, __ATOMIC_RELAXED, __HIP_MEMORY_SCOPE_AGENT);
        asm volatile("s_waitcnt vmcnt(0)" ::: "memory");
        __syncthreads();
        if (tid == 0) __hip_atomic_store(selfb + g * 32 + (n & 31), 1u, __ATOMIC_RELAXED, __HIP_MEMORY_SCOPE_AGENT);
    }
    }
    if (chunk != 0) {
        const KSrc ks{proj + C_NKW + g * 128, PP, nullptr, 0};
        const VSrc vs{proj + C_NVW + g * 128, PP};
        const int j0 = n >= 8 ? n - 8 : 0;
        m = -1e30f; l = 0.f;
        NSA_ZERO_O();
        fa_pass<128>(lds, wid_s, qr, o, m, l, n - j0 + 1, [&](int tt) { return j0 + tt; }, ks, vs,
            [](int) { return true; }, [](int) { return 0; },
            [&](f32x16& p0, f32x16& p1, int j, int) {
                const int dq = t - 64 * j - 4 * hi;
                float cb = 0.f;
                if (t0w - (64 * j + 63) >= 127) cb = mytab[127];
                else bias_tile(p0, p1, dq, mytab);
                if (!(64 * j + 63 <= t0w && t0w + 31 - 64 * j < 512)) mask_tile(p0, p1, dq, 512u);
                return cb;
            });
        if (chunk < 0) nsa_accum<false>(o, l, proj, t0w, g, hg, 2, proj + C_NSAO, PP);
        else nsa_accum<true>(o, l, proj, t0w, g, hg, 2, (u16*)(ws + WS_MKN), 1024);
    }
    if (chunk == 1) {
        if (tid == 0) { unsigned sp = 0;
            while (__hip_atomic_load(selfb + g * 32 + (n & 31), __ATOMIC_RELAXED, __HIP_MEMORY_SCOPE_AGENT) == 0u) { __builtin_amdgcn_s_sleep(8); if (++sp > (1u << 20)) break; }
            __builtin_amdgcn_fence(__ATOMIC_ACQUIRE, "agent"); asm volatile("s_waitcnt vmcnt(0)" ::: "memory"); }
        __syncthreads();
        const u32* sx = (const u32*)(ws + WS_SELX) + (size_t)(g * 32 + (n & 31)) * 256;
        if (tid < 128) selm[tid] = sx[tid]; else if (tid < 192) tlist[tid - 128] = (int)sx[tid];
        nts = __builtin_amdgcn_readfirstlane((int)sx[192]);
        __syncthreads();
    }
    const u32 ms0 = selm[q * 2], ms1 = selm[q * 2 + 1];
    {
        const KSrc ks{proj + C_NKS + g * 128, PP, nullptr, 0};
        const VSrc vs{proj + C_NVS + g * 128, PP};
        m = -1e30f; l = 0.f;
        NSA_ZERO_O();
        const int half = (nts + 1) >> 1, t_lo = chunk == 1 ? half : 0, t_hi = chunk == 0 ? half : nts;
        fa_pass<128>(lds, wid_s, qr, o, m, l, t_hi - t_lo, [&](int tt) { return tlist[t_lo + tt]; }, ks, vs,
            [&](int j) { const u32 w = j < 32 ? ms0 : ms1; return __any((w >> (j & 31)) & 1u) != 0; },
            [](int) { return 0; },
            [&](f32x16& p0, f32x16& p1, int j, int) {
                const int dq = t - 64 * j - 4 * hi;
                float cb = 0.f;
                if (t0w - (64 * j + 63) >= 127) cb = mytab[127];
                else bias_tile(p0, p1, dq, mytab);
                if (j == n) mask_tile(p0, p1, dq, 0x80000000u);
                const u32 w = j < 32 ? ms0 : ms1;
                if (!((w >> (j & 31)) & 1u)) { const float NEG = -__builtin_inff();
#pragma unroll
                    for (int r = 0; r < 16; ++r) { p0[r] = NEG; p1[r] = NEG; } }
                return cb;
            });
        if (chunk >= 0) { if (!split_arrive_merge(glds, wid_s, ws, 128 + g * 32 + (n & 31), chunk, cntb, o, m, l)) return; nsa_final(o, l, proj, t0w, g, hg, (const u16*)(ws + WS_MKN), 1024); }
        else nsa_accum<false>(o, l, proj, t0w, g, hg, 1, proj + C_NSAO, PP);
    }
#undef NSA_ZERO_O
}

__device__ const unsigned short ATT4_ITEMS[192] = {240, 248, 241, 249, 242, 250, 243, 251, 244, 252, 245, 253, 246, 254, 247, 255, 224, 232, 225, 233, 226, 234, 227, 235, 228, 236, 229, 237, 230, 238, 231, 239, 112, 113, 114, 115, 116, 117, 118, 119, 208, 216, 209, 217, 210, 218, 211, 219, 212, 220, 213, 221, 214, 222, 215, 223, 192, 200, 193, 201, 194, 202, 195, 203, 196, 204, 197, 205, 198, 206, 199, 207, 96, 97, 98, 99, 100, 101, 102, 103, 176, 184, 177, 185, 178, 186, 179, 187, 180, 188, 181, 189, 182, 190, 183, 191, 160, 168, 161, 169, 162, 170, 163, 171, 164, 172, 165, 173, 166, 174, 167, 175, 80, 81, 82, 83, 84, 85, 86, 87, 144, 152, 145, 153, 146, 154, 147, 155, 148, 156, 149, 157, 150, 158, 151, 159, 128, 136, 129, 137, 130, 138, 131, 139, 132, 140, 133, 141, 134, 142, 135, 143, 64, 65, 66, 67, 68, 69, 70, 71, 48, 49, 50, 51, 52, 53, 54, 55, 32, 33, 34, 35, 36, 37, 38, 39, 16, 17, 18, 19, 20, 21, 22, 23, 0, 1, 2, 3, 4, 5, 6, 7};
constexpr int N_ATT4 = 192;
__device__ const unsigned short ATT5_ITEMS[384] = {2544, 2545, 2528, 2529, 2512, 2513, 2496, 2497, 2480, 2481, 2464, 2465, 3040, 3041, 3056, 3057, 2448, 2449, 3008, 3009, 3024, 3025, 2432, 2433, 2976, 2977, 2992, 2993, 2416, 2417, 2944, 2945, 2960, 2961, 2400, 2401, 2912, 2913, 2928, 2929, 2384, 2385, 2880, 2881, 2896, 2897, 2368, 2369, 2848, 2849, 2864, 2865, 2352, 2353, 2816, 2817, 2832, 2833, 2336, 2337, 2320, 2321, 3058, 3059, 2304, 2305, 3026, 3027, 3042, 3043, 2784, 2785, 2800, 2801, 2994, 2995, 3010, 3011, 2752, 2753, 2768, 2769, 2962, 2963, 2978, 2979, 2720, 2721, 2736, 2737, 2288, 2289, 2930, 2931, 2946, 2947, 2688, 2689, 2704, 2705, 2272, 2273, 2898, 2899, 2914, 2915, 2656, 2657, 2672, 2673, 2256, 2257, 2866, 2867, 2882, 2883, 2624, 2625, 2640, 2641, 2240, 2241, 2834, 2835, 2850, 2851, 2592, 2593, 2608, 2609, 2224, 2225, 2802, 2803, 2818, 2819, 2560, 2561, 2576, 2577, 2208, 2209, 2770, 2771, 2786, 2787, 2192, 2193, 2738, 2739, 2754, 2755, 2176, 2177, 2706, 2707, 2722, 2723, 2674, 2675, 2690, 2691, 2160, 2161, 2642, 2643, 2658, 2659, 1264, 1265, 1266, 1267, 1268, 1269, 1270, 1271, 1272, 1273, 1274, 1275, 1276, 1277, 1278, 1279, 2610, 2611, 2626, 2627, 2144, 2145, 2578, 2579, 2594, 2595, 1248, 1249, 1250, 1251, 1252, 1253, 1254, 1255, 1256, 1257, 1258, 1259, 1260, 1261, 1262, 1263, 2562, 2563, 2128, 2129, 1136, 1137, 1138, 1139, 1140, 1141, 1142, 1143, 1232, 1233, 1234, 1235, 1236, 1237, 1238, 1239, 1240, 1241, 1242, 1243, 1244, 1245, 1246, 1247, 2112, 2113, 1216, 1217, 1218, 1219, 1220, 1221, 1222, 1223, 1224, 1225, 1226, 1227, 1228, 1229, 1230, 1231, 2096, 2097, 1120, 1121, 1122, 1123, 1124, 1125, 1126, 1127, 1200, 1201, 1202, 1203, 1204, 1205, 1206, 1207, 1208, 1209, 1210, 1211, 1212, 1213, 1214, 1215, 2080, 2081, 1184, 1185, 1186, 1187, 1188, 1189, 1190, 1191, 1192, 1193, 1194, 1195, 1196, 1197, 1198, 1199, 2064, 2065, 1104, 1105, 1106, 1107, 1108, 1109, 1110, 1111, 1168, 1169, 1170, 1171, 1172, 1173, 1174, 1175, 1176, 1177, 1178, 1179, 1180, 1181, 1182, 1183, 2048, 2049, 1152, 1153, 1154, 1155, 1156, 1157, 1158, 1159, 1160, 1161, 1162, 1163, 1164, 1165, 1166, 1167, 1088, 1089, 1090, 1091, 1092, 1093, 1094, 1095, 1072, 1073, 1074, 1075, 1076, 1077, 1078, 1079, 1056, 1057, 1058, 1059, 1060, 1061, 1062, 1063, 1040, 1041, 1042, 1043, 1044, 1045, 1046, 1047, 1024, 1025, 1026, 1027, 1028, 1029, 1030, 1031};
constexpr int N_ATT5 = 384;
constexpr int SPLIT_QB = 8, SPLIT_N = 32;

DI size_t score_off(int rb) { const int m = rb >> 1; return (size_t)2048 * ((rb & 1) ? (m + 1) * (m + 1) : m * (m + 1)); }
DI void idx_score_unit(unsigned char* glds, int wid_s, int rb, int kq) {
    using namespace fa;
    LAS unsigned char* lds = (LAS unsigned char*)glds; const int tid = opaque_tid(wid_s); unsigned char* const ws = (unsigned char*)(GAS unsigned char*)ldp(glds, 21);
    const int lane = tid & 63, r32 = lane & 31, hi = lane >> 5;
    const u16* proj = (const u16*)(ws + WS_PROJ);
    const int ntile = (rb >> 1) + 1, width = 64 * ntile;
    __syncthreads();
#pragma unroll
    for (int i = 0; i < 4; ++i) { const int id = tid + 512 * i, row = id >> 6, c = id & 63;
        const u32x4 v = *(const u32x4*)(proj + (size_t)(32 * rb + row) * PP + C_IDXQ + c * 8);
        *(LAS u32x4*)(lds + row * 1024 + (((c & ~7) | ((c & 7) ^ (row & 7))) << 4)) = v; }
    if (tid < 256) { const int row = tid >> 3, hh = tid & 7; ((LAS float*)(lds + 32768))[row * 8 + hh] = bf2f(proj[(size_t)(32 * rb + row) * PP + C_IDXW + hh]); }
    __syncthreads();
    float* sc = (float*)(ws + WS_SCORE) + score_off(rb) + (size_t)r32 * width + 4 * hi;
    LAS unsigned char* qbase = lds + r32 * 1024;
    const int sw = r32 & 7;
    bf16x8 kn[2][4];
    { const int j0 = kq * 8 + wid_s, jc = j0 < ntile ? j0 : 0;
#pragma unroll
      for (int half = 0; half < 2; ++half)
#pragma unroll
          for (int ks = 0; ks < 4; ++ks) kn[half][ks] = *(const bf16x8*)(proj + (size_t)(64 * jc + 32 * half + r32) * PP + C_IDXK + ks * 16 + hi * 8); }
#pragma unroll 1
    for (int j = kq * 8 + wid_s; j < ntile; j += 32) {
        asm volatile("" ::: "memory");
        bf16x8 kf[2][4];
#pragma unroll
        for (int half = 0; half < 2; ++half)
#pragma unroll
            for (int ks = 0; ks < 4; ++ks) kf[half][ks] = kn[half][ks];
        { const int jn = j + 32 < ntile ? j + 32 : j;
#pragma unroll
          for (int half = 0; half < 2; ++half)
#pragma unroll
              for (int ks = 0; ks < 4; ++ks) kn[half][ks] = *(const bf16x8*)(proj + (size_t)(64 * jn + 32 * half + r32) * PP + C_IDXK + ks * 16 + hi * 8); }
        f32x16 a0, a1;
#pragma unroll
        for (int r = 0; r < 16; ++r) { a0[r] = 0.f; a1[r] = 0.f; }
#pragma unroll 1
        for (int h = 0; h < 8; ++h) {
            const float iwh = ((const LAS float*)(lds + 32768))[r32 * 8 + h];
            f32x16 p0, p1;
#pragma unroll
            for (int r = 0; r < 16; ++r) { p0[r] = 0.f; p1[r] = 0.f; }
#pragma unroll
            for (int ks = 0; ks < 4; ++ks) {
                const bf16x8 qf = *(const LAS bf16x8*)(qbase + h * 128 + (((ks * 2 + hi) ^ sw) << 4));
                p0 = __builtin_amdgcn_mfma_f32_32x32x16_bf16(kf[0][ks], qf, p0, 0, 0, 0);
                p1 = __builtin_amdgcn_mfma_f32_32x32x16_bf16(kf[1][ks], qf, p1, 0, 0, 0);
            }
#pragma unroll
            for (int r = 0; r < 16; ++r) { a0[r] = fmaf(iwh, fmaxf(p0[r], 0.f), a0[r]); a1[r] = fmaf(iwh, fmaxf(p1[r], 0.f), a1[r]); }
        }
#pragma unroll
        for (int g4 = 0; g4 < 4; ++g4) {
            *(f32x4*)(sc + 64 * j + 8 * g4) = (f32x4){a0[4 * g4], a0[4 * g4 + 1], a0[4 * g4 + 2], a0[4 * g4 + 3]};
            *(f32x4*)(sc + 64 * j + 32 + 8 * g4) = (f32x4){a1[4 * g4], a1[4 * g4 + 1], a1[4 * g4 + 2], a1[4 * g4 + 3]};
        }
    }
}

DI int wave_total_i(int v) {
    v += __builtin_amdgcn_update_dpp(0, v, 0x111, 0xf, 0xf, false);
    v += __builtin_amdgcn_update_dpp(0, v, 0x112, 0xf, 0xf, false);
    v += __builtin_amdgcn_update_dpp(0, v, 0x114, 0xf, 0xf, false);
    v += __builtin_amdgcn_update_dpp(0, v, 0x118, 0xf, 0xf, false);
    v += __builtin_amdgcn_update_dpp(0, v, 0x142, 0xa, 0xf, false);
    v += __builtin_amdgcn_update_dpp(0, v, 0x143, 0xc, 0xf, false);
    return __builtin_amdgcn_readlane(v, 63);
}
DI void tk_cnt_ge8(int& cl, const u32* u, u32 cand) {
    asm("v_cmp_le_u32_e32 vcc, %9, %1\n\tv_addc_co_u32_e32 %0, vcc, 0, %0, vcc\n\tv_cmp_le_u32_e32 vcc, %9, %2\n\tv_addc_co_u32_e32 %0, vcc, 0, %0, vcc\n\t"
        "v_cmp_le_u32_e32 vcc, %9, %3\n\tv_addc_co_u32_e32 %0, vcc, 0, %0, vcc\n\tv_cmp_le_u32_e32 vcc, %9, %4\n\tv_addc_co_u32_e32 %0, vcc, 0, %0, vcc\n\t"
        "v_cmp_le_u32_e32 vcc, %9, %5\n\tv_addc_co_u32_e32 %0, vcc, 0, %0, vcc\n\tv_cmp_le_u32_e32 vcc, %9, %6\n\tv_addc_co_u32_e32 %0, vcc, 0, %0, vcc\n\t"
        "v_cmp_le_u32_e32 vcc, %9, %7\n\tv_addc_co_u32_e32 %0, vcc, 0, %0, vcc\n\tv_cmp_le_u32_e32 vcc, %9, %8\n\tv_addc_co_u32_e32 %0, vcc, 0, %0, vcc"
        : "+v"(cl) : "v"(u[0]), "v"(u[1]), "v"(u[2]), "v"(u[3]), "v"(u[4]), "v"(u[5]), "v"(u[6]), "v"(u[7]), "s"(cand) : "vcc"); }
DI void tk_cnt_gt(int& cl, u32 u, u32 thr) { asm("v_cmp_lt_u32_e32 vcc, %2, %1\n\tv_addc_co_u32_e32 %0, vcc, 0, %0, vcc" : "+v"(cl) : "v"(u), "s"(thr) : "vcc"); }
template <int K, int NK> struct TopkMask {
    static DI void run(const u32 (&u)[NK], u32 Tv, int exact, int need, int& run_, int lane, u32& w0, u32& w1) {
        int pred;
        if (exact) pred = u[K] >= Tv ? 1 : 0;
        else { const bool gt = u[K] > Tv, eq = u[K] == Tv; const u64 beq = __ballot(eq);
               const int rank = run_ + __popcll(beq & ((1ull << lane) - 1ull)); run_ += __popcll(beq); pred = (gt || (eq && rank < need)) ? 1 : 0; }
        asm volatile("v_cmp_ne_u32_e32 vcc, 0, %2\n\ts_nop 4\n\tv_writelane_b32 %0, vcc_lo, %3\n\tv_writelane_b32 %1, vcc_hi, %3" : "+v"(w0), "+v"(w1) : "v"(pred), "n"(K) : "vcc");
        TopkMask<K + 1, NK>::run(u, Tv, exact, need, run_, lane, w0, w1);
    }
};
template <int NK> struct TopkMask<NK, NK> { static DI void run(const u32 (&)[NK], u32, int, int, int&, int, u32&, u32&) {} };
template <int NK> DI void topk_row(const float* srow, int n, u32* mrow, int lane) {
    u32 u[NK];
#pragma unroll
    for (int k = 0; k < NK; ++k) { const int i = 64 * k + lane; const float sv = srow[i] + 0.f;
        const u32 bts = __float_as_uint(sv); const u32 key = bts ^ ((u32)((int)bts >> 31) | 0x80000000u);
        u[k] = key & ~(u32)((n - 1 - i) >> 31); }
    u32 kmax = 0u;
#pragma unroll
    for (int k = 0; k < NK; ++k) kmax = kmax > u[k] ? kmax : u[k];
#pragma unroll
    for (int off = 32; off; off >>= 1) { const u32 t = (u32)__shfl_xor((int)kmax, off); kmax = kmax > t ? kmax : t; }
    u32 lo = 0u, hi = __builtin_amdgcn_readfirstlane(kmax) + 1u; int clo = n, chi = 0;
    u32 Tv = 0u; int exact = 0, it = 0;
#pragma unroll 1
    while (hi - lo > 1u) {
        u32 mid;
        if (it & 1) mid = lo + ((hi - lo) >> 1);
        else { const unsigned long long w = (unsigned long long)(hi - lo) * (unsigned)(clo - 256) / (unsigned)(clo - chi); mid = lo + (u32)w; }
        if (mid <= lo) mid = lo + 1u; if (mid >= hi) mid = hi - 1u;
        ++it;
        const u32 cand = __builtin_amdgcn_readfirstlane(mid); int cl = 0;
#pragma unroll
        for (int k = 0; k < NK; k += 8) tk_cnt_ge8(cl, u + k, cand);
        const int cnt = wave_total_i(cl);
        if (cnt == 256) { Tv = cand; exact = 1; break; }
        if (cnt > 256) { lo = cand; clo = cnt; } else { hi = cand; chi = cnt; }
    }
    if (!exact) Tv = lo;
    int need = 0x7fffffff, run = 0;
    if (!exact) { int cl = 0; const u32 thr = __builtin_amdgcn_readfirstlane(Tv);
#pragma unroll
        for (int k = 0; k < NK; ++k) tk_cnt_gt(cl, u[k], thr);
        need = 256 - wave_total_i(cl); }
    u32 w0 = 0u, w1 = 0u;
    TopkMask<0, NK>::run(u, Tv, exact, need, run, lane, w0, w1);
    uint2 w; w.x = lane < NK ? w0 : 0u; w.y = lane < NK ? w1 : 0u;
    *(uint2*)(mrow + 2 * lane) = w;
}
__global__ void __launch_bounds__(512, 2) mega(Params p) {
    extern __shared__ __attribute__((aligned(16))) unsigned char lds[];
    LAS unsigned char* llds = (LAS unsigned char*)lds;
    volatile LAS unsigned* xbw = (volatile LAS unsigned*)(lds + LDS_MISC);
    const int wid_s = __builtin_amdgcn_readfirstlane((int)(threadIdx.x >> 6));
    if (threadIdx.x == 0) {
        xbw[0] = 0u; xbw[1] = 0u; xbw[2] = 0u; xbw[3] = 0u;
        volatile LAS u64* pt = (volatile LAS u64*)(lds + LDS_MISC + 64);
        pt[0] = (u64)p.x; pt[1] = (u64)p.mem; pt[2] = (u64)p.pos; pt[3] = (u64)p.rel_bias; pt[4] = (u64)p.gains; pt[5] = (u64)p.w_in; pt[6] = (u64)p.qnorm; pt[7] = (u64)p.kvnorm;
        pt[8] = (u64)p.w_uq; pt[9] = (u64)p.w_ukv; pt[10] = (u64)p.cmp_pos; pt[11] = (u64)p.cmp_w1; pt[12] = (u64)p.cmp_w2; pt[13] = (u64)p.w_branch; pt[14] = (u64)p.w_out;
        pt[15] = (u64)p.cwq; pt[16] = (u64)p.cwkv; pt[17] = (u64)p.cwo; pt[18] = (u64)p.w1; pt[19] = (u64)p.w2; pt[20] = (u64)p.out; pt[21] = (u64)p.ws;
    }
    __syncthreads();
    XcdBarrier bar = xcd_barrier_post((unsigned*)(p.ws + WS_CTL) + 4096, xbw);
    using pg8::f32x4; using pg8::u32x4;
#define LP(T_, idx) ((T_)(GAS unsigned char*)ldp(lds, idx))
#define P_X LP(const float*, 0)
#define P_MEM LP(const float*, 1)
#define P_POS LP(const int*, 2)
#define P_RELB LP(const float*, 3)
#define P_GAINS LP(const float*, 4)
#define P_WIN LP(const float*, 5)
#define P_QNORM LP(const float*, 6)
#define P_KVNORM LP(const float*, 7)
#define P_WUQ LP(const float*, 8)
#define P_WUKV LP(const float*, 9)
#define P_CPOS LP(const float*, 10)
#define P_CW1 LP(const float*, 11)
#define P_CW2 LP(const float*, 12)
#define P_WBR LP(const float*, 13)
#define P_WOUT LP(const float*, 14)
#define P_CWQ LP(const float*, 15)
#define P_CWKV LP(const float*, 16)
#define P_CWO LP(const float*, 17)
#define P_W1 LP(const float*, 18)
#define P_W2 LP(const float*, 19)
#define P_OUT LP(float*, 20)
#define HB ((u16*)(ws + WS_HB))
#define MEMN ((u16*)(ws + WS_MEMN))
#define CKV ((u16*)(ws + WS_CKV))
#define MERGED ((u16*)(ws + WS_MERGED))
#define PROJ ((u16*)(ws + WS_PROJ))
#define GATES ((u16*)(ws + WS_GATES))
#define QNRM ((u16*)(ws + WS_QNRM))
#define KVNRM ((u16*)(ws + WS_KVNRM))
#define MQN ((u16*)(ws + WS_MQN))
#define MQR ((u16*)(ws + WS_MQR))
#define MKN ((u16*)(ws + WS_MKN))
#define MV ((u16*)(ws + WS_MV))
#define MKR ((u16*)(ws + WS_MKR))
#define CB ((u16*)(ws + WS_CBK))
#define CPART ((float*)(ws + WS_CPART))
#define KCMP ((u16*)(ws + WS_KCMP))
#define VCMP ((u16*)(ws + WS_VCMP))
#define BITM ((u32*)(ws + WS_BITM))
#define F32 ((float*)(ws + WS_F32))
#define CQ ((u16*)(ws + WS_CQ))
#define U ((u16*)(ws + WS_U))

    int ph = 0;
#define PH_BEGIN(kind) if (ph >= p.ph_lo && ph < p.ph_hi) { constexpr int nrep_ = PROBE_REP_H[kind]; for (int rep_ = 0; rep_ < nrep_; ++rep_) { const int tid = opaque_tid(wid_s), lane = tid & 63, wv = tid >> 6; float* wsl = (float*)(lds + wv * WSLOT); unsigned char* const ws = LP(unsigned char*, 21); (void)lane; (void)wsl; (void)ws;
#define PH_END   if (ph + 1 < p.ph_hi || rep_ + 1 < nrep_) xcd_barrier(bar); } } ++ph;

    for (int l = 0; l < DEPTH; ++l) {
#define GL (P_GAINS + (size_t)l * 7 * 1024)
#define XIN ((l == 0) ? P_X : (const float*)P_OUT)
        PH_BEGIN(0)
            {
                float* scr = (float*)(lds + wv * 16896);
                const int gw = blockIdx.x * 8 + wv, ngw = gridDim.x * 8;
                int it0 = 0;
                { const float* W = P_WIN + (size_t)l * 1024 * D_IN; u16* WT = (u16*)(ws + WT_IN);
                  it0 = pg8::conv_matrix(W, D_IN, 1024, 10240, [&](int n) { return n < PP ? proj_src(n) : 6944 + (n - PP); },
                                         [&](int n, int k) { return WT + (size_t)n * 1024 + k; }, scr, lane, gw, ngw, it0); }
                { const float* W = P_WUQ + (size_t)l * 384 * 1536; u16* WT = (u16*)(ws + WT_UQ);
                  it0 = pg8::conv_matrix(W, 1536, 384, 1536, [&](int n) { return n < 1024 ? (n >> 7) * 192 + (n & 127) : ((n - 1024) >> 6) * 192 + 128 + ((n - 1024) & 63); },
                                         [&](int n, int k) { return WT + (size_t)n * 384 + k; }, scr, lane, gw, ngw, it0); }
                { const float* W = P_WUKV + (size_t)l * 256 * 2048; u16* WT = (u16*)(ws + WT_UKV);
                  it0 = pg8::conv_matrix(W, 2048, 256, 2048, [&](int n) { return n; }, [&](int n, int k) { return WT + (size_t)n * 256 + k; }, scr, lane, gw, ngw, it0); }
                for (int kv = 0; kv < 2; ++kv) { const float* W = P_CW1 + ((size_t)l * 2 + kv) * 4096 * 256; u16* WT = (u16*)(ws + WT_C1);
                  it0 = pg8::conv_matrix(W, 256, 4096, 256, [&](int n) { return n; },
                                         [&](int n, int k) { return WT + ((size_t)((kv * 8 + (k >> 9)) * 256 + n)) * 512 + (k & 511); }, scr, lane, gw, ngw, it0); }
                for (int i = 0; i < 3; ++i) { const float* W = P_WBR + ((size_t)l * 3 + i) * 1024 * 1024; u16* WT = (u16*)(ws + WT_BR) + (size_t)i * 1024 * 1024;
                  it0 = pg8::conv_matrix(W, 1024, 1024, 1024, [&](int n) { return n; }, [&](int n, int k) { return WT + (size_t)n * 1024 + k; }, scr, lane, gw, ngw, it0); }
                { const float* W = P_WOUT + (size_t)l * 1024 * 1024; u16* WT = (u16*)(ws + WT_OUT);
                  it0 = pg8::conv_matrix(W, 1024, 1024, 1024, [&](int n) { return n; }, [&](int n, int k) { return WT + (size_t)n * 1024 + k; }, scr, lane, gw, ngw, it0); }
                { const float* W = P_CWKV + (size_t)l * 1024 * 2048; u16* WT = (u16*)(ws + WT_CKV);
                  it0 = pg8::conv_matrix(W, 2048, 1024, 2048, [&](int n) { return n; }, [&](int n, int k) { return WT + (size_t)n * 1024 + k; }, scr, lane, gw, ngw, it0); }
            }
            if (l == 0) ph_norm_rows(XIN, GL, HB, T, tid);
            ph_norm_rows(P_MEM, GL + 3 * 1024, MEMN, 1024, tid);
            if (l == 0) {
                float2* rt = (float2*)(ws + WS_ROPE); const int* posp = P_POS;
                for (int e = blockIdx.x * 512 + tid; e < T * 32; e += gridDim.x * 512) {
                    const float invf = powf(10000.f, -(float)(e & 31) * (1.f / 32.f));
                    float sn, cs; sincosf((float)posp[e >> 5] * invf, &sn, &cs);
                    rt[e] = make_float2(cs, sn);
                }
            }
        PH_END
        for (int b = 0; b < NB; ++b) {
            PH_BEGIN(1)
                {
                    pg8::Sched1 S; S.init(HB + (size_t)b * SEQ * 1024, 1024, ws + WT_IN, 1024, SEQ, PP, 0);
                    auto E = pg8::epi_b16([&](int row, int col, f32x4 v0, f32x4 v1) { *(u32x4*)(PROJ + (size_t)row * PP + col) = pg8::pack8(v0, v1); });
                    pg8::gemm_phase(llds, 1024, 1024, 1024, S, E, wid_s);
                }
                if (b == 0) {
                    pg8::Sched1 S; S.init(MEMN, 1024, ws + WT_CKV, 1024, 1024, 2048, 192);
                    auto E = pg8::epi_b16([&](int row, int col, f32x4 v0, f32x4 v1) { *(u32x4*)(CKV + (size_t)row * 2048 + col) = pg8::pack8(v0, v1); });
                    pg8::gemm_phase(llds, 1024, 1024, 1024, S, E, wid_s);
                }
            PH_END
            PH_BEGIN(2)
                {
                    const float* qg = P_QNORM + l * 384; const float* kg = P_KVNORM + l * 256;
                    for (int r = blockIdx.x * 8 + wv; r < SEQ; r += gridDim.x * 8) {
                        const u16* pr = PROJ + (size_t)r * PP;
                        float v[6]; float ss = 0.f;
#pragma unroll
                        for (int i = 0; i < 6; ++i) { v[i] = bf2f(pr[C_QLAT + lane + 64 * i]); ss += v[i] * v[i]; }
                        ss = wave_sum(ss); float rs = rsqrtf(ss * (1.f / 384.f) + EPS);
#pragma unroll
                        for (int i = 0; i < 6; ++i) QNRM[(size_t)r * 384 + lane + 64 * i] = (u16)f2bf(v[i] * rs * qg[lane + 64 * i]);
                        ss = 0.f;
#pragma unroll
                        for (int i = 0; i < 4; ++i) { v[i] = bf2f(pr[C_KVLAT + lane + 64 * i]); ss += v[i] * v[i]; }
                        ss = wave_sum(ss); rs = rsqrtf(ss * (1.f / 256.f) + EPS);
#pragma unroll
                        for (int i = 0; i < 4; ++i) KVNRM[(size_t)r * 256 + lane + 64 * i] = (u16)f2bf(v[i] * rs * kg[lane + 64 * i]);
                        if (lane < 32) {
                            const float2 csn = ((const float2*)(ws + WS_ROPE))[(size_t)(b * SEQ + r) * 32 + lane];
                            const float x1 = bf2f(pr[C_KROPE + lane]), x2 = bf2f(pr[C_KROPE + 32 + lane]);
                            MKR[(size_t)r * 64 + lane] = (u16)f2bf(x1 * csn.x - x2 * csn.y);
                            MKR[(size_t)r * 64 + 32 + lane] = (u16)f2bf(x2 * csn.x + x1 * csn.y);
                        }
                    }
                    const float* cpos = P_CPOS + (size_t)l * 2 * 32 * 128;
                    for (size_t e = (size_t)blockIdx.x * 512 + tid; e < (size_t)512 * 4096; e += (size_t)gridDim.x * 512) {
                        const int row = (int)(e >> 12), col = (int)(e & 4095), c = row >> 1, gg = row & 1, ll = col >> 7, d = col & 127;
                        float vk = 0.f, vv = 0.f;
                        if (row < 510) {
                            const u16* pr = PROJ + (size_t)(16 * c + ll) * PP + gg * 128 + d;
                            vk = bf2f(pr[C_NKC]) + cpos[ll * 128 + d];
                            vv = bf2f(pr[C_NVC]) + cpos[32 * 128 + ll * 128 + d];
                        }
                        const size_t de = ((size_t)(col >> 9) * 512 + row) * 512 + (col & 511);
                        CB[de] = (u16)f2bf(vk); CB[(size_t)8 * 512 * 512 + de] = (u16)f2bf(vv);
                    }
                }
            PH_END
            PH_BEGIN(3)
                {
                    pg8::Sched1 S; S.init(QNRM, 384, ws + WT_UQ, 384, SEQ, 1536, 0);
                    auto E = pg8::epi_b16([&](int row, int col, f32x4 v0, f32x4 v1) {
                        u16* d = col < 1024 ? MQN + (size_t)row * 1024 + col : MQR + (size_t)row * 512 + (col - 1024);
                        *(u32x4*)d = pg8::pack8(v0, v1); });
                    pg8::gemm_phase(llds, 384, 384, 384, S, E, wid_s);
                    pg8::Unit u0;
                    if (S.next(0, u0) && u0.pn >= 4) {
                        asm volatile("s_waitcnt vmcnt(0)" ::: "memory");
                        __syncthreads();
                        const float2* rt = (const float2*)(ws + WS_ROPE) + (size_t)(b * SEQ + 256 * u0.pm) * 32;
                        u16* qt = MQR + (size_t)(256 * u0.pm) * 512 + (u0.pn - 4) * 256;
#pragma unroll 2
                        for (int e = opaque_tid(wid_s); e < 256 * 16; e += 512) {
                            const int row = e >> 4, hh = (e >> 2) & 3, f0 = (e & 3) * 8;
                            u16* q = qt + (size_t)row * 512 + hh * 64 + f0;
                            const u32x4 a = *(const u32x4*)q, c2 = *(const u32x4*)(q + 32);
                            const f32x4* tp = (const f32x4*)(rt + row * 32 + f0);
                            u32x4 oa, oc;
#pragma unroll
                            for (int i = 0; i < 4; ++i) {
                                const f32x4 cs = tp[i];
                                const float x1a = bf2f(a[i] & 0xffffu), x1b = bf2f(a[i] >> 16), x2a = bf2f(c2[i] & 0xffffu), x2b = bf2f(c2[i] >> 16);
                                oa[i] = pg8::pk2(x1a * cs[0] - x2a * cs[1], x1b * cs[2] - x2b * cs[3]);
                                oc[i] = pg8::pk2(x2a * cs[0] + x1a * cs[1], x2b * cs[2] + x1b * cs[3]);
                            }
                            *(u32x4*)q = oa; *(u32x4*)(q + 32) = oc;
                        }
                    }
                }
                {
                    pg8::Sched1 S; S.init(KVNRM, 256, ws + WT_UKV, 256, SEQ, 2048, 96);
                    auto E = pg8::epi_b16([&](int row, int col, f32x4 v0, f32x4 v1) {
                        u16* d = ((col & 128) ? MV : MKN) + (size_t)row * 1024 + (col >> 8) * 128 + (col & 127);
                        *(u32x4*)d = pg8::pack8(v0, v1); });
                    pg8::gemm_phase(llds, 256, 256, 256, S, E, wid_s);
                }
                {
                    pg8::SchedCmp S; S.init(CB, ws + WT_C1, 224);
                    auto E = pg8::epi_f32([&](int row, int col, f32x4 v) { *(f32x4*)(CPART + (size_t)row * 256 + col) = v; });
                    pg8::gemm_phase(llds, 512, 512, 512, S, E, wid_s);
                }
                for (int c = blockIdx.x; c < 256; c += gridDim.x) {
                    { const int rb = 127 - (c >> 2); if (rb >= 8) idx_score_unit(lds, wid_s, rb, c & 3); }
                    { const int u2 = 511 - c, rb = 127 - (u2 >> 2); if (rb >= 8) idx_score_unit(lds, wid_s, rb, u2 & 3); }
                }
            PH_END
            PH_BEGIN(4)
                {
                    unsigned* qctr = (unsigned*)(ws + WS_CTL) + 16384 + 64 * (l * NB + b);
                    volatile LAS int* qslot = (volatile LAS int*)(lds + LDS_MISC + 16);
                    unsigned* cntb = (unsigned*)(ws + WS_CTL) + 65536 + 256 * (l * NB + b);
                    for (;;) {
                        __syncthreads();
                        if (opaque_tid(wid_s) == 0) *qslot = (int)atomicAdd(qctr, 1u);
                        __syncthreads();
                        const int item = __builtin_amdgcn_readfirstlane(*qslot);
                        if (item >= 512 + 64 + N_ATT4 + 192) break;
                        if (item < 512) {
                            const int rr = 8 * (511 - item) + wid_s, n = rr + 1;
                            const int lane2 = opaque_tid(0);
                            u32* mrow = BITM + (size_t)rr * 128;
                            if (n <= 256) {
                                for (int w = lane2; w < 128; w += 64) { const int lo = 32 * w; mrow[w] = (lo + 32 <= n) ? 0xffffffffu : (lo >= n ? 0u : ((1u << (n - lo)) - 1u)); }
                            } else {
                                const int rb = rr >> 5, width = 64 * ((rb >> 1) + 1);
                                const float* srow = (const float*)(ws + WS_SCORE) + score_off(rb) + (size_t)(rr & 31) * width;
                                if (n <= 512) topk_row<8>(srow, n, mrow, lane2);
                                else if (n <= 1024) topk_row<16>(srow, n, mrow, lane2);
                                else if (n <= 1536) topk_row<24>(srow, n, mrow, lane2);
                                else if (n <= 2048) topk_row<32>(srow, n, mrow, lane2);
                                else if (n <= 2560) topk_row<40>(srow, n, mrow, lane2);
                                else if (n <= 3072) topk_row<48>(srow, n, mrow, lane2);
                                else if (n <= 3584) topk_row<56>(srow, n, mrow, lane2);
                                else topk_row<64>(srow, n, mrow, lane2);
                            }
                        } else if (item < 576) {
                            {
                                const int it32 = item - 512, kv = it32 >> 5, r0 = (it32 & 31) * 32;
                                const int tid2 = opaque_tid(wid_s), lane2 = tid2 & 63;
                                const float* W2 = P_CW2 + ((size_t)l * 2 + kv) * 256 * 128;
                                float* w2s = (float*)lds;
#pragma unroll 4
                                for (int i = 0; i < 16; ++i) ((f32x4*)w2s)[tid2 + 512 * i] = ((const f32x4*)W2)[tid2 + 512 * i];
                                float* hid = (float*)(lds + 131072 + wid_s * 1024);
                                __syncthreads();
#pragma unroll 1
                                for (int rr4 = 0; rr4 < 4; ++rr4) {
                                    const int row = r0 + wid_s * 4 + rr4;
                                    u16* dst = (kv ? VCMP : KCMP) + (size_t)row * 128;
                                    if (row >= 510) { *(u32*)(dst + lane2 * 2) = 0u; continue; }
                                    float h4[4] = {0.f, 0.f, 0.f, 0.f};
#pragma unroll
                                    for (int ch = 0; ch < 8; ++ch) { const f32x4 pv = *(const f32x4*)(CPART + ((size_t)(kv * 8 + ch) * 512 + row) * 256 + lane2 * 4);
                                        h4[0] += pv[0]; h4[1] += pv[1]; h4[2] += pv[2]; h4[3] += pv[3]; }
#pragma unroll
                                    for (int j = 0; j < 4; ++j) hid[lane2 * 4 + j] = gelu_tanh(h4[j]);
                                    float o0 = 0.f, o1 = 0.f;
#pragma unroll 8
                                    for (int j = 0; j < 256; ++j) { const float hj = hid[j]; o0 = fmaf(hj, w2s[j * 128 + lane2], o0); o1 = fmaf(hj, w2s[j * 128 + 64 + lane2], o1); }
                                    dst[lane2] = (u16)f2bf(o0); dst[64 + lane2] = (u16)f2bf(o1);
                                }
                            }
                        } else if (item < 576 + N_ATT4) {
                            const int code = ATT4_ITEMS[item - 576], xx = (code >> 4) & 63, yy = code & 15;
                            mla_unit(lds, wid_s, yy & 7, xx, xx >= SPLIT_QB ? (yy >> 3) : -1, cntb);
                        } else {
                            const int uu = item - 576 - N_ATT4, pm = uu / 12, pn = uu % 12;
                            pg8::SchedOne S{(const char*)(HB + ((size_t)b * SEQ + 256 * pm) * 1024), (const char*)(ws + WT_IN) + (size_t)(PP + 256 * pn) * 1024 * 2, pm, pn};
                            auto E = pg8::epi_b16([&](int row, int col, f32x4 v0, f32x4 v1) {
                                f32x4 a, c2;
#pragma unroll
                                for (int j = 0; j < 4; ++j) { a[j] = sigmoidf_(v0[j]); c2[j] = sigmoidf_(v1[j]); }
                                *(u32x4*)(GATES + (size_t)row * 3072 + col) = pg8::pack8(a, c2); });
                            pg8::gemm_phase(llds, 1024, 1024, 1024, S, E, wid_s);
                        }
                    }
                    __syncthreads();
                }
            PH_END
            PH_BEGIN(5)
                {
                    float* sc = wsl;
                    float* qs = wsl + 4096;
                    {
                        unsigned* qctr = (unsigned*)(ws + WS_CTL) + 16384 + 64 * (8 + l * NB + b);
                        volatile LAS int* qslot = (volatile LAS int*)(lds + LDS_MISC + 16);
                        for (;;) {
                            __syncthreads();
                            if (opaque_tid(wid_s) == 0) *qslot = (int)atomicAdd(qctr, 1u);
                            __syncthreads();
                            const int item = __builtin_amdgcn_readfirstlane(*qslot);
                            if (item >= N_ATT5) break;
                            const int code = ATT5_ITEMS[item], ty = code >> 10, xx = (code >> 4) & 63, yy = code & 15;
                            unsigned* cntb = (unsigned*)(ws + WS_CTL) + 65536 + 256 * (l * NB + b);
                            if (ty == 1) dsa_unit(lds, wid_s, yy & 7, xx, xx >= SPLIT_QB ? (yy >> 3) : -1, cntb);
                            else nsa_unit(lds, wid_s, yy & 1, xx, xx >= SPLIT_N ? ((yy >> 1) & 1) : -1, cntb, (unsigned*)(ws + WS_CTL) + 72000 + 64 * (l * NB + b));
                        }
                        __syncthreads();
                    }
                }
            PH_END
            PH_BEGIN(6)
                for (int i = 0; i < 3; ++i) {
                    const u16* A = i == 0 ? MQN : (i == 1 ? PROJ + C_DSAQ : PROJ + C_NSAO);
                    const int lda = i == 0 ? 1024 : PP;
                    pg8::Sched1 S; S.init(A, lda, ws + WT_BR + (size_t)i * 2 * MiB, 1024, SEQ, 1024, 64 * i);
                    auto E = pg8::epi_b16([&](int row, int col, f32x4 v0, f32x4 v1) {
                        u16* gp = GATES + (size_t)row * 3072 + i * 1024 + col; const u32x4 gq = *(const u32x4*)gp;
                        const f32x4 a = {bf2f(gq.x & 0xffffu), bf2f(gq.x >> 16), bf2f(gq.y & 0xffffu), bf2f(gq.y >> 16)};
                        const f32x4 c2 = {bf2f(gq.z & 0xffffu), bf2f(gq.z >> 16), bf2f(gq.w & 0xffffu), bf2f(gq.w >> 16)};
                        *(u32x4*)gp = pg8::pack8(a * v0, c2 * v1); });
                    pg8::gemm_phase(llds, 1024, lda, 1024, S, E, wid_s);
                }
            PH_END
            PH_BEGIN(7)
                for (size_t e = (size_t)blockIdx.x * 512 + tid; e < (size_t)SEQ * 128; e += (size_t)gridDim.x * 512) {
                    const size_t m = e >> 7, n = (e & 127) * 8; const u16* gp = GATES + m * 3072 + n;
                    const u32x4 a = *(const u32x4*)gp, b2 = *(const u32x4*)(gp + 1024), c = *(const u32x4*)(gp + 2048);
                    u32x4 o4;
#pragma unroll
                    for (int i = 0; i < 4; ++i) o4[i] = pg8_pk2(bf2f(a[i] & 0xffffu) + bf2f(b2[i] & 0xffffu) + bf2f(c[i] & 0xffffu), bf2f(a[i] >> 16) + bf2f(b2[i] >> 16) + bf2f(c[i] >> 16));
                    *(u32x4*)(MERGED + ((size_t)b * SEQ + m) * 1024 + n) = o4;
                }
            PH_END
        }
        PH_BEGIN(8)
            { pg8::Sched1 S; S.init(MERGED, 1024, ws + WT_OUT, 1024, T, 1024, 0);
              auto E = pg8::epi_f32([&](int row, int col, f32x4 v) { *(f32x4*)(F32 + (size_t)row * 1024 + col) = v; });
              pg8::gemm_phase(llds, 1024, 1024, 1024, S, E, wid_s); }
        PH_END
        PH_BEGIN(9)
            {
                float* scr = (float*)(lds + wv * 16896);
                const int gw = blockIdx.x * 8 + wv, ngw = gridDim.x * 8;
                int it0 = 0;
                { const float* W = P_CWQ + (size_t)l * 1024 * 1024; u16* WT = (u16*)(ws + WT_CQ);
                  it0 = pg8::conv_matrix(W, 1024, 1024, 1024, [&](int n) { return n; }, [&](int n, int k) { return WT + (size_t)n * 1024 + k; }, scr, lane, gw, ngw, it0); }
                { const float* W = P_CWO + (size_t)l * 1024 * 1024; u16* WT = (u16*)(ws + WT_CO);
                  it0 = pg8::conv_matrix(W, 1024, 1024, 1024, [&](int n) { return n; }, [&](int n, int k) { return WT + (size_t)n * 1024 + k; }, scr, lane, gw, ngw, it0); }
                { const float* W = P_W1 + (size_t)l * 1024 * 4096; u16* WT = (u16*)(ws + WT_W1);
                  it0 = pg8::conv_matrix(W, 4096, 1024, 4096, [&](int n) { return n; }, [&](int n, int k) { return WT + (size_t)n * 1024 + k; }, scr, lane, gw, ngw, it0); }
                { const float* W = P_W2 + (size_t)l * 4096 * 1024; u16* WT = (u16*)(ws + WT_W2);
                  it0 = pg8::conv_matrix(W, 1024, 4096, 1024, [&](int n) { return n; }, [&](int n, int k) { return WT + (size_t)n * 4096 + k; }, scr, lane, gw, ngw, it0); }
            }
            ph_resid_norm(F32, GL + 1 * 1024, XIN, P_OUT, GL + 2 * 1024, HB, T, tid);
        PH_END
        PH_BEGIN(10)
            { pg8::Sched1 S; S.init(HB, 1024, ws + WT_CQ, 1024, T, 1024, 0);
              auto E = pg8::epi_b16([&](int row, int col, f32x4 v0, f32x4 v1) { *(u32x4*)(CQ + (size_t)row * 1024 + col) = pg8::pack8(v0, v1); });
              pg8::gemm_phase(llds, 1024, 1024, 1024, S, E, wid_s); }
        PH_END
        PH_BEGIN(11)
            for (int u = blockIdx.x; u < NB * 4 * 16; u += gridDim.x) cross_unit(lds, wid_s, u >> 6, (u >> 4) & 3, u & 15);
        PH_END
        PH_BEGIN(12)
            { pg8::Sched1 S; S.init(CQ, 1024, ws + WT_CO, 1024, T, 1024, 0);
              auto E = pg8::epi_f32([&](int row, int col, f32x4 v) { *(f32x4*)(F32 + (size_t)row * 1024 + col) = v; });
              pg8::gemm_phase(llds, 1024, 1024, 1024, S, E, wid_s); }
        PH_END
        PH_BEGIN(13)
            ph_resid_norm(F32, GL + 4 * 1024, P_OUT, P_OUT, GL + 5 * 1024, HB, T, tid);
        PH_END
        PH_BEGIN(14)
            { pg8::Sched1 S; S.init(HB, 1024, ws + WT_W1, 1024, T, 4096, 0);
              auto E = pg8::epi_b16([&](int row, int col, f32x4 v0, f32x4 v1) {
                  f32x4 a, c2;
#pragma unroll
                  for (int j = 0; j < 4; ++j) { const float r0 = fmaxf(v0[j], 0.f), r1 = fmaxf(v1[j], 0.f); a[j] = r0 * r0; c2[j] = r1 * r1; }
                  *(u32x4*)(U + (size_t)row * 4096 + col) = pg8::pack8(a, c2); });
              pg8::gemm_phase(llds, 1024, 1024, 1024, S, E, wid_s); }
        PH_END
        PH_BEGIN(15)
            { pg8::Sched1 S; S.init(U, 4096, ws + WT_W2, 4096, T, 1024, 0);
              auto E = pg8::epi_f32([&](int row, int col, f32x4 v) { *(f32x4*)(F32 + (size_t)row * 1024 + col) = v; });
              pg8::gemm_phase(llds, 4096, 4096, 4096, S, E, wid_s); }
        PH_END
        PH_BEGIN(16)
            ph_resid_norm(F32, GL + 6 * 1024, P_OUT, P_OUT, (l + 1 < DEPTH) ? P_GAINS + (size_t)(l + 1) * 7 * 1024 : (const float*)nullptr, HB, T, tid);
        PH_END
    }
}

constexpr int NPHASES = DEPTH * (1 + NB * 7 + 9);

extern "C" void kernel_launch(void* const* d_in, const int* in_sizes, int n_in, void* d_out, int out_size, void* d_ws, size_t ws_size,
                              hipStream_t stream) {
    (void)in_sizes; (void)out_size;
    if (n_in != 20 || ws_size < WS_END) { fprintf(stderr, "kernel_launch: bad n_in %d or ws_size %zu < %zu\n", n_in, ws_size, (size_t)WS_END); return; }
    static int grid = 0;
    if (!grid) {
        hipError_t e = hipFuncSetAttribute((const void*)mega, hipFuncAttributeMaxDynamicSharedMemorySize, LDS_BYTES);
        if (e != hipSuccess) fprintf(stderr, "hipFuncSetAttribute: %s\n", hipGetErrorString(e));
        int dev = 0, cus = 0, per_cu = 0;
        (void)hipGetDevice(&dev);
        (void)hipDeviceGetAttribute(&cus, hipDeviceAttributeMultiprocessorCount, dev);
        (void)hipOccupancyMaxActiveBlocksPerMultiprocessor(&per_cu, mega, 512, LDS_BYTES);
        if (cus <= 0) cus = 256;
        if (per_cu < 1) { fprintf(stderr, "occupancy query says %d blocks per CU\n", per_cu); per_cu = 1; }
        grid = cus;
    }
    (void)hipMemsetAsync((unsigned char*)d_ws + WS_CTL, 0, CTL_BYTES, stream);
    Params p; memset(&p, 0, sizeof(p));
    p.x = (const float*)d_in[0]; p.mem = (const float*)d_in[1]; p.pos = (const int*)d_in[2]; p.rel_bias = (const float*)d_in[3];
    p.gains = (const float*)d_in[4]; p.w_in = (const float*)d_in[5]; p.qnorm = (const float*)d_in[6]; p.kvnorm = (const float*)d_in[7];
    p.w_uq = (const float*)d_in[8]; p.w_ukv = (const float*)d_in[9]; p.cmp_pos = (const float*)d_in[10]; p.cmp_w1 = (const float*)d_in[11];
    p.cmp_w2 = (const float*)d_in[12]; p.w_branch = (const float*)d_in[13]; p.w_out = (const float*)d_in[14]; p.cwq = (const float*)d_in[15];
    p.cwkv = (const float*)d_in[16]; p.cwo = (const float*)d_in[17]; p.w1 = (const float*)d_in[18]; p.w2 = (const float*)d_in[19];
    p.out = (float*)d_out; p.ws = (unsigned char*)d_ws;
#if MK_MULTI_LAUNCH
    for (int ph = 0; ph < NPHASES; ++ph) { p.ph_lo = ph; p.ph_hi = ph + 1; hipLaunchKernelGGL(mega, dim3(grid), dim3(512), LDS_BYTES, stream, p); }
#else
    p.ph_lo = 0; p.ph_hi = NPHASES;
    hipLaunchKernelGGL(mega, dim3(grid), dim3(512), LDS_BYTES, stream, p);
#endif
}
```

```cpp
#include <hip/hip_runtime.h>
#include <cstdio>
#include <cstdint>
#include <cstring>

#ifndef MK_MULTI_LAUNCH
#define MK_MULTI_LAUNCH 0
#endif

typedef unsigned short u16;
typedef unsigned int u32;
typedef unsigned long long u64;
#define DI __device__ __forceinline__
#define LAS __attribute__((address_space(3)))
#define GAS __attribute__((address_space(1)))

constexpr int T = 16384, SEQ = 4096, NB = 4, DM = 1024, DEPTH = 2, D_IN = 10016;
constexpr int PP = 7168;
constexpr int C_QLAT = 0, C_KVLAT = 384, C_KROPE = 640, C_IDXK = 704, C_IDXQ = 768, C_DSAQ = 1280, C_DSAK = 2304, C_DSAV = 3328,
              C_NSAQ = 4352, C_NKC = 5376, C_NVC = 5632, C_NKS = 5888, C_NVS = 6144, C_NKW = 6400, C_NVW = 6656, C_IDXW = 6912,
              C_NGATE = 6920, C_END = 6944, C_NSAO = 0;
constexpr float EPS = 1e-6f;

constexpr size_t MiB = 1u << 20;
constexpr size_t WS_CTL = 0, CTL_BYTES = 1 * MiB;
constexpr size_t WS_WB = 1 * MiB;
constexpr size_t WT_IN = WS_WB, WT_UQ = WS_WB + 20 * MiB, WT_UKV = WS_WB + 21 * MiB + 256 * 1024, WT_C1 = WS_WB + 22 * MiB + 256 * 1024,
                 WT_BR = WS_WB + 26 * MiB + 256 * 1024, WT_OUT = WS_WB + 32 * MiB + 256 * 1024, WT_CKV = WS_WB + 34 * MiB + 256 * 1024;
constexpr size_t WT_CQ = WS_WB, WT_CO = WS_WB + 2 * MiB, WT_W1 = WS_WB + 4 * MiB, WT_W2 = WS_WB + 12 * MiB;
constexpr size_t WS_HB = 41 * MiB;
constexpr size_t WS_MEMN = 73 * MiB;
constexpr size_t WS_CKV = 75 * MiB;
constexpr size_t WS_ROPE = 79 * MiB;
constexpr size_t WS_A = 83 * MiB;
constexpr size_t WS_MERGED = WS_A;
constexpr size_t WS_PROJ = WS_A + 32 * MiB;
constexpr size_t WS_GATES = WS_A + 88 * MiB;
constexpr size_t WS_QNRM = WS_A + 112 * MiB;
constexpr size_t WS_KVNRM = WS_A + 115 * MiB;
constexpr size_t WS_MQN = WS_A + 117 * MiB;
constexpr size_t WS_MQR = WS_A + 125 * MiB;
constexpr size_t WS_MKN = WS_A + 129 * MiB;
constexpr size_t WS_MV = WS_A + 137 * MiB;
constexpr size_t WS_MKR = WS_A + 145 * MiB;
constexpr size_t WS_CBK = WS_A + 146 * MiB;
constexpr size_t WS_CH = WS_A + 154 * MiB;
constexpr size_t WS_KCMP = WS_A + 155 * MiB;
constexpr size_t WS_VCMP = WS_A + 155 * MiB + 512 * 1024;
constexpr size_t WS_BITM = WS_A + 156 * MiB;
constexpr size_t WS_CPART = WS_A + 158 * MiB;
constexpr size_t WS_SCORE = WS_A + 166 * MiB;
constexpr size_t WS_PART = WS_A + 200 * MiB;
constexpr size_t PART_BYTES = 65536 + 2048;
constexpr size_t WS_SELX = WS_PART + (size_t)192 * 2 * PART_BYTES;
constexpr size_t WS_F32 = WS_A + 32 * MiB;
constexpr size_t WS_CQ = WS_A + 96 * MiB;
constexpr size_t WS_U = WS_A + 96 * MiB;
constexpr size_t WS_END = WS_A + 226 * MiB;

constexpr int PROBE_REP_H[17] = {1, 1, 1, 1, 1, 1, 1, 1, 1, 1, 1, 1, 1, 1, 1, 1, 1};
constexpr int LDS_BYTES = 152 * 1024;
constexpr int LDS_MISC = 147456;
constexpr int WSLOT = 18432;

DI float bf2f(u32 h) { return __uint_as_float(h << 16); }
DI u32 f2bf(float f) { u32 u = __float_as_uint(f); return (u + 0x7fffu + ((u >> 16) & 1u)) >> 16; }
typedef float f32x2_g __attribute__((ext_vector_type(2)));
typedef __bf16 bf16x2_g __attribute__((ext_vector_type(2)));
DI u32 pg8_pk2(float lo, float hi) { f32x2_g v = {lo, hi}; bf16x2_g b = __builtin_convertvector(v, bf16x2_g); return __builtin_bit_cast(u32, b); }
DI float wave_sum(float v) { for (int o = 32; o; o >>= 1) v += __shfl_xor(v, o); return v; }
DI float wave_max(float v) { for (int o = 32; o; o >>= 1) v = fmaxf(v, __shfl_xor(v, o)); return v; }
DI float sigmoidf_(float x) { return 1.f / (1.f + __expf(-x)); }
DI float gelu_tanh(float x) { return 0.5f * x * (1.f + tanhf(0.7978845608028654f * (x + 0.044715f * x * x * x))); }

__device__ const unsigned char BUCKET_TAB[128] = {
    0, 1, 2, 3, 4, 5, 6, 7, 8, 9, 10, 11, 12, 13, 14, 15, 16, 16, 16, 17, 17, 18, 18, 18, 19, 19, 19, 20, 20, 20, 20, 21, 21, 21, 21, 22, 22, 22, 22, 22,
    23, 23, 23, 23, 23, 23, 24, 24, 24, 24, 24, 24, 25, 25, 25, 25, 25, 25, 25, 26, 26, 26, 26, 26, 26, 26, 26, 27, 27, 27, 27, 27, 27, 27, 27, 27, 27,
    28, 28, 28, 28, 28, 28, 28, 28, 28, 28, 29, 29, 29, 29, 29, 29, 29, 29, 29, 29, 29, 29, 30, 30, 30, 30, 30, 30, 30, 30, 30, 30, 30, 30, 30, 30,
    31, 31, 31, 31, 31, 31, 31, 31, 31, 31, 31, 31, 31, 31, 31};
DI int relbucket(int n) { return n >= 127 ? 31 : (int)BUCKET_TAB[n < 0 ? 0 : n]; }

DI int proj_src(int n) {
    if (n < 704) return n;
    if (n < 768) return 4288 + (n - 704);
    if (n < 1280) return 3776 + (n - 768);
    if (n < 4352) return 704 + (n - 1280);
    if (n < 5376) return 4360 + (n - 4352);
    if (n < 6912) return 5384 + (n - 5376);
    if (n < 6920) return 4352 + (n - 6912);
    if (n < 6944) return 6920 + (n - 6920);
    return -1;
}

#define XB_TMO      128
#define XB_XCNT(j)  (256  + 64 * (j))
#define XB_XSUB(j)  (1280 + 64 * (j))
#define XB_XGEN(j)  (2304 + 64 * (j))
#define XB_TOP      3328
#define XB_TOPGEN   3392
#define XCD_BAR_WORDS 3456
#define XB_SPIN_CAP (1u << 21)
DI unsigned xb_ld(unsigned* p)              { return __hip_atomic_load(p, __ATOMIC_RELAXED, __HIP_MEMORY_SCOPE_AGENT); }
DI unsigned xb_add(unsigned* p, unsigned v) { return __hip_atomic_fetch_add(p, v, __ATOMIC_RELAXED, __HIP_MEMORY_SCOPE_AGENT); }
DI unsigned xb_xcc_id() { return (unsigned)__builtin_amdgcn_s_getreg((3 << 11) | 20) & 0xFu; }
#define XB_SPIN(cond, bar) do { unsigned _sp = 0; while (cond) { __builtin_amdgcn_s_sleep(1); \
    if ((++_sp & 255u) == 0u) { if (xb_ld(&(bar)[XB_TMO])) break; if (_sp > XB_SPIN_CAP) { atomicAdd(&(bar)[XB_TMO], 1u); break; } } } } while (0)
struct XcdBarrier { unsigned* bar; unsigned x; volatile LAS unsigned* st; };
DI XcdBarrier xcd_barrier_post(unsigned* bar, volatile LAS unsigned* st) {
    XcdBarrier b; b.bar = bar; b.x = xb_xcc_id(); b.st = st;
    if (threadIdx.x == 0) (void)xb_add(&bar[XB_XCNT(b.x)], 1u);
    return b;
}
DI void xcd_barrier_complete(unsigned* bar, unsigned x, unsigned& nloc, unsigned& nx) {
    const unsigned G = gridDim.x * gridDim.y * gridDim.z;
    unsigned sum, cnt, mine, sp = 0u;
    for (;;) {
        sum = 0u; cnt = 0u; mine = 0u;
#pragma unroll
        for (unsigned j = 0; j < 16; ++j) { const unsigned c = xb_ld(&bar[XB_XCNT(j)]); sum += c; cnt += (c > 0u) ? 1u : 0u; mine = (j == x) ? c : mine; }
        if (sum == G) break;
        __builtin_amdgcn_s_sleep(1);
        if ((++sp & 255u) == 0u) { if (xb_ld(&bar[XB_TMO])) break; if (sp > XB_SPIN_CAP) { atomicAdd(&bar[XB_TMO], 1u); break; } }
    }
    nloc = mine > 0u ? mine : 1u; nx = cnt > 0u ? cnt : 1u;
}
DI void xcd_barrier(const XcdBarrier& b) {
    asm volatile("s_waitcnt vmcnt(0)" ::: "memory");
    __syncthreads();
    if (threadIdx.x == 0) {
        unsigned* bar = b.bar;
        __builtin_amdgcn_s_waitcnt(0);
        unsigned nloc = b.st[0], nx = b.st[1];
        if (nloc == 0u) { xcd_barrier_complete(bar, b.x, nloc, nx); b.st[0] = nloc; b.st[1] = nx; }
        const unsigned old = xb_add(&bar[XB_XSUB(b.x)], 1u);
        const unsigned gen = old / nloc;
        if (old + 1u == (gen + 1u) * nloc) {
            __builtin_amdgcn_fence(__ATOMIC_RELEASE, "agent");
            asm volatile("s_waitcnt vmcnt(0)" ::: "memory");
            const unsigned og = xb_add(&bar[XB_TOP], 1u);
            const unsigned tg = og / nx;
            if (og + 1u == (tg + 1u) * nx) xb_add(&bar[XB_TOPGEN], 1u);
            else XB_SPIN(xb_ld(&bar[XB_TOPGEN]) == tg, bar);
            __builtin_amdgcn_fence(__ATOMIC_ACQUIRE, "agent");
            xb_add(&bar[XB_XGEN(b.x)], 1u);
            asm volatile("s_waitcnt vmcnt(0)" ::: "memory");
        } else {
            XB_SPIN(xb_ld(&bar[XB_XGEN(b.x)]) == gen, bar);
            __builtin_amdgcn_fence(__ATOMIC_ACQUIRE, "agent");
            asm volatile("s_waitcnt vmcnt(0)" ::: "memory");
        }
    }
    __syncthreads();
}

struct Params {
    const float* x; const float* mem; const int* pos; const float* rel_bias; const float* gains; const float* w_in;
    const float* qnorm; const float* kvnorm; const float* w_uq; const float* w_ukv; const float* cmp_pos; const float* cmp_w1;
    const float* cmp_w2; const float* w_branch; const float* w_out; const float* cwq; const float* cwkv; const float* cwo;
    const float* w1; const float* w2;
    float* out; unsigned char* ws;
    int ph_lo, ph_hi;
};

DI u64 ldp(unsigned char* lds, int idx) {
    volatile LAS u32* t = (volatile LAS u32*)(lds + LDS_MISC + 64);
    const u32 lo = __builtin_amdgcn_readfirstlane(t[2 * idx]), hi = __builtin_amdgcn_readfirstlane(t[2 * idx + 1]);
    return ((u64)hi << 32) | lo;
}
DI int opaque_tid(int wid_s) { int t; asm volatile("v_mbcnt_lo_u32_b32 %0, -1, 0\n\tv_mbcnt_hi_u32_b32 %0, -1, %0" : "=v"(t)); return (wid_s << 6) | t; }
template <class BF, class EF>
DI void ngemm(unsigned char* lds, const u16* A, int lda, int M, int N, int K, BF bfn, EF efn, int tid) {
    float* As = (float*)lds;
    float* Bs = As + 16 * 132;
    const int tx = tid & 31, ty = tid >> 5;
    const int ntn = N / 128, ntiles = (M / 128) * ntn;
    for (int tile = blockIdx.x; tile < ntiles; tile += gridDim.x) {
        const int m0 = (tile / ntn) * 128, n0 = (tile % ntn) * 128;
        float acc[8][4];
#pragma unroll
        for (int i = 0; i < 8; ++i)
#pragma unroll
            for (int j = 0; j < 4; ++j) acc[i][j] = 0.f;
        for (int k0 = 0; k0 < K; k0 += 16) {
            {
                const int i = tid >> 2, kq = (tid & 3) * 4;
                const uint2 v = *(const uint2*)(A + (size_t)(m0 + i) * lda + k0 + kq);
                As[(kq + 0) * 132 + i] = bf2f(v.x & 0xffffu); As[(kq + 1) * 132 + i] = bf2f(v.x >> 16);
                As[(kq + 2) * 132 + i] = bf2f(v.y & 0xffffu); As[(kq + 3) * 132 + i] = bf2f(v.y >> 16);
                const int kk = tid >> 5, nq = (tid & 31) * 4;
#pragma unroll
                for (int j = 0; j < 4; ++j) Bs[kk * 132 + nq + j] = bfn(k0 + kk, n0 + nq + j);
            }
            __syncthreads();
#pragma unroll 2
            for (int kk = 0; kk < 16; ++kk) {
                float a[8], b[4];
#pragma unroll
                for (int i = 0; i < 8; ++i) a[i] = As[kk * 132 + ty * 8 + i];
#pragma unroll
                for (int j = 0; j < 4; ++j) b[j] = Bs[kk * 132 + tx * 4 + j];
#pragma unroll
                for (int i = 0; i < 8; ++i)
#pragma unroll
                    for (int j = 0; j < 4; ++j) acc[i][j] = fmaf(a[i], b[j], acc[i][j]);
            }
            __syncthreads();
        }
#pragma unroll
        for (int i = 0; i < 8; ++i)
#pragma unroll
            for (int j = 0; j < 4; ++j) efn(m0 + ty * 8 + i, n0 + tx * 4 + j, acc[i][j]);
    }
}

DI void ph_norm_rows(const float* src, const float* g, u16* dst, int rows, int tid) {
    typedef float f4 __attribute__((ext_vector_type(4)));
    const int lane = tid & 63, wv = tid >> 6;
    for (int r = blockIdx.x * 8 + wv; r < rows; r += gridDim.x * 8) {
        const f4* s = (const f4*)(src + (size_t)r * 1024) + lane;
        f4 v[4]; float ss = 0.f;
#pragma unroll
        for (int i = 0; i < 4; ++i) { v[i] = s[64 * i]; ss += (v[i][0] * v[i][0] + v[i][1] * v[i][1]) + (v[i][2] * v[i][2] + v[i][3] * v[i][3]); }
        ss = wave_sum(ss);
        const float rs = rsqrtf(ss * (1.f / 1024.f) + EPS);
        uint2* d = (uint2*)(dst + (size_t)r * 1024) + lane;
#pragma unroll
        for (int i = 0; i < 4; ++i) { const f4 gg = ((const f4*)g)[lane + 64 * i]; uint2 w; w.x = pg8_pk2(v[i][0] * rs * gg[0], v[i][1] * rs * gg[1]); w.y = pg8_pk2(v[i][2] * rs * gg[2], v[i][3] * rs * gg[3]); d[64 * i] = w; }
    }
}
DI void ph_resid_norm(const float* f, const float* gpost, const float* xin, float* xout, const float* gnext, u16* hb, int rows, int tid) {
    typedef float f4 __attribute__((ext_vector_type(4)));
    const int lane = tid & 63, wv = tid >> 6;
    for (int r = blockIdx.x * 8 + wv; r < rows; r += gridDim.x * 8) {
        const f4* s = (const f4*)(f + (size_t)r * 1024) + lane;
        const f4* xi = (const f4*)(xin + (size_t)r * 1024) + lane;
        f4 v[4], x[4]; float ss = 0.f;
#pragma unroll
        for (int i = 0; i < 4; ++i) { v[i] = s[64 * i]; x[i] = xi[64 * i]; ss += (v[i][0] * v[i][0] + v[i][1] * v[i][1]) + (v[i][2] * v[i][2] + v[i][3] * v[i][3]); }
        ss = wave_sum(ss);
        const float rs = rsqrtf(ss * (1.f / 1024.f) + EPS);
        float s2 = 0.f;
        f4* xo = (f4*)(xout + (size_t)r * 1024) + lane;
#pragma unroll
        for (int i = 0; i < 4; ++i) { const f4 gg = ((const f4*)gpost)[lane + 64 * i]; x[i] = x[i] + v[i] * rs * gg; xo[64 * i] = x[i];
            s2 += (x[i][0] * x[i][0] + x[i][1] * x[i][1]) + (x[i][2] * x[i][2] + x[i][3] * x[i][3]); }
        if (gnext) {
            s2 = wave_sum(s2);
            const float r2 = rsqrtf(s2 * (1.f / 1024.f) + EPS);
            uint2* d = (uint2*)(hb + (size_t)r * 1024) + lane;
#pragma unroll
            for (int i = 0; i < 4; ++i) { const f4 gg = ((const f4*)gnext)[lane + 64 * i]; uint2 w; w.x = pg8_pk2(x[i][0] * r2 * gg[0], x[i][1] * r2 * gg[1]); w.y = pg8_pk2(x[i][2] * r2 * gg[2], x[i][3] * r2 * gg[3]); d[64 * i] = w; }
        }
    }
}

template <int NV, class SF, class VF>
DI float wave_attn(float* sc, int n, SF scoref, VF vrowf, float (&out)[NV], int lane) {
#pragma unroll
    for (int j = 0; j < NV; ++j) out[j] = 0.f;
    float m = -INFINITY;
#pragma unroll 1
    for (int i = lane; i < n; i += 64) { asm volatile("" ::: "memory"); const float s = scoref(i); sc[i] = s; m = fmaxf(m, s); }
    m = wave_max(m);
    if (!(m > -INFINITY)) return 0.f;
    float sum = 0.f;
    for (int i = lane; i < n; i += 64) { const float p = __expf(sc[i] - m); sc[i] = p; sum += p; }
    sum = wave_sum(sum);
    float acc[NV];
#pragma unroll
    for (int j = 0; j < NV; ++j) acc[j] = 0.f;
#pragma unroll 4
    for (int i = 0; i < n; ++i) {
        const float p = sc[i];
        if (p != 0.f) {
            const u16* v = vrowf(i);
            if constexpr (NV == 2) { const u32 w = *(const u32*)(v + lane * 2); acc[0] = fmaf(p, bf2f(w & 0xffffu), acc[0]); acc[1] = fmaf(p, bf2f(w >> 16), acc[1]); }
            else { const uint2 w = *(const uint2*)(v + lane * 4); acc[0] = fmaf(p, bf2f(w.x & 0xffffu), acc[0]); acc[1] = fmaf(p, bf2f(w.x >> 16), acc[1]);
                   acc[2 % NV] = fmaf(p, bf2f(w.y & 0xffffu), acc[2 % NV]); acc[3 % NV] = fmaf(p, bf2f(w.y >> 16), acc[3 % NV]); }
        }
    }
    const float inv = 1.f / sum;
#pragma unroll
    for (int j = 0; j < NV; ++j) out[j] = acc[j] * inv;
    return sum;
}
DI float dot_q(const float* q, const u16* k, int n) {
    float a = 0.f;
#pragma unroll 4
    for (int d = 0; d < n; d += 8) {
        const uint4 w = *(const uint4*)(k + d);
        a = fmaf(q[d + 0], bf2f(w.x & 0xffffu), a); a = fmaf(q[d + 1], bf2f(w.x >> 16), a);
        a = fmaf(q[d + 2], bf2f(w.y & 0xffffu), a); a = fmaf(q[d + 3], bf2f(w.y >> 16), a);
        a = fmaf(q[d + 4], bf2f(w.z & 0xffffu), a); a = fmaf(q[d + 5], bf2f(w.z >> 16), a);
        a = fmaf(q[d + 6], bf2f(w.w & 0xffffu), a); a = fmaf(q[d + 7], bf2f(w.w >> 16), a);
    }
    return a;
}

namespace pg8 {
typedef short bf16x8 __attribute__((ext_vector_type(8)));
typedef float f32x4 __attribute__((ext_vector_type(4)));
typedef unsigned u32x4 __attribute__((ext_vector_type(4)));
typedef float f32x2_t __attribute__((ext_vector_type(2)));
typedef __bf16 bf16x2_t __attribute__((ext_vector_type(2)));
constexpr int BM = 256, BK = 64, HALF = 128, HTB = HALF * BK * 2, STAGE_BYTES = 8 * HTB, NXCD = 8, WGM = 8;
DI u32 pk2(float lo, float hi) { f32x2_t v = {lo, hi}; bf16x2_t b = __builtin_convertvector(v, bf16x2_t); return __builtin_bit_cast(u32, b); }
__host__ __device__ __forceinline__ int lds_byte(int r, int c) { const int st = (r >> 4) * 2 + (c >> 5), rr = r & 15, cc = c & 31, ob = rr * 64 + cc * 2; return st * 1024 + (ob ^ (((ob >> 9) & 1) << 5)); }
__host__ __device__ __forceinline__ void stage_rc(int b, int& R, int& C) { const int st = b / 1024, sb = b % 1024, swz = sb ^ (((sb >> 9) & 1) << 5); R = (st >> 1) * 16 + swz / 64; C = (st & 1) * 32 + (swz % 64) / 2; }
__host__ __device__ __forceinline__ int perm32(int rho) { const int n = rho >> 4, i = rho & 15; return 8 * (i >> 2) + 4 * n + (i & 3); }

struct Unit { const char* A; const char* B; int pm, pn; };

struct Sched1 {
    const char* A; const char* B; size_t sA, sB; int nM, nN, nwg, G, c;
    DI void init(const void* A_, int lda, const void* B_, int ldb, int M, int N, int rot) {
        A = (const char*)A_; B = (const char*)B_; sA = (size_t)BM * lda * 2; sB = (size_t)BM * ldb * 2; nM = M / BM; nN = N / BM; nwg = nM * nN; G = gridDim.x;
        c = (int)((blockIdx.x + G - (rot % G)) % G);
    }
    DI bool next(int i, Unit& u) const {
        const long L = (long)i * G + c; if (L >= nwg) return false;
        int wgid = (int)L; { const int q = nwg / NXCD, r = nwg % NXCD, xcd = wgid % NXCD, off = wgid / NXCD; wgid = (xcd < r ? xcd * (q + 1) : r * (q + 1) + (xcd - r) * q) + off; }
        const int nig = WGM * nN, gid = wgid / nig, fm = gid * WGM, gsz = (nM - fm) < WGM ? (nM - fm) : WGM;
        u.pm = fm + ((wgid % nig) % gsz); u.pn = (wgid % nig) / gsz; u.A = A + (size_t)u.pm * sA; u.B = B + (size_t)u.pn * sB; return true;
    }
};
struct SchedOne { const char* A; const char* B; int pm, pn; DI bool next(int i, Unit& u) const { if (i) return false; u.pm = pm; u.pn = pn; u.A = A; u.B = B; return true; } };
struct SchedCmp {
    const char* A; const char* B; int G, c;
    DI void init(const void* A_, const void* B_, int rot) { A = (const char*)A_; B = (const char*)B_; G = gridDim.x; c = (int)((blockIdx.x + G - (rot % G)) % G); }
    DI bool next(int i, Unit& u) const {
        const int L = i * G + c; if (L >= 32) return false;
        u.pm = L; u.pn = 0; u.A = A + (size_t)L * 256 * 512 * 2; u.B = B + (size_t)(L >> 1) * 256 * 512 * 2; return true;
    }
};

template <class F> struct EpiB16 {
    static constexpr bool PERM = true; F f;
    DI void operator()(const f32x4 (&acc)[2][2][4][2], const Unit& u, int wr, int wc, int fr, int fq) const {
        const int row0 = u.pm * BM + wr * 64 + fr, col0 = u.pn * BM + wc * 32 + 8 * fq;
#pragma unroll
        for (int ai = 0; ai < 2; ++ai)
#pragma unroll
            for (int m = 0; m < 4; ++m)
#pragma unroll
                for (int bj = 0; bj < 2; ++bj) f(row0 + ai * HALF + m * 16, col0 + bj * HALF, acc[ai][bj][m][0], acc[ai][bj][m][1]);
    }
};
template <class F> struct EpiF32 {
    static constexpr bool PERM = false; F f;
    DI void operator()(const f32x4 (&acc)[2][2][4][2], const Unit& u, int wr, int wc, int fr, int fq) const {
        const int row0 = u.pm * BM + wr * 64 + fr, col0 = u.pn * BM + wc * 32 + 4 * fq;
#pragma unroll
        for (int ai = 0; ai < 2; ++ai)
#pragma unroll
            for (int m = 0; m < 4; ++m)
#pragma unroll
                for (int bj = 0; bj < 2; ++bj)
#pragma unroll
                    for (int n = 0; n < 2; ++n) f(row0 + ai * HALF + m * 16, col0 + bj * HALF + n * 16, acc[ai][bj][m][n]);
    }
};
template <class F> DI EpiB16<F> epi_b16(F f) { return EpiB16<F>{f}; }
template <class F> DI EpiF32<F> epi_f32(F f) { return EpiF32<F>{f}; }
DI u32x4 pack8(f32x4 a, f32x4 b) { u32x4 w; w.x = pk2(a[0], a[1]); w.y = pk2(a[2], a[3]); w.z = pk2(b[0], b[1]); w.w = pk2(b[2], b[3]); return w; }

template <class Epi, class Sched, bool ALIGN_EPI = true, bool SP2 = true>
DI void gemm_phase(LAS unsigned char* lds, const int K, const int lda, const int ldb, const Sched& S, const Epi& E, const int wid_s) {
    const int tid = opaque_tid(wid_s);
    const int wid = __builtin_amdgcn_readfirstlane(tid >> 6), lane = tid & 63, wr = wid >> 2, wc = wid & 3, fr = lane & 15, fq = lane >> 4;
    const int nt = K / BK;
    unsigned voffA[2], voffB[2];
#pragma unroll
    for (int i = 0; i < 2; ++i) { int R, C; stage_rc(tid * 16 + i * 8192, R, C); const int Rb = Epi::PERM ? ((R & ~31) + perm32(R & 31)) : R;
        voffA[i] = (unsigned)(R * lda + C) * 2u; voffB[i] = (unsigned)(Rb * ldb + C) * 2u; }
    const size_t kstep = (size_t)(BK * 2);
    const size_t hstepA = (size_t)HALF * lda * 2, hstepB = (size_t)HALF * ldb * 2;
    const unsigned ldsw = (unsigned)wid * 1024u;
    const int aoff = lds_byte(wr * 64 + fr, fq * 8), boff = lds_byte(wc * 32 + fr, fq * 8);
#define PG8_SA(b, h) (((b) * 2 + (h)) * HTB)
#define PG8_SB(b, h) ((4 + (b) * 2 + (h)) * HTB)
#define PG8_STAGE(bufoff, gbase, voff) do { _Pragma("unroll") for (int _i = 0; _i < 2; ++_i) \
        __builtin_amdgcn_global_load_lds((const unsigned*)((const char*)(gbase) + (voff)[_i]), (LAS unsigned*)(lds + (bufoff) + ldsw + _i * 8192), 16, 0, 0); } while (0)
#define PG8_LDA(dst, b, h) do { _Pragma("unroll") for (int m = 0; m < 4; ++m) _Pragma("unroll") for (int k = 0; k < 2; ++k) dst[m][k] = *(const LAS bf16x8*)(lds + PG8_SA(b, h) + aoff + m * 2048 + k * 1024); } while (0)
#define PG8_LDB(dst, b, h) do { _Pragma("unroll") for (int n = 0; n < 2; ++n) _Pragma("unroll") for (int k = 0; k < 2; ++k) dst[n][k] = *(const LAS bf16x8*)(lds + PG8_SB(b, h) + boff + n * 2048 + k * 1024); } while (0)
#define PG8_MMA(ai, bj, At, Bt) do { __builtin_amdgcn_s_setprio(1); _Pragma("unroll") for (int m = 0; m < 4; ++m) _Pragma("unroll") for (int n = 0; n < 2; ++n) _Pragma("unroll") for (int k = 0; k < 2; ++k) \
        acc[ai][bj][m][n] = __builtin_amdgcn_mfma_f32_16x16x32_bf16(Bt[n][k], At[m][k], acc[ai][bj][m][n], 0, 0, 0); __builtin_amdgcn_s_setprio(0); } while (0)
#define PG8_WAIT_V(n) asm volatile("s_waitcnt vmcnt(" #n ")" ::: "memory")
#define PG8_WAIT_L(n) asm volatile("s_waitcnt lgkmcnt(" #n ")" ::: "memory")
#define PG8_BAR __builtin_amdgcn_s_barrier()
#define PG8_SCHED __builtin_amdgcn_sched_barrier(0)
    Unit cur, nxt; int ui = 0;
    if (!S.next(0, cur)) return;
    f32x4 acc[2][2][4][2];
#pragma unroll
    for (int a = 0; a < 2; ++a)
#pragma unroll
        for (int b = 0; b < 2; ++b)
#pragma unroll
            for (int m = 0; m < 4; ++m)
#pragma unroll
                for (int n = 0; n < 2; ++n) acc[a][b][m][n] = (f32x4){0.f, 0.f, 0.f, 0.f};
    bf16x8 At[4][2], B0[2][2], B1[2][2];
    const char* cA = cur.A; const char* cB = cur.B;
    if constexpr (SP2) {
        PG8_STAGE(PG8_SB(0, 0), cB, voffB); PG8_STAGE(PG8_SB(0, 1), cB + hstepB, voffB); PG8_STAGE(PG8_SA(0, 0), cA, voffA); PG8_STAGE(PG8_SA(0, 1), cA + hstepA, voffA);
        if (wr == 1) PG8_BAR;
        PG8_WAIT_V(2); PG8_BAR;
        PG8_STAGE(PG8_SB(1, 0), cB + kstep, voffB); PG8_STAGE(PG8_SA(1, 0), cA + kstep, voffA); PG8_STAGE(PG8_SB(1, 1), cB + hstepB + kstep, voffB);
        PG8_WAIT_V(6); PG8_BAR;
    } else {
        PG8_STAGE(PG8_SB(0, 0), cB, voffB); PG8_STAGE(PG8_SA(0, 0), cA, voffA); PG8_STAGE(PG8_SB(0, 1), cB + hstepB, voffB); PG8_STAGE(PG8_SA(0, 1), cA + hstepA, voffA);
        if (wr == 1) PG8_BAR;
        PG8_WAIT_V(4); PG8_BAR;
        PG8_STAGE(PG8_SB(1, 0), cB + kstep, voffB); PG8_STAGE(PG8_SA(1, 0), cA + kstep, voffA); PG8_STAGE(PG8_SB(1, 1), cB + hstepB + kstep, voffB);
        PG8_WAIT_V(6); PG8_BAR;
    }
    for (;;) {
        const bool has_next = S.next(ui + 1, nxt);
        const char* nA = has_next ? nxt.A : cA; const char* nB = has_next ? nxt.B : cB;
#pragma unroll 1
        for (int t = 0; t < nt; t += 2) {
            const bool last = (t == nt - 2);
            const char* a1 = cA + (size_t)(t + 1) * kstep;
            const char* a2 = last ? nA : cA + (size_t)(t + 2) * kstep; const char* b2 = last ? nB : cB + (size_t)(t + 2) * kstep;
            const char* a3 = a2 + kstep; const char* b3 = b2 + kstep;
            if constexpr (SP2) {
            PG8_LDB(B0, 0, 0); PG8_LDB(B1, 0, 1); PG8_SCHED; PG8_LDA(At, 0, 0); PG8_STAGE(PG8_SA(1, 1), a1 + hstepA, voffA);
            PG8_WAIT_V(8); PG8_WAIT_L(0); PG8_BAR; PG8_MMA(0, 0, At, B0); PG8_MMA(0, 1, At, B1); PG8_BAR; PG8_SCHED;
            PG8_LDA(At, 0, 1); PG8_STAGE(PG8_SB(0, 0), b2, voffB); PG8_STAGE(PG8_SB(0, 1), b2 + hstepB, voffB); PG8_STAGE(PG8_SA(0, 0), a2, voffA);
            PG8_WAIT_V(8); PG8_WAIT_L(0); PG8_BAR; PG8_MMA(1, 0, At, B0); PG8_MMA(1, 1, At, B1); PG8_BAR; PG8_SCHED;
            PG8_LDB(B0, 1, 0); PG8_LDB(B1, 1, 1); PG8_SCHED; PG8_LDA(At, 1, 0); PG8_STAGE(PG8_SA(0, 1), a2 + hstepA, voffA);
            PG8_WAIT_V(8); PG8_WAIT_L(0); PG8_BAR; PG8_MMA(0, 0, At, B0); PG8_MMA(0, 1, At, B1); PG8_BAR; PG8_SCHED;
            PG8_LDA(At, 1, 1); PG8_STAGE(PG8_SB(1, 0), b3, voffB); PG8_STAGE(PG8_SB(1, 1), b3 + hstepB, voffB); PG8_STAGE(PG8_SA(1, 0), a3, voffA);
            PG8_WAIT_V(8); PG8_WAIT_L(0); PG8_BAR; PG8_MMA(1, 0, At, B0); PG8_MMA(1, 1, At, B1); PG8_BAR; PG8_SCHED;
            } else {
            PG8_LDB(B0, 0, 0); PG8_SCHED; PG8_LDA(At, 0, 0); PG8_STAGE(PG8_SA(1, 1), a1 + hstepA, voffA);
            PG8_WAIT_L(8); PG8_BAR; PG8_WAIT_L(0); PG8_MMA(0, 0, At, B0); PG8_BAR; PG8_SCHED;
            PG8_LDB(B1, 0, 1); PG8_STAGE(PG8_SB(0, 0), b2, voffB);
            PG8_BAR; PG8_WAIT_L(0); PG8_MMA(0, 1, At, B1); PG8_BAR;
            PG8_LDA(At, 0, 1); PG8_STAGE(PG8_SA(0, 0), a2, voffA);
            PG8_BAR; PG8_WAIT_L(0); PG8_MMA(1, 0, At, B0); PG8_BAR; PG8_SCHED;
            PG8_STAGE(PG8_SB(0, 1), b2 + hstepB, voffB);
            PG8_WAIT_V(6); PG8_BAR; PG8_MMA(1, 1, At, B1); PG8_BAR;
            PG8_LDB(B0, 1, 0); PG8_SCHED; PG8_LDA(At, 1, 0); PG8_STAGE(PG8_SA(0, 1), a2 + hstepA, voffA);
            PG8_WAIT_L(8); PG8_BAR; PG8_WAIT_L(0); PG8_MMA(0, 0, At, B0); PG8_BAR; PG8_SCHED;
            PG8_LDB(B1, 1, 1); PG8_STAGE(PG8_SB(1, 0), b3, voffB);
            PG8_BAR; PG8_WAIT_L(0); PG8_MMA(0, 1, At, B1); PG8_BAR;
            PG8_LDA(At, 1, 1); PG8_STAGE(PG8_SA(1, 0), a3, voffA);
            PG8_BAR; PG8_WAIT_L(0); PG8_MMA(1, 0, At, B0); PG8_BAR; PG8_SCHED;
            PG8_STAGE(PG8_SB(1, 1), b3 + hstepB, voffB);
            PG8_WAIT_V(6); PG8_BAR; PG8_MMA(1, 1, At, B1); PG8_BAR;
            }
        }
        if constexpr (ALIGN_EPI) { if (wr == 0) PG8_BAR; }
        E(acc, cur, wr, wc, fr, fq);
        if (!has_next) break;
#pragma unroll
        for (int a = 0; a < 2; ++a)
#pragma unroll
            for (int b = 0; b < 2; ++b)
#pragma unroll
                for (int m = 0; m < 4; ++m)
#pragma unroll
                    for (int n = 0; n < 2; ++n) acc[a][b][m][n] = (f32x4){0.f, 0.f, 0.f, 0.f};
        cur = nxt; cA = nA; cB = nB; ++ui;
        if constexpr (ALIGN_EPI) { if (wr == 1) PG8_BAR; }
    }
    PG8_WAIT_V(0);
    if constexpr (!ALIGN_EPI) { if (wr == 0) PG8_BAR; }
    PG8_BAR;
#undef PG8_SA
#undef PG8_SB
#undef PG8_STAGE
#undef PG8_LDA
#undef PG8_LDB
#undef PG8_MMA
#undef PG8_WAIT_V
#undef PG8_WAIT_L
#undef PG8_BAR
#undef PG8_SCHED
}

template <class SF, class DF>
DI void conv_tile(const float* W, int ldw, int k0, int n0, SF srccol, DF dstp, float* scr, int lane) {
    const int sc = srccol(n0 + lane);
    float tv[64];
#pragma unroll
    for (int kk = 0; kk < 64; ++kk) tv[kk] = sc >= 0 ? W[(size_t)(k0 + kk) * ldw + sc] : 0.f;
#pragma unroll
    for (int kk = 0; kk < 64; ++kk) scr[kk * 65 + lane] = tv[kk];
    asm volatile("s_waitcnt lgkmcnt(0)" ::: "memory");
    const int c = lane & 7;
#pragma unroll
    for (int j = 0; j < 8; ++j) { const int n = (lane >> 3) + 8 * j; const float* s = scr + (8 * c) * 65 + n;
        u32x4 o; o.x = pk2(s[0 * 65], s[1 * 65]); o.y = pk2(s[2 * 65], s[3 * 65]); o.z = pk2(s[4 * 65], s[5 * 65]); o.w = pk2(s[6 * 65], s[7 * 65]);
        *(u32x4*)dstp(n0 + n, k0 + 8 * c) = o; }
    asm volatile("s_waitcnt lgkmcnt(0)" ::: "memory");
}
template <class SF, class DF>
DI int conv_matrix(const float* W, int ldw, int Kd, int Nd, SF srccol, DF dstp, float* scr, int lane, int gw, int ngw, int it0) {
    const int nblk = Nd / 64, nitems = (Kd / 64) * nblk;
    int first = gw - (it0 % ngw); if (first < 0) first += ngw;
    for (int it = first; it < nitems; it += ngw) conv_tile(W, ldw, (it / nblk) * 64, (it % nblk) * 64, srccol, dstp, scr, lane);
    return it0 + nitems;
}
}

namespace fa {
typedef short bf16x8 __attribute__((ext_vector_type(8)));
typedef short s16x4 __attribute__((ext_vector_type(4)));
typedef float f32x16 __attribute__((ext_vector_type(16)));
typedef float f32x4 __attribute__((ext_vector_type(4)));
typedef unsigned u32x4 __attribute__((ext_vector_type(4)));
constexpr int SHM_V = 16384;
constexpr int LDS_V = 0, LDS_K = 65536, LDS_TAB = 114688;
constexpr float LOG2E = 1.4426950408889634f;
DI int v_st(int k, int c) { return ((k >> 3) * 4 + (c >> 5)) * 512 + ((k & 7) * 32 + (c & 31)) * 2; }
DI int v_rd_base(int lane) { return ((lane & 3) << 3) | (((lane >> 2) & 3) << 6) | (((lane >> 4) & 1) << 5) | (((lane >> 5) & 1) << 8); }
constexpr int v_rd_off(int d0, int ks, int half) { return d0 * 512 + ks * 4096 + half * 2048; }
DI u32 pk2(float lo, float hi) { return pg8::pk2(lo, hi); }

struct KSrc { const u16* p; int pitch; const u16* p2; int pitch2; };
struct VSrc { const u16* p; int pitch; };
template <int DQK> DI void stage_dma(LAS unsigned char* lds, int buf, const KSrc& ks, const VSrc& vs, int kb, int wid, int lane) {
    constexpr int CPR = DQK / 8, PITCH = DQK * 2, KBYTES = 64 * PITCH;
#pragma unroll
    for (int i = 0; i < DQK / 64; ++i) {
        const int q = (i * 8 + wid) * 64 + lane, row = q / CPR, pc = q % CPR, cc = (pc & ~7) | ((pc & 7) ^ (row & 7));
        const u16* src = (DQK == 192 && cc >= 16) ? ks.p2 + (size_t)(kb + row) * ks.pitch2 + (cc - 16) * 8 : ks.p + (size_t)(kb + row) * ks.pitch + cc * 8;
        __builtin_amdgcn_global_load_lds((const unsigned*)src, (LAS unsigned*)(lds + LDS_K + buf * KBYTES + (i * 8 + wid) * 1024), 16, 0, 0);
    }
#pragma unroll
    for (int i = 0; i < 2; ++i) {
        const int q = (i * 8 + wid) * 64 + lane, st = q >> 5, key = (st >> 2) * 8 + ((q >> 2) & 7), col = (st & 3) * 32 + (q & 3) * 8;
        __builtin_amdgcn_global_load_lds((const unsigned*)(vs.p + (size_t)(kb + key) * vs.pitch + col), (LAS unsigned*)(lds + LDS_V + buf * SHM_V + (i * 8 + wid) * 1024), 16, 0, 0);
    }
}
template <int DQK> DI void qkt(f32x16& p0, f32x16& p1, LAS unsigned char* lds, int buf, int r32, int hi, const bf16x8 (&qr)[DQK / 16]) {
    constexpr int PITCH = DQK * 2, KBYTES = 64 * PITCH;
#pragma unroll
    for (int i = 0; i < 16; ++i) { p0[i] = 0.f; p1[i] = 0.f; }
    LAS unsigned char* kb[4];
#pragma unroll
    for (int dd = 0; dd < 4; ++dd) kb[dd] = lds + LDS_K + buf * KBYTES + r32 * PITCH + (((dd * 16 + hi * 8) * 2) ^ ((r32 & 7) << 4));
#pragma unroll
    for (int d0 = 0; d0 < DQK / 16; ++d0) {
        LAS unsigned char* a = kb[d0 & 3] + (d0 >> 2) * 128;
        const bf16x8 b0 = *(const LAS bf16x8*)a;
        const bf16x8 b1 = *(const LAS bf16x8*)(a + 32 * PITCH);
        p0 = __builtin_amdgcn_mfma_f32_32x32x16_bf16(b0, qr[d0], p0, 0, 0, 0);
        p1 = __builtin_amdgcn_mfma_f32_32x32x16_bf16(b1, qr[d0], p1, 0, 0, 0);
        if ((d0 & 3) == 3) __builtin_amdgcn_sched_barrier(0);
    }
}
DI float xhalf_max(float v) { auto rr = __builtin_amdgcn_permlane32_swap(__float_as_uint(v), __float_as_uint(v), false, false); return fmaxf(__uint_as_float(rr[0]), __uint_as_float(rr[1])); }
DI float xhalf_sum(float v) { auto rr = __builtin_amdgcn_permlane32_swap(__float_as_uint(v), __float_as_uint(v), false, false); return __uint_as_float(rr[0]) + __uint_as_float(rr[1]); }
DI void softmax_tile(f32x16& p0, f32x16& p1, float& m, float& l, f32x16 (&o)[4], bf16x8 (&pa)[4]) {
    float pmax = p0[0];
#pragma unroll
    for (int r = 1; r < 16; ++r) pmax = fmaxf(pmax, p0[r]);
#pragma unroll
    for (int r = 0; r < 16; ++r) pmax = fmaxf(pmax, p1[r]);
    pmax = xhalf_max(pmax);
    const float mn = fmaxf(m, pmax);
    const float alpha = __builtin_amdgcn_exp2f(m - mn);
    m = mn;
    float ps = 0.f;
#pragma unroll
    for (int r = 0; r < 16; ++r) { p0[r] = __builtin_amdgcn_exp2f(p0[r] - mn); ps += p0[r]; }
#pragma unroll
    for (int r = 0; r < 16; ++r) { p1[r] = __builtin_amdgcn_exp2f(p1[r] - mn); ps += p1[r]; }
    ps = xhalf_sum(ps);
    l = l * alpha + ps;
    if (__any(alpha < 1.f)) {
#pragma unroll
        for (int d = 0; d < 4; ++d)
#pragma unroll
            for (int r = 0; r < 16; ++r) o[d][r] *= alpha;
    }
#pragma unroll
    for (int s = 0; s < 2; ++s) {
        u32x4 w0 = {pk2(p0[8 * s + 0], p0[8 * s + 1]), pk2(p0[8 * s + 2], p0[8 * s + 3]), pk2(p0[8 * s + 4], p0[8 * s + 5]), pk2(p0[8 * s + 6], p0[8 * s + 7])};
        u32x4 w1 = {pk2(p1[8 * s + 0], p1[8 * s + 1]), pk2(p1[8 * s + 2], p1[8 * s + 3]), pk2(p1[8 * s + 4], p1[8 * s + 5]), pk2(p1[8 * s + 6], p1[8 * s + 7])};
        pa[s] = __builtin_bit_cast(bf16x8, w0); pa[2 + s] = __builtin_bit_cast(bf16x8, w1);
    }
}
DI void softmax_tile2(f32x16& p0, f32x16& p1, float cb, float& m, float& l, f32x16 (&o)[4], bf16x8 (&pa)[4]) {
    float pmax = p0[0];
#pragma unroll
    for (int r = 1; r < 16; ++r) pmax = fmaxf(pmax, p0[r]);
#pragma unroll
    for (int r = 0; r < 16; ++r) pmax = fmaxf(pmax, p1[r]);
    pmax = xhalf_max(pmax) + cb;
    const float mn = fmaxf(m, pmax);
    const float alpha = __builtin_amdgcn_exp2f(m - mn);
    m = mn;
    const float sh = mn - cb;
    float ps = 0.f;
#pragma unroll
    for (int r = 0; r < 16; ++r) { p0[r] = __builtin_amdgcn_exp2f(p0[r] - sh); ps += p0[r]; }
#pragma unroll
    for (int r = 0; r < 16; ++r) { p1[r] = __builtin_amdgcn_exp2f(p1[r] - sh); ps += p1[r]; }
    ps = xhalf_sum(ps);
    l = l * alpha + ps;
    if (__any(alpha < 1.f)) {
#pragma unroll
        for (int d = 0; d < 4; ++d)
#pragma unroll
            for (int r = 0; r < 16; ++r) o[d][r] *= alpha;
    }
#pragma unroll
    for (int s = 0; s < 2; ++s) {
        u32x4 w0 = {pk2(p0[8 * s + 0], p0[8 * s + 1]), pk2(p0[8 * s + 2], p0[8 * s + 3]), pk2(p0[8 * s + 4], p0[8 * s + 5]), pk2(p0[8 * s + 6], p0[8 * s + 7])};
        u32x4 w1 = {pk2(p1[8 * s + 0], p1[8 * s + 1]), pk2(p1[8 * s + 2], p1[8 * s + 3]), pk2(p1[8 * s + 4], p1[8 * s + 5]), pk2(p1[8 * s + 6], p1[8 * s + 7])};
        pa[s] = __builtin_bit_cast(bf16x8, w0); pa[2 + s] = __builtin_bit_cast(bf16x8, w1);
    }
}
constexpr float FA_TAU = 8.f;
DI void softmax_lazy(f32x16& p0, f32x16& p1, float& m, float& l, f32x16 (&o)[4], bf16x8 (&pa)[4]) {
    float pmax = p0[0];
#pragma unroll
    for (int r = 1; r < 16; ++r) pmax = fmaxf(pmax, p0[r]);
#pragma unroll
    for (int r = 0; r < 16; ++r) pmax = fmaxf(pmax, p1[r]);
    pmax = xhalf_max(pmax);
    const bool inval = !(m > -1e29f);
    const bool bump = inval ? (pmax > -1e29f) : (pmax > FA_TAU);
    if (__any(bump)) {
        const float mref = inval ? 0.f : m;
        const float mn = bump ? mref + pmax : m;
        const float alpha = bump ? __builtin_amdgcn_exp2f(m - mn) : 1.f;
        const float d = bump ? pmax : 0.f;
#pragma unroll
        for (int r = 0; r < 16; ++r) { p0[r] -= d; p1[r] -= d; }
        l *= alpha; m = mn;
#pragma unroll
        for (int dd = 0; dd < 4; ++dd)
#pragma unroll
            for (int r = 0; r < 16; ++r) o[dd][r] *= alpha;
    }
    float ps = 0.f;
#pragma unroll
    for (int r = 0; r < 16; ++r) { p0[r] = __builtin_amdgcn_exp2f(p0[r]); ps += p0[r]; }
#pragma unroll
    for (int r = 0; r < 16; ++r) { p1[r] = __builtin_amdgcn_exp2f(p1[r]); ps += p1[r]; }
    l += xhalf_sum(ps);
#pragma unroll
    for (int s = 0; s < 2; ++s) {
        u32x4 w0 = {pk2(p0[8 * s + 0], p0[8 * s + 1]), pk2(p0[8 * s + 2], p0[8 * s + 3]), pk2(p0[8 * s + 4], p0[8 * s + 5]), pk2(p0[8 * s + 6], p0[8 * s + 7])};
        u32x4 w1 = {pk2(p1[8 * s + 0], p1[8 * s + 1]), pk2(p1[8 * s + 2], p1[8 * s + 3]), pk2(p1[8 * s + 4], p1[8 * s + 5]), pk2(p1[8 * s + 6], p1[8 * s + 7])};
        pa[s] = __builtin_bit_cast(bf16x8, w0); pa[2 + s] = __builtin_bit_cast(bf16x8, w1);
    }
}
DI bf16x8 scale_frag(bf16x8 q, float c) {
    u32x4 w = __builtin_bit_cast(u32x4, q);
#pragma unroll
    for (int i = 0; i < 4; ++i) w[i] = pk2(__uint_as_float(w[i] << 16) * c, __uint_as_float(w[i] & 0xffff0000u) * c);
    return __builtin_bit_cast(bf16x8, w);
}
#define FA_TRRD(dst, off) asm volatile("ds_read_b64_tr_b16 %0, %1 offset:%2" : "=&v"(dst) : "v"(vb), "i"(off) : "memory")
DI void pv_tile(f32x16 (&o)[4], int vb, const bf16x8 (&pa)[4]) {
#define FA_PV_D0(d0) do { s16x4 l0, l1, l2, l3, h0, h1, h2, h3; constexpr int b_ = v_rd_off(d0, 0, 0); \
        FA_TRRD(l0, b_); FA_TRRD(h0, b_ + 2048); FA_TRRD(l1, b_ + 4096); FA_TRRD(h1, b_ + 6144); FA_TRRD(l2, b_ + 8192); FA_TRRD(h2, b_ + 10240); FA_TRRD(l3, b_ + 12288); FA_TRRD(h3, b_ + 14336); \
        asm volatile("s_waitcnt lgkmcnt(0)" ::: "memory"); __builtin_amdgcn_sched_barrier(0); \
        o[d0] = __builtin_amdgcn_mfma_f32_32x32x16_bf16((bf16x8){l0[0], l0[1], l0[2], l0[3], h0[0], h0[1], h0[2], h0[3]}, pa[0], o[d0], 0, 0, 0); \
        o[d0] = __builtin_amdgcn_mfma_f32_32x32x16_bf16((bf16x8){l1[0], l1[1], l1[2], l1[3], h1[0], h1[1], h1[2], h1[3]}, pa[1], o[d0], 0, 0, 0); \
        o[d0] = __builtin_amdgcn_mfma_f32_32x32x16_bf16((bf16x8){l2[0], l2[1], l2[2], l2[3], h2[0], h2[1], h2[2], h2[3]}, pa[2], o[d0], 0, 0, 0); \
        o[d0] = __builtin_amdgcn_mfma_f32_32x32x16_bf16((bf16x8){l3[0], l3[1], l3[2], l3[3], h3[0], h3[1], h3[2], h3[3]}, pa[3], o[d0], 0, 0, 0); } while (0)
    FA_PV_D0(0); FA_PV_D0(1); FA_PV_D0(2); FA_PV_D0(3);
#undef FA_PV_D0
}
DI void mask_tile(f32x16& p0, f32x16& p1, int dq, unsigned W) {
    const float NEG = -__builtin_inff();
#pragma unroll
    for (int r = 0; r < 16; ++r) {
        const int c = (r & 3) + 8 * (r >> 2);
        if ((unsigned)(dq - c) >= W) p0[r] = NEG;
        if ((unsigned)(dq - c - 32) >= W) p1[r] = NEG;
    }
}
DI void bias_tile(f32x16& p0, f32x16& p1, int dq, const LAS float* tab) {
#pragma unroll
    for (int r = 0; r < 16; ++r) {
        const int c = (r & 3) + 8 * (r >> 2);
        int d0 = dq - c, d1 = dq - c - 32;
        d0 = d0 < 0 ? 0 : (d0 > 127 ? 127 : d0); d1 = d1 < 0 ? 0 : (d1 > 127 ? 127 : d1);
        p0[r] += tab[d0]; p1[r] += tab[d1];
    }
}
#ifndef FA_PROBE
#define FA_PROBE 0
#endif
template <int DQK, int NBUF, class TF, class AF, class PF, class MF>
DI void fa_pass_simple(LAS unsigned char* lds, int wid_s, const bf16x8 (&qr)[DQK / 16], f32x16 (&o)[4], float& m, float& l, int nt, TF tilef, const KSrc& ks, const VSrc& vs, AF activef, PF pref, MF postf) {
    constexpr int NL = (DQK / 64 + 2) * (FA_PROBE == 1 ? 2 : 1);
    const int lane = opaque_tid(0), r32 = lane & 31, hi = lane >> 5, wid = wid_s;
    const int vb0 = (int)(unsigned)(size_t)lds + LDS_V + v_rd_base(lane);
    if (nt <= 0) return;
#pragma unroll
    for (int d0 = 0; d0 < DQK / 16; ++d0) asm volatile("" :: "v"(qr[d0]));
    stage_dma<DQK>(lds, 0, ks, vs, __builtin_amdgcn_readfirstlane(tilef(0)) * 64, wid, lane);
    if (NBUF == 3 && nt > 1) { stage_dma<DQK>(lds, 1, ks, vs, __builtin_amdgcn_readfirstlane(tilef(1)) * 64, wid, lane); asm volatile("s_waitcnt vmcnt(%0) lgkmcnt(0)\n\ts_barrier" :: "n"(NL) : "memory"); }
    else asm volatile("s_waitcnt vmcnt(0) lgkmcnt(0)\n\ts_barrier" ::: "memory");
    int buf = 0;
#pragma unroll 1
    for (int tt = 0; tt < nt; ++tt) {
        const int j = __builtin_amdgcn_readfirstlane(tilef(tt));
        const bool act = activef(j);
        const auto aux = pref(j);
        const int nb = (NBUF == 3) ? (buf == 0 ? 2 : buf - 1) : (buf ^ 1);
        const bool more = tt + (NBUF - 1) < nt;
        if (more) stage_dma<DQK>(lds, nb, ks, vs, __builtin_amdgcn_readfirstlane(tilef(tt + NBUF - 1)) * 64, wid, lane);
        if (FA_PROBE == 1 && more) stage_dma<DQK>(lds, nb, ks, vs, tilef(tt + NBUF - 1) * 64, wid, lane);
        if (act) {
            f32x16 p0, p1; bf16x8 pa[4];
            if (FA_PROBE == 3) { float m2 = m, l2 = l; f32x16 o2[4]; for (int d = 0; d < 4; ++d) o2[d] = o[d]; qkt<DQK>(p0, p1, lds, buf, r32, hi, qr); postf(p0, p1, j, aux); softmax_tile(p0, p1, m2, l2, o2, pa); asm volatile("" :: "v"(pa[0]), "v"(pa[1]), "v"(pa[2]), "v"(pa[3]), "v"(m2), "v"(l2)); }
            qkt<DQK>(p0, p1, lds, buf, r32, hi, qr);
            postf(p0, p1, j, aux);
            softmax_tile(p0, p1, m, l, o, pa);
            pv_tile(o, vb0 + buf * SHM_V, pa);
            if (FA_PROBE == 4) { f32x16 o2[4]; for (int d = 0; d < 4; ++d) o2[d] = o[d]; pv_tile(o2, vb0 + buf * SHM_V, pa); asm volatile("" :: "v"(o2[0]), "v"(o2[1]), "v"(o2[2]), "v"(o2[3])); }
        }
        if (FA_PROBE == 2) asm volatile("s_barrier" ::: "memory");
        if (NBUF == 3 && more) asm volatile("s_waitcnt vmcnt(%0) lgkmcnt(0)\n\ts_barrier" :: "n"(NL) : "memory");
        else asm volatile("s_waitcnt vmcnt(0) lgkmcnt(0)\n\ts_barrier" ::: "memory");
        buf = (NBUF == 3) ? (buf == 2 ? 0 : buf + 1) : (buf ^ 1);
    }
}
#define FA_TRRD2(dst, off) asm volatile("ds_read_b64_tr_b16 %0, %1 offset:%2" : "=&v"(dst) : "v"(vb), "i"(off) : "memory")
#define FA_KRD(dst, base, off) asm volatile("ds_read_b128 %0, %1 offset:%2" : "=&v"(dst) : "v"(base), "i"(off) : "memory")
#define FA_LGKM(n) do { asm volatile("s_waitcnt lgkmcnt(%0)" :: "n"(n) : "memory"); __builtin_amdgcn_sched_barrier(0); } while (0)
struct VFrag { s16x4 l0, h0, l1, h1, l2, h2, l3, h3; };
template <int D0> DI void pv_read(VFrag& f, int vb) { constexpr int b_ = v_rd_off(D0, 0, 0);
    FA_TRRD2(f.l0, b_); FA_TRRD2(f.h0, b_ + 2048); FA_TRRD2(f.l1, b_ + 4096); FA_TRRD2(f.h1, b_ + 6144); FA_TRRD2(f.l2, b_ + 8192); FA_TRRD2(f.h2, b_ + 10240); FA_TRRD2(f.l3, b_ + 12288); FA_TRRD2(f.h3, b_ + 14336); }
DI void pv_mma(f32x16& od, const VFrag& f, const bf16x8 (&pa)[4]) {
    od = __builtin_amdgcn_mfma_f32_32x32x16_bf16((bf16x8){f.l0[0], f.l0[1], f.l0[2], f.l0[3], f.h0[0], f.h0[1], f.h0[2], f.h0[3]}, pa[0], od, 0, 0, 0);
    od = __builtin_amdgcn_mfma_f32_32x32x16_bf16((bf16x8){f.l1[0], f.l1[1], f.l1[2], f.l1[3], f.h1[0], f.h1[1], f.h1[2], f.h1[3]}, pa[1], od, 0, 0, 0);
    od = __builtin_amdgcn_mfma_f32_32x32x16_bf16((bf16x8){f.l2[0], f.l2[1], f.l2[2], f.l2[3], f.h2[0], f.h2[1], f.h2[2], f.h2[3]}, pa[2], od, 0, 0, 0);
    od = __builtin_amdgcn_mfma_f32_32x32x16_bf16((bf16x8){f.l3[0], f.l3[1], f.l3[2], f.l3[3], f.h3[0], f.h3[1], f.h3[2], f.h3[3]}, pa[3], od, 0, 0, 0);
}
DI void pv_pipe(f32x16 (&o)[4], int vb, const bf16x8 (&pa)[4]) {
    VFrag f0, f1, f2;
    pv_read<0>(f0, vb); pv_read<1>(f1, vb);
    FA_LGKM(8); pv_mma(o[0], f0, pa); __builtin_amdgcn_sched_barrier(0); pv_read<2>(f2, vb);
    FA_LGKM(8); pv_mma(o[1], f1, pa); __builtin_amdgcn_sched_barrier(0); pv_read<3>(f0, vb);
    FA_LGKM(8); pv_mma(o[2], f2, pa); __builtin_amdgcn_sched_barrier(0);
    FA_LGKM(0); pv_mma(o[3], f0, pa); __builtin_amdgcn_sched_barrier(0);
}
struct KFrag { bf16x8 a0, a1, b0, b1; };
template <int S> DI void qk_read(KFrag& f, const int (&kbm)[4], const int (&kbe)[4]) {
    if constexpr (S < 4) { constexpr int dA = 2 * S, dB = 2 * S + 1;
        FA_KRD(f.a0, kbm[dA & 3], (dA >> 2) * 128); FA_KRD(f.a1, kbm[dA & 3], (dA >> 2) * 128 + 32 * 256);
        FA_KRD(f.b0, kbm[dB & 3], (dB >> 2) * 128); FA_KRD(f.b1, kbm[dB & 3], (dB >> 2) * 128 + 32 * 256); }
    else { constexpr int eA = 2 * S - 8, eB = 2 * S - 7;
        FA_KRD(f.a0, kbe[eA], 0); FA_KRD(f.a1, kbe[eA], 32 * 128);
        FA_KRD(f.b0, kbe[eB], 0); FA_KRD(f.b1, kbe[eB], 32 * 128); }
}
template <int S, int NQ> DI void qk_mma(f32x16& p0, f32x16& p1, const KFrag& f, const bf16x8 (&qr)[NQ]) {
    p0 = __builtin_amdgcn_mfma_f32_32x32x16_bf16(f.a0, qr[2 * S], p0, 0, 0, 0); p1 = __builtin_amdgcn_mfma_f32_32x32x16_bf16(f.a1, qr[2 * S], p1, 0, 0, 0);
    p0 = __builtin_amdgcn_mfma_f32_32x32x16_bf16(f.b0, qr[2 * S + 1], p0, 0, 0, 0); p1 = __builtin_amdgcn_mfma_f32_32x32x16_bf16(f.b1, qr[2 * S + 1], p1, 0, 0, 0);
}
template <int DQK> DI void qk_pipe(f32x16& p0, f32x16& p1, int ldsK, int r32, int hi, const bf16x8 (&qr)[DQK / 16], float ini) {
    constexpr int NS = DQK / 32;
    int kbm[4], kbe[4];
#pragma unroll
    for (int dd = 0; dd < 4; ++dd) { kbm[dd] = ldsK + r32 * 256 + (((dd * 2 + hi) ^ (r32 & 7)) << 4); kbe[dd] = ldsK + 16384 + r32 * 128 + (((dd * 2 + hi) ^ (r32 & 7)) << 4); }
#pragma unroll
    for (int i = 0; i < 16; ++i) { p0[i] = ini; p1[i] = ini; }
    KFrag f0, f1, f2;
    qk_read<0>(f0, kbm, kbe); qk_read<1>(f1, kbm, kbe);
    FA_LGKM(4); qk_mma<0>(p0, p1, f0, qr); __builtin_amdgcn_sched_barrier(0); qk_read<2>(f2, kbm, kbe);
    FA_LGKM(4); qk_mma<1>(p0, p1, f1, qr); __builtin_amdgcn_sched_barrier(0); qk_read<3>(f0, kbm, kbe);
    if constexpr (NS == 4) {
        FA_LGKM(4); qk_mma<2>(p0, p1, f2, qr); __builtin_amdgcn_sched_barrier(0);
        FA_LGKM(0); qk_mma<3>(p0, p1, f0, qr); __builtin_amdgcn_sched_barrier(0);
    } else {
        FA_LGKM(4); qk_mma<2>(p0, p1, f2, qr); __builtin_amdgcn_sched_barrier(0); qk_read<4>(f1, kbm, kbe);
        FA_LGKM(4); qk_mma<3>(p0, p1, f0, qr); __builtin_amdgcn_sched_barrier(0); qk_read<5>(f2, kbm, kbe);
        FA_LGKM(4); qk_mma<4>(p0, p1, f1, qr); __builtin_amdgcn_sched_barrier(0);
        FA_LGKM(0); qk_mma<5>(p0, p1, f2, qr); __builtin_amdgcn_sched_barrier(0);
    }
}
DI void fa_pin(int&) {}
DI void fa_pin(u64& a) { asm volatile("" : "+v"(a)); }
template <int DQK, class TF, class AF, class PF, class CF, class MF>
DI void fa_pass(LAS unsigned char* lds, int wid_s, const bf16x8 (&qr)[DQK / 16], f32x16 (&o)[4], float& m, float& l, int nt, TF tilef, const KSrc& ks, const VSrc& vs, AF activef, PF pref, CF cbf, MF postf) {
    static_assert(DQK == 128 || DQK == 192, "fa_pass: DQK 128 or 192");
    constexpr int NL = DQK / 64 + 2, KBYTES = 64 * DQK * 2;
    const int lane = opaque_tid(0), r32 = lane & 31, hi = lane >> 5, wid = wid_s;
    const int vb0 = (int)(unsigned)(size_t)lds + LDS_V + v_rd_base(lane);
    if (nt <= 0) return;
#pragma unroll
    for (int d0 = 0; d0 < DQK / 16; ++d0) asm volatile("" :: "v"(qr[d0]));
    unsigned offK[2], offE = 0u, offV[2];
#pragma unroll
    for (int i = 0; i < 2; ++i) {
        { const int q = (i * 8 + wid) * 64 + lane, row = q >> 4, pc = q & 15, cc = (pc & 8) | ((pc & 7) ^ (row & 7)); offK[i] = (unsigned)(row * ks.pitch + cc * 8) * 2u; }
        { const int q = (i * 8 + wid) * 64 + lane, st = q >> 5, key = (st >> 2) * 8 + ((q >> 2) & 7), col = (st & 3) * 32 + (q & 3) * 8; offV[i] = (unsigned)(key * vs.pitch + col) * 2u; }
    }
    if (DQK == 192) { const int q = wid * 64 + lane, row = q >> 3, pc = q & 7, cc = pc ^ (row & 7); offE = (unsigned)(row * ks.pitch2 + cc * 8) * 2u; }
#define FA_DMA(tau, kb_, vb_) do { const int kbase_ = __builtin_amdgcn_readfirstlane(tilef(tau)) * 64; \
        const char* kp_ = (const char*)(ks.p + (size_t)kbase_ * ks.pitch); const char* vp_ = (const char*)(vs.p + (size_t)kbase_ * vs.pitch); \
        _Pragma("unroll") for (int i_ = 0; i_ < 2; ++i_) __builtin_amdgcn_global_load_lds((const unsigned*)(kp_ + offK[i_]), (LAS unsigned*)(lds + LDS_K + (kb_) * KBYTES + (i_ * 8 + wid) * 1024), 16, 0, 0); \
        if (DQK == 192) { const char* ep_ = (const char*)(ks.p2 + (size_t)kbase_ * ks.pitch2); __builtin_amdgcn_global_load_lds((const unsigned*)(ep_ + offE), (LAS unsigned*)(lds + LDS_K + (kb_) * KBYTES + 16384 + wid * 1024), 16, 0, 0); } \
        _Pragma("unroll") for (int i_ = 0; i_ < 2; ++i_) __builtin_amdgcn_global_load_lds((const unsigned*)(vp_ + offV[i_]), (LAS unsigned*)(lds + LDS_V + (vb_) * SHM_V + (i_ * 8 + wid) * 1024), 16, 0, 0); } while (0)
#define FA_BAR() asm volatile("s_waitcnt lgkmcnt(0)\n\ts_barrier" ::: "memory")
    FA_DMA(0, 0, 0);
    if (nt > 1) { FA_DMA(1, 1, 1); asm volatile("s_waitcnt vmcnt(%0)" :: "n"(NL) : "memory"); } else asm volatile("s_waitcnt vmcnt(0)" ::: "memory");
    FA_BAR();
    if (wid >= 4) FA_BAR();
    int kb = 0, vb = 0;
    bool act_prev = false; bf16x8 pa[4];
    int vb_prev = 0;
#pragma unroll 1
    for (int tt = 0; tt < nt; ++tt) {
        const int j = __builtin_amdgcn_readfirstlane(tilef(tt));
        const bool act = activef(j);
        auto aux = pref(j);
        const bool more = tt + 2 < nt;
        if (more) { const int kb2 = kb == 0 ? 2 : kb - 1, vb2 = (vb + 2) & 3; FA_DMA(tt + 2, kb2, vb2); }
        __builtin_amdgcn_s_setprio(1);
        if (act_prev) pv_pipe(o, vb0 + vb_prev * SHM_V, pa);
        f32x16 p0, p1;
        if (act) qk_pipe<DQK>(p0, p1, (int)(unsigned)(size_t)lds + LDS_K + kb * KBYTES, r32, hi, qr, cbf(j) - (m > -1e29f ? m : 0.f));
        __builtin_amdgcn_s_setprio(0);
        if (more) asm volatile("s_waitcnt vmcnt(%0)" :: "n"(NL) : "memory"); else asm volatile("s_waitcnt vmcnt(0)" ::: "memory");
        fa_pin(aux);
        FA_BAR();
        if (act) { postf(p0, p1, j, aux); softmax_lazy(p0, p1, m, l, o, pa); }
        FA_BAR();
        act_prev = act; vb_prev = vb;
        kb = kb == 2 ? 0 : kb + 1; vb = (vb + 1) & 3;
    }
    if (act_prev) pv_pipe(o, vb0 + vb_prev * SHM_V, pa);
    FA_BAR();
    if (wid < 4) FA_BAR();
#undef FA_DMA
#undef FA_BAR
}
DI void write_o(const f32x16 (&o)[4], float l, u16* dst, int pitch) {
    const float inv = l > 0.f ? 1.f / l : 0.f;
    const int lane = opaque_tid(0), rr = lane & 31, hi = lane >> 5;
    u16* rowp = dst + (size_t)rr * pitch + 4 * hi;
#pragma unroll
    for (int d0 = 0; d0 < 4; ++d0)
#pragma unroll
        for (int g4 = 0; g4 < 4; ++g4) {
            uint2 w; w.x = pk2(o[d0][4 * g4 + 0] * inv, o[d0][4 * g4 + 1] * inv); w.y = pk2(o[d0][4 * g4 + 2] * inv, o[d0][4 * g4 + 3] * inv);
            *(uint2*)(rowp + d0 * 32 + 8 * g4) = w;
        }
}
}


DI bool split_arrive_merge(unsigned char* glds, int wid_s, unsigned char* ws, int pslot, int chunk, unsigned* cntb, fa::f32x16 (&o)[4], float& m, float& l) {
    using namespace fa;
    const int lane = opaque_tid(0), rr = lane & 31, hi = lane >> 5, row = wid_s * 32 + rr;
    unsigned char* mine = ws + WS_PART + (size_t)(pslot * 2 + chunk) * PART_BYTES;
    const unsigned char* other = ws + WS_PART + (size_t)(pslot * 2 + (chunk ^ 1)) * PART_BYTES;
    {
        const float inv = l > 0.f ? 1.f / l : 0.f;
        u64* po = (u64*)(mine + (size_t)row * 256 + 8 * hi);
#pragma unroll
        for (int d0 = 0; d0 < 4; ++d0)
#pragma unroll
            for (int g4 = 0; g4 < 4; ++g4) {
                const u64 w = (u64)pk2(o[d0][4 * g4 + 0] * inv, o[d0][4 * g4 + 1] * inv) | ((u64)pk2(o[d0][4 * g4 + 2] * inv, o[d0][4 * g4 + 3] * inv) << 32);
                po[d0 * 8 + 2 * g4] = w;
            }
        if (hi == 0) *(u64*)(mine + 65536 + (size_t)row * 8) = (u64)__float_as_uint(m) | ((u64)__float_as_uint(l) << 32);
    }
    asm volatile("s_waitcnt vmcnt(0)" ::: "memory");
    __syncthreads();
    volatile LAS unsigned* flag = (volatile LAS unsigned*)(glds + LDS_MISC + 24);
    if (wid_s == 0 && lane == 0) {
        __builtin_amdgcn_fence(__ATOMIC_RELEASE, "agent");
        asm volatile("s_waitcnt vmcnt(0)" ::: "memory");
        *flag = __hip_atomic_fetch_add(cntb + pslot, 1u, __ATOMIC_RELAXED, __HIP_MEMORY_SCOPE_AGENT);
    }
    __syncthreads();
    if (__builtin_amdgcn_readfirstlane(*flag) == 0u) return false;
    __builtin_amdgcn_fence(__ATOMIC_ACQUIRE, "agent");
    asm volatile("s_waitcnt vmcnt(0)" ::: "memory");
    const u64 ml = *(const u64*)(other + 65536 + (size_t)row * 8);
    const float m2 = __uint_as_float((u32)ml), l2 = __uint_as_float((u32)(ml >> 32));
    const float M = fmaxf(m, m2);
    const float a1 = __fmul_rn(__builtin_amdgcn_exp2f(m - M), l), a2 = __fmul_rn(__builtin_amdgcn_exp2f(m2 - M), l2), den = __fadd_rn(a1, a2);
    const float r1 = den > 0.f ? a1 / den : 0.f, r2 = den > 0.f ? a2 / den : 0.f;
    const float inv = l > 0.f ? 1.f / l : 0.f;
    const u64* qo = (const u64*)(other + (size_t)row * 256 + 8 * hi);
#pragma unroll
    for (int d0 = 0; d0 < 4; ++d0)
#pragma unroll
        for (int g4 = 0; g4 < 4; ++g4) {
            const u64 w = qo[d0 * 8 + 2 * g4];
            const u32 s0 = pk2(o[d0][4 * g4 + 0] * inv, o[d0][4 * g4 + 1] * inv), s1 = pk2(o[d0][4 * g4 + 2] * inv, o[d0][4 * g4 + 3] * inv);
            o[d0][4 * g4 + 0] = __fadd_rn(__fmul_rn(bf2f(s0 & 0xffffu), r1), __fmul_rn(bf2f((u32)w & 0xffffu), r2));
            o[d0][4 * g4 + 1] = __fadd_rn(__fmul_rn(bf2f(s0 >> 16), r1), __fmul_rn(bf2f(((u32)w) >> 16), r2));
            o[d0][4 * g4 + 2] = __fadd_rn(__fmul_rn(bf2f(s1 & 0xffffu), r1), __fmul_rn(bf2f((u32)(w >> 32) & 0xffffu), r2));
            o[d0][4 * g4 + 3] = __fadd_rn(__fmul_rn(bf2f(s1 >> 16), r1), __fmul_rn(bf2f((u32)(w >> 48)), r2));
        }
    m = M; l = den > 0.f ? 1.f : 0.f;
    return true;
}

DI void mla_unit(unsigned char* glds, int wid_s, int h, int qb, int chunk, unsigned* cnt) {
    using namespace fa;
    LAS unsigned char* lds = (LAS unsigned char*)glds; const int tid = opaque_tid(wid_s); unsigned char* const ws = (unsigned char*)(GAS unsigned char*)ldp(glds, 21);
    const int lane = tid & 63, wid = wid_s, r32 = lane & 31, hi = lane >> 5;
    const int row0 = qb * 256 + wid * 32, row = row0 + r32;
    u16* mqn = (u16*)(ws + WS_MQN); const u16* mqr = (const u16*)(ws + WS_MQR);
    bf16x8 qr[12];
#pragma unroll
    for (int d0 = 0; d0 < 8; ++d0) qr[d0] = *(const bf16x8*)(mqn + (size_t)row * 1024 + h * 128 + d0 * 16 + hi * 8);
#pragma unroll
    for (int d0 = 0; d0 < 4; ++d0) qr[8 + d0] = *(const bf16x8*)(mqr + (size_t)row * 512 + h * 64 + d0 * 16 + hi * 8);
    f32x16 o[4];
#pragma unroll
    for (int d = 0; d < 4; ++d)
#pragma unroll
        for (int r = 0; r < 16; ++r) o[d][r] = 0.f;
    float m = -1e30f, l = 0.f;
    const KSrc ks{(const u16*)(ws + WS_MKN) + h * 128, 1024, (const u16*)(ws + WS_MKR), 64};
    const VSrc vs{(const u16*)(ws + WS_MV) + h * 128, 1024};
    constexpr float C2 = 0.07216878364870322f * LOG2E;
#pragma unroll
    for (int d0 = 0; d0 < 12; ++d0) qr[d0] = scale_frag(qr[d0], C2);
    const int ntt = 4 * (qb + 1), t_lo = chunk == 1 ? ntt / 2 : 0, t_hi = chunk == 0 ? ntt / 2 : ntt;
    fa_pass<192>(lds, wid_s, qr, o, m, l, t_hi - t_lo, [&](int t) { return t_lo + t; }, ks, vs,
        [&](int j) { return j * 64 <= row0 + 31; },
        [](int) { return 0; }, [](int) { return 0.f; },
        [&](f32x16& p0, f32x16& p1, int j, int) {
            if (j * 64 + 63 > row0) mask_tile(p0, p1, row - j * 64 - 4 * hi, 0x80000000u);
        });
    if (chunk >= 0 && !split_arrive_merge(glds, wid_s, ws, h * 8 + (qb & 7), chunk, cnt, o, m, l)) return;
    write_o(o, l, mqn + (size_t)row0 * 1024 + h * 128, 1024);
}
DI void dsa_unit(unsigned char* glds, int wid_s, int h, int qb, int chunk, unsigned* cnt) {
    using namespace fa;
    LAS unsigned char* lds = (LAS unsigned char*)glds; const int tid = opaque_tid(wid_s); unsigned char* const ws = (unsigned char*)(GAS unsigned char*)ldp(glds, 21); const float* relb = (const float*)(GAS unsigned char*)ldp(glds, 3);
    const int lane = tid & 63, wid = wid_s, r32 = lane & 31, hi = lane >> 5;
    const int row0 = qb * 256 + wid * 32, row = row0 + r32;
    u16* proj = (u16*)(ws + WS_PROJ);
    LAS float* tab = (LAS float*)(lds + LDS_TAB);
    if (tid < 128) tab[tid] = relb[relbucket(tid) * 16 + h] * LOG2E;
    bf16x8 qr[8];
#pragma unroll
    for (int d0 = 0; d0 < 8; ++d0) qr[d0] = *(const bf16x8*)(proj + (size_t)row * PP + C_DSAQ + h * 128 + d0 * 16 + hi * 8);
    f32x16 o[4];
#pragma unroll
    for (int d = 0; d < 4; ++d)
#pragma unroll
        for (int r = 0; r < 16; ++r) o[d][r] = 0.f;
    float m = -1e30f, l = 0.f;
    const KSrc ks{proj + C_DSAK + h * 128, PP, nullptr, 0};
    const VSrc vs{proj + C_DSAV + h * 128, PP};
    const u32* mrow = (const u32*)(ws + WS_BITM) + (size_t)row * 128;
    constexpr float C2 = 0.08838834764831845f * LOG2E;
#pragma unroll
    for (int d0 = 0; d0 < 8; ++d0) qr[d0] = scale_frag(qr[d0], C2);
    const int ntt = 4 * (qb + 1), t_lo = chunk == 1 ? ntt / 2 : 0, t_hi = chunk == 0 ? ntt / 2 : ntt;
    fa_pass<128>(lds, wid_s, qr, o, m, l, t_hi - t_lo, [&](int t) { return t_lo + t; }, ks, vs,
        [&](int j) { return j * 64 <= row0 + 31; },
        [&](int j) { u64 w; const u32* ap = mrow + 2 * j; asm volatile("global_load_dwordx2 %0, %1, off" : "=v"(w) : "v"(ap) : "memory"); return w; },
        [&](int j) { return row0 - (j * 64 + 63) >= 127 ? tab[127] : 0.f; },
        [&](f32x16& p0, f32x16& p1, int j, u64 mw64) {
            uint2 mw; mw.x = (u32)mw64; mw.y = (u32)(mw64 >> 32);
            if (!(row0 - (j * 64 + 63) >= 127)) bias_tile(p0, p1, row - j * 64 - 4 * hi, tab);
            const u32 w0 = mw.x >> (4 * hi), w1 = mw.y >> (4 * hi);
            const float NEG = -__builtin_inff();
#pragma unroll
            for (int r = 0; r < 16; ++r) { const int c = (r & 3) + 8 * (r >> 2); if (!((w0 >> c) & 1u)) p0[r] = NEG; if (!((w1 >> c) & 1u)) p1[r] = NEG; }
        });
    if (chunk >= 0 && !split_arrive_merge(glds, wid_s, ws, 64 + h * 8 + (qb & 7), chunk, cnt, o, m, l)) return;
    write_o(o, l, proj + (size_t)row0 * PP + C_DSAQ + h * 128, PP);
}

DI void cross_unit(unsigned char* glds, int wid_s, int bb, int h, int qb) {
    using namespace fa;
    LAS unsigned char* lds = (LAS unsigned char*)glds; const int tid = opaque_tid(wid_s); unsigned char* const ws = (unsigned char*)(GAS unsigned char*)ldp(glds, 21);
    const int lane = tid & 63, wid = wid_s, r32 = lane & 31, hi = lane >> 5;
    const int row0 = bb * SEQ + qb * 256 + wid * 32, row = row0 + r32;
    u16* cq = (u16*)(ws + WS_CQ); const u16* ckv = (const u16*)(ws + WS_CKV) + (size_t)bb * 256 * 2048;
    bf16x8 qr[16];
#pragma unroll
    for (int d0 = 0; d0 < 16; ++d0) qr[d0] = *(const bf16x8*)(cq + (size_t)row * 1024 + h * 256 + d0 * 16 + hi * 8);
    constexpr float C2 = 0.0625f * LOG2E;
    const KSrc ks{ckv + h * 256, 2048, nullptr, 0};
#pragma unroll 1
    for (int half = 0; half < 2; ++half) {
        f32x16 o[4];
#pragma unroll
        for (int d = 0; d < 4; ++d)
#pragma unroll
            for (int r = 0; r < 16; ++r) o[d][r] = 0.f;
        float m = -1e30f, l = 0.f;
        const VSrc vs{ckv + 1024 + h * 256 + half * 128, 2048};
        fa_pass_simple<256, 2>(lds, wid_s, qr, o, m, l, 4, [](int t) { return t; }, ks, vs,
            [](int) { return true; }, [](int) { return 0; },
            [&](f32x16& p0, f32x16& p1, int, int) {
#pragma unroll
                for (int r = 0; r < 16; ++r) { p0[r] *= C2; p1[r] *= C2; } });
        write_o(o, l, cq + (size_t)row0 * 1024 + h * 256 + half * 128, 1024);
    }
}

template <bool FIRST> DI void nsa_accum(const fa::f32x16 (&o)[4], float l, u16* proj, int t0w, int g, int hg, int gi, u16* dst, int dpitch) {
    const int lane = opaque_tid(0), rr = lane & 31, hh = lane >> 5;
    const u16* gp = proj + (size_t)(t0w + rr) * PP + C_NGATE + gi * 8 + g * 4 + hg;
    const float gate = sigmoidf_(bf2f(*gp));
    const float inv = l > 0.f ? gate / l : 0.f;
    u64* orow = (u64*)(dst + (size_t)(t0w + rr) * dpitch + (g * 4 + hg) * 128 + 4 * hh);
#pragma unroll
    for (int d = 0; d < 4; ++d)
#pragma unroll
        for (int g4 = 0; g4 < 4; ++g4) {
            float a0 = 0.f, a1 = 0.f, a2 = 0.f, a3 = 0.f;
            if (!FIRST) { const u64 w = orow[d * 8 + 2 * g4]; a0 = bf2f((u32)w & 0xffffu); a1 = bf2f(((u32)w) >> 16); a2 = bf2f((u32)(w >> 32) & 0xffffu); a3 = bf2f((u32)(w >> 48)); }
            const u64 w2 = (u64)fa::pk2(a0 + o[d][4 * g4] * inv, a1 + o[d][4 * g4 + 1] * inv) | ((u64)fa::pk2(a2 + o[d][4 * g4 + 2] * inv, a3 + o[d][4 * g4 + 3] * inv) << 32);
            orow[d * 8 + 2 * g4] = w2;
        }
}
DI void nsa_final(const fa::f32x16 (&o)[4], float l, u16* proj, int t0w, int g, int hg, const u16* ow, int owpitch) {
    const int lane = opaque_tid(0), rr = lane & 31, hh = lane >> 5;
    const u16* gp = proj + (size_t)(t0w + rr) * PP + C_NGATE + 1 * 8 + g * 4 + hg;
    const float gate = sigmoidf_(bf2f(*gp));
    const float inv = l > 0.f ? gate / l : 0.f;
    u64* orow = (u64*)(proj + (size_t)(t0w + rr) * PP + C_NSAO + (g * 4 + hg) * 128 + 4 * hh);
    const u64* wrow = (const u64*)(ow + (size_t)(t0w + rr) * owpitch + (g * 4 + hg) * 128 + 4 * hh);
#pragma unroll
    for (int d = 0; d < 4; ++d)
#pragma unroll
        for (int g4 = 0; g4 < 4; ++g4) {
            const u64 a = orow[d * 8 + 2 * g4], c = wrow[d * 8 + 2 * g4];
            const float s0 = bf2f((u32)a & 0xffffu) + bf2f((u32)c & 0xffffu), s1 = bf2f(((u32)a) >> 16) + bf2f(((u32)c) >> 16);
            const float s2 = bf2f((u32)(a >> 32) & 0xffffu) + bf2f((u32)(c >> 32) & 0xffffu), s3 = bf2f((u32)(a >> 48)) + bf2f((u32)(c >> 48));
            orow[d * 8 + 2 * g4] = (u64)fa::pk2(s0 + o[d][4 * g4] * inv, s1 + o[d][4 * g4 + 1] * inv) | ((u64)fa::pk2(s2 + o[d][4 * g4 + 2] * inv, s3 + o[d][4 * g4 + 3] * inv) << 32);
        }
}

DI void nsa_unit(unsigned char* glds, int wid_s, int g, int n, int chunk, unsigned* cntb, unsigned* selfb) {
    using namespace fa;
    LAS unsigned char* lds = (LAS unsigned char*)glds; const int tid = opaque_tid(wid_s); unsigned char* const ws = (unsigned char*)(GAS unsigned char*)ldp(glds, 21); const float* relb = (const float*)(GAS unsigned char*)ldp(glds, 3);
    const int lane = tid & 63, r32 = lane & 31, hi = lane >> 5, hg = wid_s >> 1, qh = wid_s & 1;
    const int q = qh * 32 + r32, t = 64 * n + q, t0w = 64 * n + 32 * qh;
    u16* proj = (u16*)(ws + WS_PROJ);
    LAS float* tab = (LAS float*)(lds + LDS_TAB);
    LAS u32* imp = (LAS u32*)(lds + LDS_TAB + 2048);
    LAS u32* selm = (LAS u32*)(lds + LDS_TAB + 2048 + 16384);
    LAS int* tlist = (LAS int*)(lds + LDS_TAB + 2048 + 16384 + 512);
    tab[tid] = relb[relbucket(tid & 127) * 16 + 8 + g * 4 + (tid >> 7)] * LOG2E;
#pragma unroll
    for (int k = 0; k < 8; ++k) imp[tid + 512 * k] = 0u;
    if (tid < 128) selm[tid] = 0u;
    u16* qrow = proj + (size_t)t * PP + C_NSAQ + (g * 4 + hg) * 128;
    bf16x8 qr[8];
#pragma unroll
    for (int d0 = 0; d0 < 8; ++d0) qr[d0] = *(const bf16x8*)(qrow + d0 * 16 + hi * 8);
    constexpr float C2 = 0.08838834764831845f * LOG2E;
#pragma unroll
    for (int d0 = 0; d0 < 8; ++d0) qr[d0] = scale_frag(qr[d0], C2);
    const LAS float* mytab = tab + hg * 128;
    f32x16 o[4];
#define NSA_ZERO_O() do { _Pragma("unroll") for (int d = 0; d < 4; ++d) _Pragma("unroll") for (int r = 0; r < 16; ++r) o[d][r] = 0.f; } while (0)
    float m = -1e30f, l = 0.f; int nts = 0;
    if (chunk != 1) {
    const int cmaxq = t >= 31 ? ((t - 31) >> 4) : -1;
    const int ntc = (4 * n + 3 + 63) >> 6;
    const KSrc kc{(const u16*)(ws + WS_KCMP) + g * 128, 256, nullptr, 0};
    const VSrc vc{(const u16*)(ws + WS_VCMP) + g * 128, 256};
    m = -1e30f; l = 0.f;
    NSA_ZERO_O();
    fa_pass<128>(lds, wid_s, qr, o, m, l, ntc, [](int tt) { return tt; }, kc, vc,
        [](int) { return true; }, [](int) { return 0; }, [](int) { return 0.f; },
        [&](f32x16& p0, f32x16& p1, int j, int) {
            mask_tile(p0, p1, cmaxq - 64 * j - 4 * hi, 0x80000000u);
        });
    nsa_accum<true>(o, l, proj, t0w, g, hg, 0, proj + C_NSAO, PP);
    {
        const float invl = l > 0.f ? 1.f / l : 0.f;
        fa_pass<128>(lds, wid_s, qr, o, m, l, ntc, [](int tt) { return tt; }, kc, vc,
            [](int) { return true; }, [](int) { return 0; }, [](int) { return 0.f; },
            [&](f32x16& p0, f32x16& p1, int j, int) {
                mask_tile(p0, p1, cmaxq - 64 * j - 4 * hi, 0x80000000u);
#pragma unroll
                for (int r = 0; r < 16; ++r) { p0[r] = __builtin_amdgcn_exp2f(p0[r]) * invl; p1[r] = __builtin_amdgcn_exp2f(p1[r]) * invl; }
#pragma unroll
                for (int gi = 0; gi < 4; ++gi) {
                    const int jj0 = 16 * j + 2 * gi + hi, jj1 = jj0 + 8;
                    const float G0 = (p0[4 * gi] + p0[4 * gi + 1]) + (p0[4 * gi + 2] + p0[4 * gi + 3]), G1 = (p1[4 * gi] + p1[4 * gi + 1]) + (p1[4 * gi + 2] + p1[4 * gi + 3]);
                    constexpr float FX = 67108864.f;
                    if (G0 != 0.f) { __hip_atomic_fetch_add(imp + jj0 * 64 + q, (u32)(G0 * FX + 0.5f), __ATOMIC_RELAXED, __HIP_MEMORY_SCOPE_WORKGROUP);
                                     if (p0[4 * gi + 3] != 0.f) __hip_atomic_fetch_add(imp + (jj0 + 1) * 64 + q, (u32)(p0[4 * gi + 3] * FX + 0.5f), __ATOMIC_RELAXED, __HIP_MEMORY_SCOPE_WORKGROUP); }
                    if (G1 != 0.f) { __hip_atomic_fetch_add(imp + jj1 * 64 + q, (u32)(G1 * FX + 0.5f), __ATOMIC_RELAXED, __HIP_MEMORY_SCOPE_WORKGROUP);
                                     if (jj1 + 1 < 64 && p1[4 * gi + 3] != 0.f) __hip_atomic_fetch_add(imp + (jj1 + 1) * 64 + q, (u32)(p1[4 * gi + 3] * FX + 0.5f), __ATOMIC_RELAXED, __HIP_MEMORY_SCOPE_WORKGROUP); }
                }
                const float NEG = -__builtin_inff();
#pragma unroll
                for (int r = 0; r < 16; ++r) { p0[r] = NEG; p1[r] = NEG; }
            });
    }
    {
#pragma unroll
        for (int k = 0; k < 8; ++k) {
            const int id = tid + 512 * k, jj = id >> 6;
            u32 key = 0u;
            if (jj <= n) { const u32 v = (jj == 0 || jj == n || jj == n - 1) ? 0x3ffffffu : min(imp[id] >> 5, 0x3fffffeu); key = (v << 6) | (u32)(63 - jj); }
            imp[id] = key;
        }
        __syncthreads();
        u32 tk[8]; int cn[8];
#pragma unroll
        for (int e = 0; e < 8; ++e) { tk[e] = imp[(wid_s + 8 * e) * 64 + lane]; cn[e] = 0; }
#pragma unroll 8
        for (int j2 = 0; j2 < 64; ++j2) {
            const u32 x = imp[j2 * 64 + lane];
#pragma unroll
            for (int e = 0; e < 8; ++e) cn[e] += (x > tk[e]) ? 1 : 0;
        }
#pragma unroll
        for (int e = 0; e < 8; ++e) { const int jj = wid_s + 8 * e;
            if (tk[e] != 0u && cn[e] < 16) __hip_atomic_fetch_or(selm + lane * 2 + (jj >> 5), 1u << (jj & 31), __ATOMIC_RELAXED, __HIP_MEMORY_SCOPE_WORKGROUP); }
    }
    __syncthreads();
    {
        u32 u0 = selm[lane * 2], u1 = selm[lane * 2 + 1];
#pragma unroll
        for (int off = 32; off; off >>= 1) { u0 |= __shfl_xor(u0, off); u1 |= __shfl_xor(u1, off); }
        const u64 un = ((u64)u1 << 32) | u0;
        nts = __builtin_amdgcn_readfirstlane(__popcll(un));
        if (wid_s == 0 && ((un >> lane) & 1ull)) tlist[__popcll(un & ((1ull << lane) - 1ull))] = lane;
    }
    __syncthreads();
    if (chunk == 0) {
        u32* sx = (u32*)(ws + WS_SELX) + (size_t)(g * 32 + (n & 31)) * 256;
        if (tid < 128) __hip_atomic_store(sx + tid, selm[tid], __ATOMIC_RELAXED, __HIP_MEMORY_SCOPE_AGENT);
        else if (tid < 192) __hip_atomic_store(sx + tid, (u32)tlist[tid - 128], __ATOMIC_RELAXED, __HIP_MEMORY_SCOPE_AGENT);
        else if (tid == 192) __hip_atomic_store(sx + 192, (u32)nts, __ATOMIC_RELAXED, __HIP_MEMORY_SCOPE_AGENT);
        asm volatile("s_waitcnt vmcnt(0)" ::: "memory");
        __syncthreads();
        if (tid == 0) __hip_atomic_store(selfb + g * 32 + (n & 31), 1u, __ATOMIC_RELAXED, __HIP_MEMORY_SCOPE_AGENT);
    }
    }
    if (chunk != 0) {
        const KSrc ks{proj + C_NKW + g * 128, PP, nullptr, 0};
        const VSrc vs{proj + C_NVW + g * 128, PP};
        const int j0 = n >= 8 ? n - 8 : 0;
        m = -1e30f; l = 0.f;
        NSA_ZERO_O();
        fa_pass<128>(lds, wid_s, qr, o, m, l, n - j0 + 1, [&](int tt) { return j0 + tt; }, ks, vs,
            [](int) { return true; }, [](int) { return 0; },
            [&](int j) { return t0w - (64 * j + 63) >= 127 ? mytab[127] : 0.f; },
            [&](f32x16& p0, f32x16& p1, int j, int) {
                const int dq = t - 64 * j - 4 * hi;
                if (!(t0w - (64 * j + 63) >= 127)) bias_tile(p0, p1, dq, mytab);
                if (!(64 * j + 63 <= t0w && t0w + 31 - 64 * j < 512)) mask_tile(p0, p1, dq, 512u);
            });
        if (chunk < 0) nsa_accum<false>(o, l, proj, t0w, g, hg, 2, proj + C_NSAO, PP);
        else nsa_accum<true>(o, l, proj, t0w, g, hg, 2, (u16*)(ws + WS_MKN), 1024);
    }
    if (chunk == 1) {
        if (tid == 0) { unsigned sp = 0;
            while (__hip_atomic_load(selfb + g * 32 + (n & 31), __ATOMIC_RELAXED, __HIP_MEMORY_SCOPE_AGENT) == 0u) { __builtin_amdgcn_s_sleep(8); if (++sp > (1u << 20)) break; }
            __builtin_amdgcn_fence(__ATOMIC_ACQUIRE, "agent"); asm volatile("s_waitcnt vmcnt(0)" ::: "memory"); }
        __syncthreads();
        const u32* sx = (const u32*)(ws + WS_SELX) + (size_t)(g * 32 + (n & 31)) * 256;
        if (tid < 128) selm[tid] = sx[tid]; else if (tid < 192) tlist[tid - 128] = (int)sx[tid];
        nts = __builtin_amdgcn_readfirstlane((int)sx[192]);
        __syncthreads();
    }
    const u32 ms0 = selm[q * 2], ms1 = selm[q * 2 + 1];
    {
        const KSrc ks{proj + C_NKS + g * 128, PP, nullptr, 0};
        const VSrc vs{proj + C_NVS + g * 128, PP};
        m = -1e30f; l = 0.f;
        NSA_ZERO_O();
        const int half = (nts + 1) >> 1, t_lo = chunk == 1 ? half : 0, t_hi = chunk == 0 ? half : nts;
        fa_pass<128>(lds, wid_s, qr, o, m, l, t_hi - t_lo, [&](int tt) { return tlist[t_lo + tt]; }, ks, vs,
            [&](int j) { const u32 w = j < 32 ? ms0 : ms1; return __any((w >> (j & 31)) & 1u) != 0; },
            [](int) { return 0; },
            [&](int j) { return t0w - (64 * j + 63) >= 127 ? mytab[127] : 0.f; },
            [&](f32x16& p0, f32x16& p1, int j, int) {
                const int dq = t - 64 * j - 4 * hi;
                if (!(t0w - (64 * j + 63) >= 127)) bias_tile(p0, p1, dq, mytab);
                if (j == n) mask_tile(p0, p1, dq, 0x80000000u);
                const u32 w = j < 32 ? ms0 : ms1;
                if (!((w >> (j & 31)) & 1u)) { const float NEG = -__builtin_inff();
#pragma unroll
                    for (int r = 0; r < 16; ++r) { p0[r] = NEG; p1[r] = NEG; } }
            });
        if (chunk >= 0) { if (!split_arrive_merge(glds, wid_s, ws, 128 + g * 32 + (n & 31), chunk, cntb, o, m, l)) return; nsa_final(o, l, proj, t0w, g, hg, (const u16*)(ws + WS_MKN), 1024); }
        else nsa_accum<false>(o, l, proj, t0w, g, hg, 1, proj + C_NSAO, PP);
    }
#undef NSA_ZERO_O
}

__device__ const unsigned short ATT4_ITEMS[192] = {240, 248, 241, 249, 242, 250, 243, 251, 244, 252, 245, 253, 246, 254, 247, 255, 224, 232, 225, 233, 226, 234, 227, 235, 228, 236, 229, 237, 230, 238, 231, 239, 112, 113, 114, 115, 116, 117, 118, 119, 208, 216, 209, 217, 210, 218, 211, 219, 212, 220, 213, 221, 214, 222, 215, 223, 192, 200, 193, 201, 194, 202, 195, 203, 196, 204, 197, 205, 198, 206, 199, 207, 96, 97, 98, 99, 100, 101, 102, 103, 176, 184, 177, 185, 178, 186, 179, 187, 180, 188, 181, 189, 182, 190, 183, 191, 160, 168, 161, 169, 162, 170, 163, 171, 164, 172, 165, 173, 166, 174, 167, 175, 80, 81, 82, 83, 84, 85, 86, 87, 144, 152, 145, 153, 146, 154, 147, 155, 148, 156, 149, 157, 150, 158, 151, 159, 128, 136, 129, 137, 130, 138, 131, 139, 132, 140, 133, 141, 134, 142, 135, 143, 64, 65, 66, 67, 68, 69, 70, 71, 48, 49, 50, 51, 52, 53, 54, 55, 32, 33, 34, 35, 36, 37, 38, 39, 16, 17, 18, 19, 20, 21, 22, 23, 0, 1, 2, 3, 4, 5, 6, 7};
constexpr int N_ATT4 = 192;
__device__ const unsigned short ATT5_ITEMS[384] = {2544, 2545, 2528, 2529, 2512, 2513, 2496, 2497, 2480, 2481, 2464, 2465, 3040, 3041, 3056, 3057, 2448, 2449, 3008, 3009, 3024, 3025, 2432, 2433, 2976, 2977, 2992, 2993, 2416, 2417, 2944, 2945, 2960, 2961, 2400, 2401, 2912, 2913, 2928, 2929, 2384, 2385, 2880, 2881, 2896, 2897, 2368, 2369, 2848, 2849, 2864, 2865, 2352, 2353, 2816, 2817, 2832, 2833, 2336, 2337, 2320, 2321, 3058, 3059, 2304, 2305, 3026, 3027, 3042, 3043, 2784, 2785, 2800, 2801, 2994, 2995, 3010, 3011, 2752, 2753, 2768, 2769, 2962, 2963, 2978, 2979, 2720, 2721, 2736, 2737, 2288, 2289, 2930, 2931, 2946, 2947, 2688, 2689, 2704, 2705, 2272, 2273, 2898, 2899, 2914, 2915, 2656, 2657, 2672, 2673, 2256, 2257, 2866, 2867, 2882, 2883, 2624, 2625, 2640, 2641, 2240, 2241, 2834, 2835, 2850, 2851, 2592, 2593, 2608, 2609, 2224, 2225, 2802, 2803, 2818, 2819, 2560, 2561, 2576, 2577, 2208, 2209, 2770, 2771, 2786, 2787, 2192, 2193, 2738, 2739, 2754, 2755, 2176, 2177, 2706, 2707, 2722, 2723, 2674, 2675, 2690, 2691, 2160, 2161, 2642, 2643, 2658, 2659, 1264, 1265, 1266, 1267, 1268, 1269, 1270, 1271, 1272, 1273, 1274, 1275, 1276, 1277, 1278, 1279, 2610, 2611, 2626, 2627, 2144, 2145, 2578, 2579, 2594, 2595, 1248, 1249, 1250, 1251, 1252, 1253, 1254, 1255, 1256, 1257, 1258, 1259, 1260, 1261, 1262, 1263, 2562, 2563, 2128, 2129, 1136, 1137, 1138, 1139, 1140, 1141, 1142, 1143, 1232, 1233, 1234, 1235, 1236, 1237, 1238, 1239, 1240, 1241, 1242, 1243, 1244, 1245, 1246, 1247, 2112, 2113, 1216, 1217, 1218, 1219, 1220, 1221, 1222, 1223, 1224, 1225, 1226, 1227, 1228, 1229, 1230, 1231, 2096, 2097, 1120, 1121, 1122, 1123, 1124, 1125, 1126, 1127, 1200, 1201, 1202, 1203, 1204, 1205, 1206, 1207, 1208, 1209, 1210, 1211, 1212, 1213, 1214, 1215, 2080, 2081, 1184, 1185, 1186, 1187, 1188, 1189, 1190, 1191, 1192, 1193, 1194, 1195, 1196, 1197, 1198, 1199, 2064, 2065, 1104, 1105, 1106, 1107, 1108, 1109, 1110, 1111, 1168, 1169, 1170, 1171, 1172, 1173, 1174, 1175, 1176, 1177, 1178, 1179, 1180, 1181, 1182, 1183, 2048, 2049, 1152, 1153, 1154, 1155, 1156, 1157, 1158, 1159, 1160, 1161, 1162, 1163, 1164, 1165, 1166, 1167, 1088, 1089, 1090, 1091, 1092, 1093, 1094, 1095, 1072, 1073, 1074, 1075, 1076, 1077, 1078, 1079, 1056, 1057, 1058, 1059, 1060, 1061, 1062, 1063, 1040, 1041, 1042, 1043, 1044, 1045, 1046, 1047, 1024, 1025, 1026, 1027, 1028, 1029, 1030, 1031};
constexpr int N_ATT5 = 384;
constexpr int SPLIT_QB = 8, SPLIT_N = 32;

DI size_t score_off(int rb) { const int m = rb >> 1; return (size_t)2048 * ((rb & 1) ? (m + 1) * (m + 1) : m * (m + 1)); }
DI void idx_score_unit(unsigned char* glds, int wid_s, int rb, int kq) {
    using namespace fa;
    LAS unsigned char* lds = (LAS unsigned char*)glds; const int tid = opaque_tid(wid_s); unsigned char* const ws = (unsigned char*)(GAS unsigned char*)ldp(glds, 21);
    const int lane = tid & 63, r32 = lane & 31, hi = lane >> 5;
    const u16* proj = (const u16*)(ws + WS_PROJ);
    const int ntile = (rb >> 1) + 1, width = 64 * ntile;
    __syncthreads();
#pragma unroll
    for (int i = 0; i < 4; ++i) { const int id = tid + 512 * i, row = id >> 6, c = id & 63;
        const u32x4 v = *(const u32x4*)(proj + (size_t)(32 * rb + row) * PP + C_IDXQ + c * 8);
        *(LAS u32x4*)(lds + row * 1024 + (((c & ~7) | ((c & 7) ^ (row & 7))) << 4)) = v; }
    if (tid < 256) { const int row = tid >> 3, hh = tid & 7; ((LAS float*)(lds + 32768))[row * 8 + hh] = bf2f(proj[(size_t)(32 * rb + row) * PP + C_IDXW + hh]); }
    __syncthreads();
    float* sc = (float*)(ws + WS_SCORE) + score_off(rb) + (size_t)r32 * width + 4 * hi;
    LAS unsigned char* qbase = lds + r32 * 1024;
    const int sw = r32 & 7;
    bf16x8 kn[2][4];
    { const int j0 = kq * 8 + wid_s, jc = j0 < ntile ? j0 : 0;
#pragma unroll
      for (int half = 0; half < 2; ++half)
#pragma unroll
          for (int ks = 0; ks < 4; ++ks) kn[half][ks] = *(const bf16x8*)(proj + (size_t)(64 * jc + 32 * half + r32) * PP + C_IDXK + ks * 16 + hi * 8); }
#pragma unroll 1
    for (int j = kq * 8 + wid_s; j < ntile; j += 32) {
        asm volatile("" ::: "memory");
        bf16x8 kf[2][4];
#pragma unroll
        for (int half = 0; half < 2; ++half)
#pragma unroll
            for (int ks = 0; ks < 4; ++ks) kf[half][ks] = kn[half][ks];
        { const int jn = j + 32 < ntile ? j + 32 : j;
#pragma unroll
          for (int half = 0; half < 2; ++half)
#pragma unroll
              for (int ks = 0; ks < 4; ++ks) kn[half][ks] = *(const bf16x8*)(proj + (size_t)(64 * jn + 32 * half + r32) * PP + C_IDXK + ks * 16 + hi * 8); }
        f32x16 a0, a1;
#pragma unroll
        for (int r = 0; r < 16; ++r) { a0[r] = 0.f; a1[r] = 0.f; }
#pragma unroll 1
        for (int h = 0; h < 8; ++h) {
            const float iwh = ((const LAS float*)(lds + 32768))[r32 * 8 + h];
            f32x16 p0, p1;
#pragma unroll
            for (int r = 0; r < 16; ++r) { p0[r] = 0.f; p1[r] = 0.f; }
#pragma unroll
            for (int ks = 0; ks < 4; ++ks) {
                const bf16x8 qf = *(const LAS bf16x8*)(qbase + h * 128 + (((ks * 2 + hi) ^ sw) << 4));
                p0 = __builtin_amdgcn_mfma_f32_32x32x16_bf16(kf[0][ks], qf, p0, 0, 0, 0);
                p1 = __builtin_amdgcn_mfma_f32_32x32x16_bf16(kf[1][ks], qf, p1, 0, 0, 0);
            }
#pragma unroll
            for (int r = 0; r < 16; ++r) { a0[r] = fmaf(iwh, fmaxf(p0[r], 0.f), a0[r]); a1[r] = fmaf(iwh, fmaxf(p1[r], 0.f), a1[r]); }
        }
#pragma unroll
        for (int g4 = 0; g4 < 4; ++g4) {
            *(f32x4*)(sc + 64 * j + 8 * g4) = (f32x4){a0[4 * g4], a0[4 * g4 + 1], a0[4 * g4 + 2], a0[4 * g4 + 3]};
            *(f32x4*)(sc + 64 * j + 32 + 8 * g4) = (f32x4){a1[4 * g4], a1[4 * g4 + 1], a1[4 * g4 + 2], a1[4 * g4 + 3]};
        }
    }
}

DI int wave_total_i(int v) {
    v += __builtin_amdgcn_update_dpp(0, v, 0x111, 0xf, 0xf, false);
    v += __builtin_amdgcn_update_dpp(0, v, 0x112, 0xf, 0xf, false);
    v += __builtin_amdgcn_update_dpp(0, v, 0x114, 0xf, 0xf, false);
    v += __builtin_amdgcn_update_dpp(0, v, 0x118, 0xf, 0xf, false);
    v += __builtin_amdgcn_update_dpp(0, v, 0x142, 0xa, 0xf, false);
    v += __builtin_amdgcn_update_dpp(0, v, 0x143, 0xc, 0xf, false);
    return __builtin_amdgcn_readlane(v, 63);
}
DI void tk_cnt_ge8(int& cl, const u32* u, u32 cand) {
    asm("v_cmp_le_u32_e32 vcc, %9, %1\n\tv_addc_co_u32_e32 %0, vcc, 0, %0, vcc\n\tv_cmp_le_u32_e32 vcc, %9, %2\n\tv_addc_co_u32_e32 %0, vcc, 0, %0, vcc\n\t"
        "v_cmp_le_u32_e32 vcc, %9, %3\n\tv_addc_co_u32_e32 %0, vcc, 0, %0, vcc\n\tv_cmp_le_u32_e32 vcc, %9, %4\n\tv_addc_co_u32_e32 %0, vcc, 0, %0, vcc\n\t"
        "v_cmp_le_u32_e32 vcc, %9, %5\n\tv_addc_co_u32_e32 %0, vcc, 0, %0, vcc\n\tv_cmp_le_u32_e32 vcc, %9, %6\n\tv_addc_co_u32_e32 %0, vcc, 0, %0, vcc\n\t"
        "v_cmp_le_u32_e32 vcc, %9, %7\n\tv_addc_co_u32_e32 %0, vcc, 0, %0, vcc\n\tv_cmp_le_u32_e32 vcc, %9, %8\n\tv_addc_co_u32_e32 %0, vcc, 0, %0, vcc"
        : "+v"(cl) : "v"(u[0]), "v"(u[1]), "v"(u[2]), "v"(u[3]), "v"(u[4]), "v"(u[5]), "v"(u[6]), "v"(u[7]), "s"(cand) : "vcc"); }
DI void tk_cnt_gt(int& cl, u32 u, u32 thr) { asm("v_cmp_lt_u32_e32 vcc, %2, %1\n\tv_addc_co_u32_e32 %0, vcc, 0, %0, vcc" : "+v"(cl) : "v"(u), "s"(thr) : "vcc"); }
template <int K, int NK> struct TopkMask {
    static DI void run(const u32 (&u)[NK], u32 Tv, int exact, int need, int& run_, int lane, u32& w0, u32& w1) {
        int pred;
        if (exact) pred = u[K] >= Tv ? 1 : 0;
        else { const bool gt = u[K] > Tv, eq = u[K] == Tv; const u64 beq = __ballot(eq);
               const int rank = run_ + __popcll(beq & ((1ull << lane) - 1ull)); run_ += __popcll(beq); pred = (gt || (eq && rank < need)) ? 1 : 0; }
        asm volatile("v_cmp_ne_u32_e32 vcc, 0, %2\n\ts_nop 4\n\tv_writelane_b32 %0, vcc_lo, %3\n\tv_writelane_b32 %1, vcc_hi, %3" : "+v"(w0), "+v"(w1) : "v"(pred), "n"(K) : "vcc");
        TopkMask<K + 1, NK>::run(u, Tv, exact, need, run_, lane, w0, w1);
    }
};
template <int NK> struct TopkMask<NK, NK> { static DI void run(const u32 (&)[NK], u32, int, int, int&, int, u32&, u32&) {} };
template <int NK> DI void topk_row(const float* srow, int n, u32* mrow, int lane) {
    u32 u[NK];
#pragma unroll
    for (int k = 0; k < NK; ++k) { const int i = 64 * k + lane; const float sv = srow[i] + 0.f;
        const u32 bts = __float_as_uint(sv); const u32 key = bts ^ ((u32)((int)bts >> 31) | 0x80000000u);
        u[k] = key & ~(u32)((n - 1 - i) >> 31); }
    u32 kmax = 0u;
#pragma unroll
    for (int k = 0; k < NK; ++k) kmax = kmax > u[k] ? kmax : u[k];
#pragma unroll
    for (int off = 32; off; off >>= 1) { const u32 t = (u32)__shfl_xor((int)kmax, off); kmax = kmax > t ? kmax : t; }
    u32 lo = 0u, hi = __builtin_amdgcn_readfirstlane(kmax) + 1u; int clo = n, chi = 0;
    u32 Tv = 0u; int exact = 0, it = 0;
#pragma unroll 1
    while (hi - lo > 1u) {
        u32 mid;
        if (it & 1) mid = lo + ((hi - lo) >> 1);
        else { const unsigned long long w = (unsigned long long)(hi - lo) * (unsigned)(clo - 256) / (unsigned)(clo - chi); mid = lo + (u32)w; }
        if (mid <= lo) mid = lo + 1u; if (mid >= hi) mid = hi - 1u;
        ++it;
        const u32 cand = __builtin_amdgcn_readfirstlane(mid); int cl = 0;
#pragma unroll
        for (int k = 0; k < NK; k += 8) tk_cnt_ge8(cl, u + k, cand);
        const int cnt = wave_total_i(cl);
        if (cnt == 256) { Tv = cand; exact = 1; break; }
        if (cnt > 256) { lo = cand; clo = cnt; } else { hi = cand; chi = cnt; }
    }
    if (!exact) Tv = lo;
    int need = 0x7fffffff, run = 0;
    if (!exact) { int cl = 0; const u32 thr = __builtin_amdgcn_readfirstlane(Tv);
#pragma unroll
        for (int k = 0; k < NK; ++k) tk_cnt_gt(cl, u[k], thr);
        need = 256 - wave_total_i(cl); }
    u32 w0 = 0u, w1 = 0u;
    TopkMask<0, NK>::run(u, Tv, exact, need, run, lane, w0, w1);
    uint2 w; w.x = lane < NK ? w0 : 0u; w.y = lane < NK ? w1 : 0u;
    *(uint2*)(mrow + 2 * lane) = w;
}
__global__ void __launch_bounds__(512, 2) mega(Params p) {
    extern __shared__ __attribute__((aligned(16))) unsigned char lds[];
    LAS unsigned char* llds = (LAS unsigned char*)lds;
    volatile LAS unsigned* xbw = (volatile LAS unsigned*)(lds + LDS_MISC);
    const int wid_s = __builtin_amdgcn_readfirstlane((int)(threadIdx.x >> 6));
    if (threadIdx.x == 0) {
        xbw[0] = 0u; xbw[1] = 0u; xbw[2] = 0u; xbw[3] = 0u;
        volatile LAS u64* pt = (volatile LAS u64*)(lds + LDS_MISC + 64);
        pt[0] = (u64)p.x; pt[1] = (u64)p.mem; pt[2] = (u64)p.pos; pt[3] = (u64)p.rel_bias; pt[4] = (u64)p.gains; pt[5] = (u64)p.w_in; pt[6] = (u64)p.qnorm; pt[7] = (u64)p.kvnorm;
        pt[8] = (u64)p.w_uq; pt[9] = (u64)p.w_ukv; pt[10] = (u64)p.cmp_pos; pt[11] = (u64)p.cmp_w1; pt[12] = (u64)p.cmp_w2; pt[13] = (u64)p.w_branch; pt[14] = (u64)p.w_out;
        pt[15] = (u64)p.cwq; pt[16] = (u64)p.cwkv; pt[17] = (u64)p.cwo; pt[18] = (u64)p.w1; pt[19] = (u64)p.w2; pt[20] = (u64)p.out; pt[21] = (u64)p.ws;
    }
    __syncthreads();
    XcdBarrier bar = xcd_barrier_post((unsigned*)(p.ws + WS_CTL) + 4096, xbw);
    using pg8::f32x4; using pg8::u32x4;
#define LP(T_, idx) ((T_)(GAS unsigned char*)ldp(lds, idx))
#define P_X LP(const float*, 0)
#define P_MEM LP(const float*, 1)
#define P_POS LP(const int*, 2)
#define P_RELB LP(const float*, 3)
#define P_GAINS LP(const float*, 4)
#define P_WIN LP(const float*, 5)
#define P_QNORM LP(const float*, 6)
#define P_KVNORM LP(const float*, 7)
#define P_WUQ LP(const float*, 8)
#define P_WUKV LP(const float*, 9)
#define P_CPOS LP(const float*, 10)
#define P_CW1 LP(const float*, 11)
#define P_CW2 LP(const float*, 12)
#define P_WBR LP(const float*, 13)
#define P_WOUT LP(const float*, 14)
#define P_CWQ LP(const float*, 15)
#define P_CWKV LP(const float*, 16)
#define P_CWO LP(const float*, 17)
#define P_W1 LP(const float*, 18)
#define P_W2 LP(const float*, 19)
#define P_OUT LP(float*, 20)
#define HB ((u16*)(ws + WS_HB))
#define MEMN ((u16*)(ws + WS_MEMN))
#define CKV ((u16*)(ws + WS_CKV))
#define MERGED ((u16*)(ws + WS_MERGED))
#define PROJ ((u16*)(ws + WS_PROJ))
#define GATES ((u16*)(ws + WS_GATES))
#define QNRM ((u16*)(ws + WS_QNRM))
#define KVNRM ((u16*)(ws + WS_KVNRM))
#define MQN ((u16*)(ws + WS_MQN))
#define MQR ((u16*)(ws + WS_MQR))
#define MKN ((u16*)(ws + WS_MKN))
#define MV ((u16*)(ws + WS_MV))
#define MKR ((u16*)(ws + WS_MKR))
#define CB ((u16*)(ws + WS_CBK))
#define CPART ((float*)(ws + WS_CPART))
#define KCMP ((u16*)(ws + WS_KCMP))
#define VCMP ((u16*)(ws + WS_VCMP))
#define BITM ((u32*)(ws + WS_BITM))
#define F32 ((float*)(ws + WS_F32))
#define CQ ((u16*)(ws + WS_CQ))
#define U ((u16*)(ws + WS_U))

    int ph = 0;
#define PH_BEGIN(kind) if (ph >= p.ph_lo && ph < p.ph_hi) { constexpr int nrep_ = PROBE_REP_H[kind]; for (int rep_ = 0; rep_ < nrep_; ++rep_) { const int tid = opaque_tid(wid_s), lane = tid & 63, wv = tid >> 6; float* wsl = (float*)(lds + wv * WSLOT); unsigned char* const ws = LP(unsigned char*, 21); (void)lane; (void)wsl; (void)ws;
#define PH_END   if (ph + 1 < p.ph_hi || rep_ + 1 < nrep_) xcd_barrier(bar); } } ++ph;

    for (int l = 0; l < DEPTH; ++l) {
#define GL (P_GAINS + (size_t)l * 7 * 1024)
#define XIN ((l == 0) ? P_X : (const float*)P_OUT)
        PH_BEGIN(0)
            {
                float* scr = (float*)(lds + wv * 16896);
                const int gw = blockIdx.x * 8 + wv, ngw = gridDim.x * 8;
                int it0 = 0;
                { const float* W = P_WIN + (size_t)l * 1024 * D_IN; u16* WT = (u16*)(ws + WT_IN);
                  it0 = pg8::conv_matrix(W, D_IN, 1024, 10240, [&](int n) { return n < PP ? proj_src(n) : 6944 + (n - PP); },
                                         [&](int n, int k) { return WT + (size_t)n * 1024 + k; }, scr, lane, gw, ngw, it0); }
                { const float* W = P_WUQ + (size_t)l * 384 * 1536; u16* WT = (u16*)(ws + WT_UQ);
                  it0 = pg8::conv_matrix(W, 1536, 384, 1536, [&](int n) { return n < 1024 ? (n >> 7) * 192 + (n & 127) : ((n - 1024) >> 6) * 192 + 128 + ((n - 1024) & 63); },
                                         [&](int n, int k) { return WT + (size_t)n * 384 + k; }, scr, lane, gw, ngw, it0); }
                { const float* W = P_WUKV + (size_t)l * 256 * 2048; u16* WT = (u16*)(ws + WT_UKV);
                  it0 = pg8::conv_matrix(W, 2048, 256, 2048, [&](int n) { return n; }, [&](int n, int k) { return WT + (size_t)n * 256 + k; }, scr, lane, gw, ngw, it0); }
                for (int kv = 0; kv < 2; ++kv) { const float* W = P_CW1 + ((size_t)l * 2 + kv) * 4096 * 256; u16* WT = (u16*)(ws + WT_C1);
                  it0 = pg8::conv_matrix(W, 256, 4096, 256, [&](int n) { return n; },
                                         [&](int n, int k) { return WT + ((size_t)((kv * 8 + (k >> 9)) * 256 + n)) * 512 + (k & 511); }, scr, lane, gw, ngw, it0); }
                for (int i = 0; i < 3; ++i) { const float* W = P_WBR + ((size_t)l * 3 + i) * 1024 * 1024; u16* WT = (u16*)(ws + WT_BR) + (size_t)i * 1024 * 1024;
                  it0 = pg8::conv_matrix(W, 1024, 1024, 1024, [&](int n) { return n; }, [&](int n, int k) { return WT + (size_t)n * 1024 + k; }, scr, lane, gw, ngw, it0); }
                { const float* W = P_WOUT + (size_t)l * 1024 * 1024; u16* WT = (u16*)(ws + WT_OUT);
                  it0 = pg8::conv_matrix(W, 1024, 1024, 1024, [&](int n) { return n; }, [&](int n, int k) { return WT + (size_t)n * 1024 + k; }, scr, lane, gw, ngw, it0); }
                { const float* W = P_CWKV + (size_t)l * 1024 * 2048; u16* WT = (u16*)(ws + WT_CKV);
                  it0 = pg8::conv_matrix(W, 2048, 1024, 2048, [&](int n) { return n; }, [&](int n, int k) { return WT + (size_t)n * 1024 + k; }, scr, lane, gw, ngw, it0); }
            }
            if (l == 0) ph_norm_rows(XIN, GL, HB, T, tid);
            ph_norm_rows(P_MEM, GL + 3 * 1024, MEMN, 1024, tid);
            if (l == 0) {
                float2* rt = (float2*)(ws + WS_ROPE); const int* posp = P_POS;
                for (int e = blockIdx.x * 512 + tid; e < T * 32; e += gridDim.x * 512) {
                    const float invf = powf(10000.f, -(float)(e & 31) * (1.f / 32.f));
                    float sn, cs; sincosf((float)posp[e >> 5] * invf, &sn, &cs);
                    rt[e] = make_float2(cs, sn);
                }
            }
        PH_END
        for (int b = 0; b < NB; ++b) {
            PH_BEGIN(1)
                {
                    pg8::Sched1 S; S.init(HB + (size_t)b * SEQ * 1024, 1024, ws + WT_IN, 1024, SEQ, PP, 0);
                    auto E = pg8::epi_b16([&](int row, int col, f32x4 v0, f32x4 v1) { *(u32x4*)(PROJ + (size_t)row * PP + col) = pg8::pack8(v0, v1); });
                    pg8::gemm_phase(llds, 1024, 1024, 1024, S, E, wid_s);
                }
                if (b == 0) {
                    pg8::Sched1 S; S.init(MEMN, 1024, ws + WT_CKV, 1024, 1024, 2048, 192);
                    auto E = pg8::epi_b16([&](int row, int col, f32x4 v0, f32x4 v1) { *(u32x4*)(CKV + (size_t)row * 2048 + col) = pg8::pack8(v0, v1); });
                    pg8::gemm_phase(llds, 1024, 1024, 1024, S, E, wid_s);
                }
            PH_END
            PH_BEGIN(2)
                {
                    const float* qg = P_QNORM + l * 384; const float* kg = P_KVNORM + l * 256;
                    for (int r = blockIdx.x * 8 + wv; r < SEQ; r += gridDim.x * 8) {
                        const u16* pr = PROJ + (size_t)r * PP;
                        float v[6]; float ss = 0.f;
#pragma unroll
                        for (int i = 0; i < 6; ++i) { v[i] = bf2f(pr[C_QLAT + lane + 64 * i]); ss += v[i] * v[i]; }
                        ss = wave_sum(ss); float rs = rsqrtf(ss * (1.f / 384.f) + EPS);
#pragma unroll
                        for (int i = 0; i < 6; ++i) QNRM[(size_t)r * 384 + lane + 64 * i] = (u16)f2bf(v[i] * rs * qg[lane + 64 * i]);
                        ss = 0.f;
#pragma unroll
                        for (int i = 0; i < 4; ++i) { v[i] = bf2f(pr[C_KVLAT + lane + 64 * i]); ss += v[i] * v[i]; }
                        ss = wave_sum(ss); rs = rsqrtf(ss * (1.f / 256.f) + EPS);
#pragma unroll
                        for (int i = 0; i < 4; ++i) KVNRM[(size_t)r * 256 + lane + 64 * i] = (u16)f2bf(v[i] * rs * kg[lane + 64 * i]);
                        if (lane < 32) {
                            const float2 csn = ((const float2*)(ws + WS_ROPE))[(size_t)(b * SEQ + r) * 32 + lane];
                            const float x1 = bf2f(pr[C_KROPE + lane]), x2 = bf2f(pr[C_KROPE + 32 + lane]);
                            MKR[(size_t)r * 64 + lane] = (u16)f2bf(x1 * csn.x - x2 * csn.y);
                            MKR[(size_t)r * 64 + 32 + lane] = (u16)f2bf(x2 * csn.x + x1 * csn.y);
                        }
                    }
                    const float* cpos = P_CPOS + (size_t)l * 2 * 32 * 128;
                    for (size_t e = (size_t)blockIdx.x * 512 + tid; e < (size_t)512 * 4096; e += (size_t)gridDim.x * 512) {
                        const int row = (int)(e >> 12), col = (int)(e & 4095), c = row >> 1, gg = row & 1, ll = col >> 7, d = col & 127;
                        float vk = 0.f, vv = 0.f;
                        if (row < 510) {
                            const u16* pr = PROJ + (size_t)(16 * c + ll) * PP + gg * 128 + d;
                            vk = bf2f(pr[C_NKC]) + cpos[ll * 128 + d];
                            vv = bf2f(pr[C_NVC]) + cpos[32 * 128 + ll * 128 + d];
                        }
                        const size_t de = ((size_t)(col >> 9) * 512 + row) * 512 + (col & 511);
                        CB[de] = (u16)f2bf(vk); CB[(size_t)8 * 512 * 512 + de] = (u16)f2bf(vv);
                    }
                }
            PH_END
            PH_BEGIN(3)
                {
                    pg8::Sched1 S; S.init(QNRM, 384, ws + WT_UQ, 384, SEQ, 1536, 0);
                    auto E = pg8::epi_b16([&](int row, int col, f32x4 v0, f32x4 v1) {
                        u16* d = col < 1024 ? MQN + (size_t)row * 1024 + col : MQR + (size_t)row * 512 + (col - 1024);
                        *(u32x4*)d = pg8::pack8(v0, v1); });
                    pg8::gemm_phase(llds, 384, 384, 384, S, E, wid_s);
                    pg8::Unit u0;
                    if (S.next(0, u0) && u0.pn >= 4) {
                        asm volatile("s_waitcnt vmcnt(0)" ::: "memory");
                        __syncthreads();
                        const float2* rt = (const float2*)(ws + WS_ROPE) + (size_t)(b * SEQ + 256 * u0.pm) * 32;
                        u16* qt = MQR + (size_t)(256 * u0.pm) * 512 + (u0.pn - 4) * 256;
#pragma unroll 2
                        for (int e = opaque_tid(wid_s); e < 256 * 16; e += 512) {
                            const int row = e >> 4, hh = (e >> 2) & 3, f0 = (e & 3) * 8;
                            u16* q = qt + (size_t)row * 512 + hh * 64 + f0;
                            const u32x4 a = *(const u32x4*)q, c2 = *(const u32x4*)(q + 32);
                            const f32x4* tp = (const f32x4*)(rt + row * 32 + f0);
                            u32x4 oa, oc;
#pragma unroll
                            for (int i = 0; i < 4; ++i) {
                                const f32x4 cs = tp[i];
                                const float x1a = bf2f(a[i] & 0xffffu), x1b = bf2f(a[i] >> 16), x2a = bf2f(c2[i] & 0xffffu), x2b = bf2f(c2[i] >> 16);
                                oa[i] = pg8::pk2(x1a * cs[0] - x2a * cs[1], x1b * cs[2] - x2b * cs[3]);
                                oc[i] = pg8::pk2(x2a * cs[0] + x1a * cs[1], x2b * cs[2] + x1b * cs[3]);
                            }
                            *(u32x4*)q = oa; *(u32x4*)(q + 32) = oc;
                        }
                    }
                }
                {
                    pg8::Sched1 S; S.init(KVNRM, 256, ws + WT_UKV, 256, SEQ, 2048, 96);
                    auto E = pg8::epi_b16([&](int row, int col, f32x4 v0, f32x4 v1) {
                        u16* d = ((col & 128) ? MV : MKN) + (size_t)row * 1024 + (col >> 8) * 128 + (col & 127);
                        *(u32x4*)d = pg8::pack8(v0, v1); });
                    pg8::gemm_phase(llds, 256, 256, 256, S, E, wid_s);
                }
                {
                    pg8::SchedCmp S; S.init(CB, ws + WT_C1, 224);
                    auto E = pg8::epi_f32([&](int row, int col, f32x4 v) { *(f32x4*)(CPART + (size_t)row * 256 + col) = v; });
                    pg8::gemm_phase(llds, 512, 512, 512, S, E, wid_s);
                }
                for (int c = blockIdx.x; c < 256; c += gridDim.x) {
                    { const int rb = 127 - (c >> 2); if (rb >= 8) idx_score_unit(lds, wid_s, rb, c & 3); }
                    { const int u2 = 511 - c, rb = 127 - (u2 >> 2); if (rb >= 8) idx_score_unit(lds, wid_s, rb, u2 & 3); }
                }
            PH_END
            PH_BEGIN(4)
                {
                    unsigned* qctr = (unsigned*)(ws + WS_CTL) + 16384 + 64 * (l * NB + b);
                    volatile LAS int* qslot = (volatile LAS int*)(lds + LDS_MISC + 16);
                    unsigned* cntb = (unsigned*)(ws + WS_CTL) + 65536 + 256 * (l * NB + b);
                    for (;;) {
                        __syncthreads();
                        if (opaque_tid(wid_s) == 0) *qslot = (int)atomicAdd(qctr, 1u);
                        __syncthreads();
                        const int item = __builtin_amdgcn_readfirstlane(*qslot);
                        if (item >= 512 + 64 + N_ATT4 + 192) break;
                        if (item < 512) {
                            const int rr = 8 * (511 - item) + wid_s, n = rr + 1;
                            const int lane2 = opaque_tid(0);
                            u32* mrow = BITM + (size_t)rr * 128;
                            if (n <= 256) {
                                for (int w = lane2; w < 128; w += 64) { const int lo = 32 * w; mrow[w] = (lo + 32 <= n) ? 0xffffffffu : (lo >= n ? 0u : ((1u << (n - lo)) - 1u)); }
                            } else {
                                const int rb = rr >> 5, width = 64 * ((rb >> 1) + 1);
                                const float* srow = (const float*)(ws + WS_SCORE) + score_off(rb) + (size_t)(rr & 31) * width;
                                if (n <= 512) topk_row<8>(srow, n, mrow, lane2);
                                else if (n <= 1024) topk_row<16>(srow, n, mrow, lane2);
                                else if (n <= 1536) topk_row<24>(srow, n, mrow, lane2);
                                else if (n <= 2048) topk_row<32>(srow, n, mrow, lane2);
                                else if (n <= 2560) topk_row<40>(srow, n, mrow, lane2);
                                else if (n <= 3072) topk_row<48>(srow, n, mrow, lane2);
                                else if (n <= 3584) topk_row<56>(srow, n, mrow, lane2);
                                else topk_row<64>(srow, n, mrow, lane2);
                            }
                        } else if (item < 576) {
                            {
                                const int it32 = item - 512, kv = it32 >> 5, r0 = (it32 & 31) * 32;
                                const int tid2 = opaque_tid(wid_s), lane2 = tid2 & 63;
                                const float* W2 = P_CW2 + ((size_t)l * 2 + kv) * 256 * 128;
                                float* w2s = (float*)lds;
#pragma unroll 4
                                for (int i = 0; i < 16; ++i) ((f32x4*)w2s)[tid2 + 512 * i] = ((const f32x4*)W2)[tid2 + 512 * i];
                                float* hid = (float*)(lds + 131072 + wid_s * 1024);
                                __syncthreads();
#pragma unroll 1
                                for (int rr4 = 0; rr4 < 4; ++rr4) {
                                    const int row = r0 + wid_s * 4 + rr4;
                                    u16* dst = (kv ? VCMP : KCMP) + (size_t)row * 128;
                                    if (row >= 510) { *(u32*)(dst + lane2 * 2) = 0u; continue; }
                                    float h4[4] = {0.f, 0.f, 0.f, 0.f};
#pragma unroll
                                    for (int ch = 0; ch < 8; ++ch) { const f32x4 pv = *(const f32x4*)(CPART + ((size_t)(kv * 8 + ch) * 512 + row) * 256 + lane2 * 4);
                                        h4[0] += pv[0]; h4[1] += pv[1]; h4[2] += pv[2]; h4[3] += pv[3]; }
#pragma unroll
                                    for (int j = 0; j < 4; ++j) hid[lane2 * 4 + j] = gelu_tanh(h4[j]);
                                    float o0 = 0.f, o1 = 0.f;
#pragma unroll 8
                                    for (int j = 0; j < 256; ++j) { const float hj = hid[j]; o0 = fmaf(hj, w2s[j * 128 + lane2], o0); o1 = fmaf(hj, w2s[j * 128 + 64 + lane2], o1); }
                                    dst[lane2] = (u16)f2bf(o0); dst[64 + lane2] = (u16)f2bf(o1);
                                }
                            }
                        } else if (item < 576 + N_ATT4) {
                            const int code = ATT4_ITEMS[item - 576], xx = (code >> 4) & 63, yy = code & 15;
                            mla_unit(lds, wid_s, yy & 7, xx, xx >= SPLIT_QB ? (yy >> 3) : -1, cntb);
                        } else {
                            const int uu = item - 576 - N_ATT4, pm = uu / 12, pn = uu % 12;
                            pg8::SchedOne S{(const char*)(HB + ((size_t)b * SEQ + 256 * pm) * 1024), (const char*)(ws + WT_IN) + (size_t)(PP + 256 * pn) * 1024 * 2, pm, pn};
                            auto E = pg8::epi_b16([&](int row, int col, f32x4 v0, f32x4 v1) {
                                f32x4 a, c2;
#pragma unroll
                                for (int j = 0; j < 4; ++j) { a[j] = sigmoidf_(v0[j]); c2[j] = sigmoidf_(v1[j]); }
                                *(u32x4*)(GATES + (size_t)row * 3072 + col) = pg8::pack8(a, c2); });
                            pg8::gemm_phase(llds, 1024, 1024, 1024, S, E, wid_s);
                        }
                    }
                    __syncthreads();
                }
            PH_END
            PH_BEGIN(5)
                {
                    float* sc = wsl;
                    float* qs = wsl + 4096;
                    {
                        unsigned* qctr = (unsigned*)(ws + WS_CTL) + 16384 + 64 * (8 + l * NB + b);
                        volatile LAS int* qslot = (volatile LAS int*)(lds + LDS_MISC + 16);
                        for (;;) {
                            __syncthreads();
                            if (opaque_tid(wid_s) == 0) *qslot = (int)atomicAdd(qctr, 1u);
                            __syncthreads();
                            const int item = __builtin_amdgcn_readfirstlane(*qslot);
                            if (item >= N_ATT5) break;
                            const int code = ATT5_ITEMS[item], ty = code >> 10, xx = (code >> 4) & 63, yy = code & 15;
                            unsigned* cntb = (unsigned*)(ws + WS_CTL) + 65536 + 256 * (l * NB + b);
                            if (ty == 1) dsa_unit(lds, wid_s, yy & 7, xx, xx >= SPLIT_QB ? (yy >> 3) : -1, cntb);
                            else nsa_unit(lds, wid_s, yy & 1, xx, xx >= SPLIT_N ? ((yy >> 1) & 1) : -1, cntb, (unsigned*)(ws + WS_CTL) + 72000 + 64 * (l * NB + b));
                        }
                        __syncthreads();
                    }
                }
            PH_END
            PH_BEGIN(6)
                for (int i = 0; i < 3; ++i) {
                    const u16* A = i == 0 ? MQN : (i == 1 ? PROJ + C_DSAQ : PROJ + C_NSAO);
                    const int lda = i == 0 ? 1024 : PP;
                    pg8::Sched1 S; S.init(A, lda, ws + WT_BR + (size_t)i * 2 * MiB, 1024, SEQ, 1024, 64 * i);
                    auto E = pg8::epi_b16([&](int row, int col, f32x4 v0, f32x4 v1) {
                        u16* gp = GATES + (size_t)row * 3072 + i * 1024 + col; const u32x4 gq = *(const u32x4*)gp;
                        const f32x4 a = {bf2f(gq.x & 0xffffu), bf2f(gq.x >> 16), bf2f(gq.y & 0xffffu), bf2f(gq.y >> 16)};
                        const f32x4 c2 = {bf2f(gq.z & 0xffffu), bf2f(gq.z >> 16), bf2f(gq.w & 0xffffu), bf2f(gq.w >> 16)};
                        *(u32x4*)gp = pg8::pack8(a * v0, c2 * v1); });
                    pg8::gemm_phase(llds, 1024, lda, 1024, S, E, wid_s);
                }
            PH_END
            PH_BEGIN(7)
                for (size_t e = (size_t)blockIdx.x * 512 + tid; e < (size_t)SEQ * 128; e += (size_t)gridDim.x * 512) {
                    const size_t m = e >> 7, n = (e & 127) * 8; const u16* gp = GATES + m * 3072 + n;
                    const u32x4 a = *(const u32x4*)gp, b2 = *(const u32x4*)(gp + 1024), c = *(const u32x4*)(gp + 2048);
                    u32x4 o4;
#pragma unroll
                    for (int i = 0; i < 4; ++i) o4[i] = pg8_pk2(bf2f(a[i] & 0xffffu) + bf2f(b2[i] & 0xffffu) + bf2f(c[i] & 0xffffu), bf2f(a[i] >> 16) + bf2f(b2[i] >> 16) + bf2f(c[i] >> 16));
                    *(u32x4*)(MERGED + ((size_t)b * SEQ + m) * 1024 + n) = o4;
                }
            PH_END
        }
        PH_BEGIN(8)
            { pg8::Sched1 S; S.init(MERGED, 1024, ws + WT_OUT, 1024, T, 1024, 0);
              auto E = pg8::epi_f32([&](int row, int col, f32x4 v) { *(f32x4*)(F32 + (size_t)row * 1024 + col) = v; });
              pg8::gemm_phase(llds, 1024, 1024, 1024, S, E, wid_s); }
        PH_END
        PH_BEGIN(9)
            {
                float* scr = (float*)(lds + wv * 16896);
                const int gw = blockIdx.x * 8 + wv, ngw = gridDim.x * 8;
                int it0 = 0;
                { const float* W = P_CWQ + (size_t)l * 1024 * 1024; u16* WT = (u16*)(ws + WT_CQ);
                  it0 = pg8::conv_matrix(W, 1024, 1024, 1024, [&](int n) { return n; }, [&](int n, int k) { return WT + (size_t)n * 1024 + k; }, scr, lane, gw, ngw, it0); }
                { const float* W = P_CWO + (size_t)l * 1024 * 1024; u16* WT = (u16*)(ws + WT_CO);
                  it0 = pg8::conv_matrix(W, 1024, 1024, 1024, [&](int n) { return n; }, [&](int n, int k) { return WT + (size_t)n * 1024 + k; }, scr, lane, gw, ngw, it0); }
                { const float* W = P_W1 + (size_t)l * 1024 * 4096; u16* WT = (u16*)(ws + WT_W1);
                  it0 = pg8::conv_matrix(W, 4096, 1024, 4096, [&](int n) { return n; }, [&](int n, int k) { return WT + (size_t)n * 1024 + k; }, scr, lane, gw, ngw, it0); }
                { const float* W = P_W2 + (size_t)l * 4096 * 1024; u16* WT = (u16*)(ws + WT_W2);
                  it0 = pg8::conv_matrix(W, 1024, 4096, 1024, [&](int n) { return n; }, [&](int n, int k) { return WT + (size_t)n * 4096 + k; }, scr, lane, gw, ngw, it0); }
            }
            ph_resid_norm(F32, GL + 1 * 1024, XIN, P_OUT, GL + 2 * 1024, HB, T, tid);
        PH_END
        PH_BEGIN(10)
            { pg8::Sched1 S; S.init(HB, 1024, ws + WT_CQ, 1024, T, 1024, 0);
              auto E = pg8::epi_b16([&](int row, int col, f32x4 v0, f32x4 v1) { *(u32x4*)(CQ + (size_t)row * 1024 + col) = pg8::pack8(v0, v1); });
              pg8::gemm_phase(llds, 1024, 1024, 1024, S, E, wid_s); }
        PH_END
        PH_BEGIN(11)
            for (int u = blockIdx.x; u < NB * 4 * 16; u += gridDim.x) cross_unit(lds, wid_s, u >> 6, (u >> 4) & 3, u & 15);
        PH_END
        PH_BEGIN(12)
            { pg8::Sched1 S; S.init(CQ, 1024, ws + WT_CO, 1024, T, 1024, 0);
              auto E = pg8::epi_f32([&](int row, int col, f32x4 v) { *(f32x4*)(F32 + (size_t)row * 1024 + col) = v; });
              pg8::gemm_phase(llds, 1024, 1024, 1024, S, E, wid_s); }
        PH_END
        PH_BEGIN(13)
            ph_resid_norm(F32, GL + 4 * 1024, P_OUT, P_OUT, GL + 5 * 1024, HB, T, tid);
        PH_END
        PH_BEGIN(14)
            { pg8::Sched1 S; S.init(HB, 1024, ws + WT_W1, 1024, T, 4096, 0);
              auto E = pg8::epi_b16([&](int row, int col, f32x4 v0, f32x4 v1) {
                  f32x4 a, c2;
#pragma unroll
                  for (int j = 0; j < 4; ++j) { const float r0 = fmaxf(v0[j], 0.f), r1 = fmaxf(v1[j], 0.f); a[j] = r0 * r0; c2[j] = r1 * r1; }
                  *(u32x4*)(U + (size_t)row * 4096 + col) = pg8::pack8(a, c2); });
              pg8::gemm_phase(llds, 1024, 1024, 1024, S, E, wid_s); }
        PH_END
        PH_BEGIN(15)
            { pg8::Sched1 S; S.init(U, 4096, ws + WT_W2, 4096, T, 1024, 0);
              auto E = pg8::epi_f32([&](int row, int col, f32x4 v) { *(f32x4*)(F32 + (size_t)row * 1024 + col) = v; });
              pg8::gemm_phase(llds, 4096, 4096, 4096, S, E, wid_s); }
        PH_END
        PH_BEGIN(16)
            ph_resid_norm(F32, GL + 6 * 1024, P_OUT, P_OUT, (l + 1 < DEPTH) ? P_GAINS + (size_t)(l + 1) * 7 * 1024 : (const float*)nullptr, HB, T, tid);
        PH_END
    }
}

constexpr int NPHASES = DEPTH * (1 + NB * 7 + 9);

extern "C" void kernel_launch(void* const* d_in, const int* in_sizes, int n_in, void* d_out, int out_size, void* d_ws, size_t ws_size,
                              hipStream_t stream) {
    (void)in_sizes; (void)out_size;
    if (n_in != 20 || ws_size < WS_END) { fprintf(stderr, "kernel_launch: bad n_in %d or ws_size %zu < %zu\n", n_in, ws_size, (size_t)WS_END); return; }
    static int grid = 0;
    if (!grid) {
        hipError_t e = hipFuncSetAttribute((const void*)mega, hipFuncAttributeMaxDynamicSharedMemorySize, LDS_BYTES);
        if (e != hipSuccess) fprintf(stderr, "hipFuncSetAttribute: %s\n", hipGetErrorString(e));
        int dev = 0, cus = 0, per_cu = 0;
        (void)hipGetDevice(&dev);
        (void)hipDeviceGetAttribute(&cus, hipDeviceAttributeMultiprocessorCount, dev);
        (void)hipOccupancyMaxActiveBlocksPerMultiprocessor(&per_cu, mega, 512, LDS_BYTES);
        if (cus <= 0) cus = 256;
        if (per_cu < 1) { fprintf(stderr, "occupancy query says %d blocks per CU\n", per_cu); per_cu = 1; }
        grid = cus;
    }
    (void)hipMemsetAsync((unsigned char*)d_ws + WS_CTL, 0, CTL_BYTES, stream);
    Params p; memset(&p, 0, sizeof(p));
    p.x = (const float*)d_in[0]; p.mem = (const float*)d_in[1]; p.pos = (const int*)d_in[2]; p.rel_bias = (const float*)d_in[3];
    p.gains = (const float*)d_in[4]; p.w_in = (const float*)d_in[5]; p.qnorm = (const float*)d_in[6]; p.kvnorm = (const float*)d_in[7];
    p.w_uq = (const float*)d_in[8]; p.w_ukv = (const float*)d_in[9]; p.cmp_pos = (const float*)d_in[10]; p.cmp_w1 = (const float*)d_in[11];
    p.cmp_w2 = (const float*)d_in[12]; p.w_branch = (const float*)d_in[13]; p.w_out = (const float*)d_in[14]; p.cwq = (const float*)d_in[15];
    p.cwkv = (const float*)d_in[16]; p.cwo = (const float*)d_in[17]; p.w1 = (const float*)d_in[18]; p.w2 = (const float*)d_in[19];
    p.out = (float*)d_out; p.ws = (unsigned char*)d_ws;
#if MK_MULTI_LAUNCH
    for (int ph = 0; ph < NPHASES; ++ph) { p.ph_lo = ph; p.ph_hi = ph + 1; hipLaunchKernelGGL(mega, dim3(grid), dim3(512), LDS_BYTES, stream, p); }
#else
    p.ph_lo = 0; p.ph_hi = NPHASES;
    hipLaunchKernelGGL(mega, dim3(grid), dim3(512), LDS_BYTES, stream, p);
#endif
}
```

```cpp
#include <hip/hip_runtime.h>
#include <cstdio>
#include <cstdint>
#include <cstring>

#ifndef MK_MULTI_LAUNCH
#define MK_MULTI_LAUNCH 0
#endif

typedef unsigned short u16;
typedef unsigned int u32;
typedef unsigned long long u64;
#define DI __device__ __forceinline__
#define LAS __attribute__((address_space(3)))
#define GAS __attribute__((address_space(1)))

constexpr int T = 16384, SEQ = 4096, NB = 4, DM = 1024, DEPTH = 2, D_IN = 10016;
constexpr int PP = 7168;
constexpr int C_QLAT = 0, C_KVLAT = 384, C_KROPE = 640, C_IDXK = 704, C_IDXQ = 768, C_DSAQ = 1280, C_DSAK = 2304, C_DSAV = 3328,
              C_NSAQ = 4352, C_NKC = 5376, C_NVC = 5632, C_NKS = 5888, C_NVS = 6144, C_NKW = 6400, C_NVW = 6656, C_IDXW = 6912,
              C_NGATE = 6920, C_END = 6944, C_NSAO = 0;
constexpr float EPS = 1e-6f;

constexpr size_t MiB = 1u << 20;
constexpr size_t WS_CTL = 0, CTL_BYTES = 1 * MiB;
constexpr size_t WS_WB = 1 * MiB;
constexpr size_t WT_IN = WS_WB, WT_UQ = WS_WB + 20 * MiB, WT_UKV = WS_WB + 21 * MiB + 256 * 1024, WT_C1 = WS_WB + 22 * MiB + 256 * 1024,
                 WT_BR = WS_WB + 26 * MiB + 256 * 1024, WT_OUT = WS_WB + 32 * MiB + 256 * 1024, WT_CKV = WS_WB + 34 * MiB + 256 * 1024;
constexpr size_t WT_CQ = WS_WB, WT_CO = WS_WB + 2 * MiB, WT_W1 = WS_WB + 4 * MiB, WT_W2 = WS_WB + 12 * MiB;
constexpr size_t WS_HB = 41 * MiB;
constexpr size_t WS_MEMN = 73 * MiB;
constexpr size_t WS_CKV = 75 * MiB;
constexpr size_t WS_ROPE = 79 * MiB;
constexpr size_t WS_A = 83 * MiB;
constexpr size_t WS_MERGED = WS_A;
constexpr size_t WS_PROJ = WS_A + 32 * MiB;
constexpr size_t WS_GATES = WS_A + 88 * MiB;
constexpr size_t WS_QNRM = WS_A + 112 * MiB;
constexpr size_t WS_KVNRM = WS_A + 115 * MiB;
constexpr size_t WS_MQN = WS_A + 117 * MiB;
constexpr size_t WS_MQR = WS_A + 125 * MiB;
constexpr size_t WS_MKN = WS_A + 129 * MiB;
constexpr size_t WS_MV = WS_A + 137 * MiB;
constexpr size_t WS_MKR = WS_A + 145 * MiB;
constexpr size_t WS_CBK = WS_A + 146 * MiB;
constexpr size_t WS_CH = WS_A + 154 * MiB;
constexpr size_t WS_KCMP = WS_A + 155 * MiB;
constexpr size_t WS_VCMP = WS_A + 155 * MiB + 512 * 1024;
constexpr size_t WS_BITM = WS_A + 156 * MiB;
constexpr size_t WS_CPART = WS_A + 158 * MiB;
constexpr size_t WS_SCORE = WS_A + 166 * MiB;
constexpr size_t WS_PART = WS_A + 200 * MiB;
constexpr size_t PART_BYTES = 65536 + 2048;
constexpr size_t WS_SELX = WS_PART + (size_t)192 * 2 * PART_BYTES;
constexpr size_t WS_F32 = WS_A + 32 * MiB;
constexpr size_t WS_CQ = WS_A + 96 * MiB;
constexpr size_t WS_U = WS_A + 96 * MiB;
constexpr size_t WS_END = WS_A + 226 * MiB;

constexpr int PROBE_REP_H[17] = {1, 1, 1, 1, 1, 1, 1, 1, 1, 1, 1, 1, 1, 1, 1, 1, 1};
constexpr int LDS_BYTES = 152 * 1024;
constexpr int LDS_MISC = 147456;
constexpr int WSLOT = 18432;

DI float bf2f(u32 h) { return __uint_as_float(h << 16); }
DI u32 f2bf(float f) { u32 u = __float_as_uint(f); return (u + 0x7fffu + ((u >> 16) & 1u)) >> 16; }
typedef float f32x2_g __attribute__((ext_vector_type(2)));
typedef __bf16 bf16x2_g __attribute__((ext_vector_type(2)));
DI u32 pg8_pk2(float lo, float hi) { f32x2_g v = {lo, hi}; bf16x2_g b = __builtin_convertvector(v, bf16x2_g); return __builtin_bit_cast(u32, b); }
DI float wave_sum(float v) { for (int o = 32; o; o >>= 1) v += __shfl_xor(v, o); return v; }
DI float wave_max(float v) { for (int o = 32; o; o >>= 1) v = fmaxf(v, __shfl_xor(v, o)); return v; }
DI float sigmoidf_(float x) { return 1.f / (1.f + __expf(-x)); }
DI float gelu_tanh(float x) { return 0.5f * x * (1.f + tanhf(0.7978845608028654f * (x + 0.044715f * x * x * x))); }

__device__ const unsigned char BUCKET_TAB[128] = {
    0, 1, 2, 3, 4, 5, 6, 7, 8, 9, 10, 11, 12, 13, 14, 15, 16, 16, 16, 17, 17, 18, 18, 18, 19, 19, 19, 20, 20, 20, 20, 21, 21, 21, 21, 22, 22, 22, 22, 22,
    23, 23, 23, 23, 23, 23, 24, 24, 24, 24, 24, 24, 25, 25, 25, 25, 25, 25, 25, 26, 26, 26, 26, 26, 26, 26, 26, 27, 27, 27, 27, 27, 27, 27, 27, 27, 27,
    28, 28, 28, 28, 28, 28, 28, 28, 28, 28, 29, 29, 29, 29, 29, 29, 29, 29, 29, 29, 29, 29, 30, 30, 30, 30, 30, 30, 30, 30, 30, 30, 30, 30, 30, 30,
    31, 31, 31, 31, 31, 31, 31, 31, 31, 31, 31, 31, 31, 31, 31};
DI int relbucket(int n) { return n >= 127 ? 31 : (int)BUCKET_TAB[n < 0 ? 0 : n]; }

DI int proj_src(int n) {
    if (n < 704) return n;
    if (n < 768) return 4288 + (n - 704);
    if (n < 1280) return 3776 + (n - 768);
    if (n < 4352) return 704 + (n - 1280);
    if (n < 5376) return 4360 + (n - 4352);
    if (n < 6912) return 5384 + (n - 5376);
    if (n < 6920) return 4352 + (n - 6912);
    if (n < 6944) return 6920 + (n - 6920);
    return -1;
}

#define XB_TMO      128
#define XB_XCNT(j)  (256  + 64 * (j))
#define XB_XSUB(j)  (1280 + 64 * (j))
#define XB_XGEN(j)  (2304 + 64 * (j))
#define XB_TOP      3328
#define XB_TOPGEN   3392
#define XCD_BAR_WORDS 3456
#define XB_SPIN_CAP (1u << 21)
DI unsigned xb_ld(unsigned* p)              { return __hip_atomic_load(p, __ATOMIC_RELAXED, __HIP_MEMORY_SCOPE_AGENT); }
DI unsigned xb_add(unsigned* p, unsigned v) { return __hip_atomic_fetch_add(p, v, __ATOMIC_RELAXED, __HIP_MEMORY_SCOPE_AGENT); }
DI unsigned xb_xcc_id() { return (unsigned)__builtin_amdgcn_s_getreg((3 << 11) | 20) & 0xFu; }
#define XB_SPIN(cond, bar) do { unsigned _sp = 0; while (cond) { __builtin_amdgcn_s_sleep(1); \
    if ((++_sp & 255u) == 0u) { if (xb_ld(&(bar)[XB_TMO])) break; if (_sp > XB_SPIN_CAP) { atomicAdd(&(bar)[XB_TMO], 1u); break; } } } } while (0)
struct XcdBarrier { unsigned* bar; unsigned x; volatile LAS unsigned* st; };
DI XcdBarrier xcd_barrier_post(unsigned* bar, volatile LAS unsigned* st) {
    XcdBarrier b; b.bar = bar; b.x = xb_xcc_id(); b.st = st;
    if (threadIdx.x == 0) (void)xb_add(&bar[XB_XCNT(b.x)], 1u);
    return b;
}
DI void xcd_barrier_complete(unsigned* bar, unsigned x, unsigned& nloc, unsigned& nx) {
    const unsigned G = gridDim.x * gridDim.y * gridDim.z;
    unsigned sum, cnt, mine, sp = 0u;
    for (;;) {
        sum = 0u; cnt = 0u; mine = 0u;
#pragma unroll
        for (unsigned j = 0; j < 16; ++j) { const unsigned c = xb_ld(&bar[XB_XCNT(j)]); sum += c; cnt += (c > 0u) ? 1u : 0u; mine = (j == x) ? c : mine; }
        if (sum == G) break;
        __builtin_amdgcn_s_sleep(1);
        if ((++sp & 255u) == 0u) { if (xb_ld(&bar[XB_TMO])) break; if (sp > XB_SPIN_CAP) { atomicAdd(&bar[XB_TMO], 1u); break; } }
    }
    nloc = mine > 0u ? mine : 1u; nx = cnt > 0u ? cnt : 1u;
}
DI void xcd_barrier(const XcdBarrier& b) {
    asm volatile("s_waitcnt vmcnt(0)" ::: "memory");
    __syncthreads();
    if (threadIdx.x == 0) {
        unsigned* bar = b.bar;
        __builtin_amdgcn_s_waitcnt(0);
        unsigned nloc = b.st[0], nx = b.st[1];
        if (nloc == 0u) { xcd_barrier_complete(bar, b.x, nloc, nx); b.st[0] = nloc; b.st[1] = nx; }
        const unsigned old = xb_add(&bar[XB_XSUB(b.x)], 1u);
        const unsigned gen = old / nloc;
        if (old + 1u == (gen + 1u) * nloc) {
            __builtin_amdgcn_fence(__ATOMIC_RELEASE, "agent");
            asm volatile("s_waitcnt vmcnt(0)" ::: "memory");
            const unsigned og = xb_add(&bar[XB_TOP], 1u);
            const unsigned tg = og / nx;
            if (og + 1u == (tg + 1u) * nx) xb_add(&bar[XB_TOPGEN], 1u);
            else XB_SPIN(xb_ld(&bar[XB_TOPGEN]) == tg, bar);
            __builtin_amdgcn_fence(__ATOMIC_ACQUIRE, "agent");
            xb_add(&bar[XB_XGEN(b.x)], 1u);
            asm volatile("s_waitcnt vmcnt(0)" ::: "memory");
        } else {
            XB_SPIN(xb_ld(&bar[XB_XGEN(b.x)]) == gen, bar);
            __builtin_amdgcn_fence(__ATOMIC_ACQUIRE, "agent");
            asm volatile("s_waitcnt vmcnt(0)" ::: "memory");
        }
    }
    __syncthreads();
}

struct Params {
    const float* x; const float* mem; const int* pos; const float* rel_bias; const float* gains; const float* w_in;
    const float* qnorm; const float* kvnorm; const float* w_uq; const float* w_ukv; const float* cmp_pos; const float* cmp_w1;
    const float* cmp_w2; const float* w_branch; const float* w_out; const float* cwq; const float* cwkv; const float* cwo;
    const float* w1; const float* w2;
    float* out; unsigned char* ws;
    int ph_lo, ph_hi;
};

DI u64 ldp(unsigned char* lds, int idx) {
    volatile LAS u32* t = (volatile LAS u32*)(lds + LDS_MISC + 64);
    const u32 lo = __builtin_amdgcn_readfirstlane(t[2 * idx]), hi = __builtin_amdgcn_readfirstlane(t[2 * idx + 1]);
    return ((u64)hi << 32) | lo;
}
DI int opaque_tid(int wid_s) { int t; asm volatile("v_mbcnt_lo_u32_b32 %0, -1, 0\n\tv_mbcnt_hi_u32_b32 %0, -1, %0" : "=v"(t)); return (wid_s << 6) | t; }
template <class BF, class EF>
DI void ngemm(unsigned char* lds, const u16* A, int lda, int M, int N, int K, BF bfn, EF efn, int tid) {
    float* As = (float*)lds;
    float* Bs = As + 16 * 132;
    const int tx = tid & 31, ty = tid >> 5;
    const int ntn = N / 128, ntiles = (M / 128) * ntn;
    for (int tile = blockIdx.x; tile < ntiles; tile += gridDim.x) {
        const int m0 = (tile / ntn) * 128, n0 = (tile % ntn) * 128;
        float acc[8][4];
#pragma unroll
        for (int i = 0; i < 8; ++i)
#pragma unroll
            for (int j = 0; j < 4; ++j) acc[i][j] = 0.f;
        for (int k0 = 0; k0 < K; k0 += 16) {
            {
                const int i = tid >> 2, kq = (tid & 3) * 4;
                const uint2 v = *(const uint2*)(A + (size_t)(m0 + i) * lda + k0 + kq);
                As[(kq + 0) * 132 + i] = bf2f(v.x & 0xffffu); As[(kq + 1) * 132 + i] = bf2f(v.x >> 16);
                As[(kq + 2) * 132 + i] = bf2f(v.y & 0xffffu); As[(kq + 3) * 132 + i] = bf2f(v.y >> 16);
                const int kk = tid >> 5, nq = (tid & 31) * 4;
#pragma unroll
                for (int j = 0; j < 4; ++j) Bs[kk * 132 + nq + j] = bfn(k0 + kk, n0 + nq + j);
            }
            __syncthreads();
#pragma unroll 2
            for (int kk = 0; kk < 16; ++kk) {
                float a[8], b[4];
#pragma unroll
                for (int i = 0; i < 8; ++i) a[i] = As[kk * 132 + ty * 8 + i];
#pragma unroll
                for (int j = 0; j < 4; ++j) b[j] = Bs[kk * 132 + tx * 4 + j];
#pragma unroll
                for (int i = 0; i < 8; ++i)
#pragma unroll
                    for (int j = 0; j < 4; ++j) acc[i][j] = fmaf(a[i], b[j], acc[i][j]);
            }
            __syncthreads();
        }
#pragma unroll
        for (int i = 0; i < 8; ++i)
#pragma unroll
            for (int j = 0; j < 4; ++j) efn(m0 + ty * 8 + i, n0 + tx * 4 + j, acc[i][j]);
    }
}

DI void ph_norm_rows(const float* src, const float* g, u16* dst, int rows, int tid) {
    typedef float f4 __attribute__((ext_vector_type(4)));
    const int lane = tid & 63, wv = tid >> 6;
    for (int r = blockIdx.x * 8 + wv; r < rows; r += gridDim.x * 8) {
        const f4* s = (const f4*)(src + (size_t)r * 1024) + lane;
        f4 v[4]; float ss = 0.f;
#pragma unroll
        for (int i = 0; i < 4; ++i) { v[i] = s[64 * i]; ss += (v[i][0] * v[i][0] + v[i][1] * v[i][1]) + (v[i][2] * v[i][2] + v[i][3] * v[i][3]); }
        ss = wave_sum(ss);
        const float rs = rsqrtf(ss * (1.f / 1024.f) + EPS);
        uint2* d = (uint2*)(dst + (size_t)r * 1024) + lane;
#pragma unroll
        for (int i = 0; i < 4; ++i) { const f4 gg = ((const f4*)g)[lane + 64 * i]; uint2 w; w.x = pg8_pk2(v[i][0] * rs * gg[0], v[i][1] * rs * gg[1]); w.y = pg8_pk2(v[i][2] * rs * gg[2], v[i][3] * rs * gg[3]); d[64 * i] = w; }
    }
}
DI void h7_sum(const u16* gates, u16* merged, int tid) {
    typedef unsigned u4 __attribute__((ext_vector_type(4)));
    const int e0 = blockIdx.x * 512 + tid, st = gridDim.x * 512;
    for (int eb = e0; eb < SEQ * 128; eb += 4 * st) {
        u4 a[4], b2[4], c[4];
#pragma unroll
        for (int u = 0; u < 4; ++u) { const int e = eb + u * st; const int ee = e < SEQ * 128 ? e : eb; const u16* gp = gates + (size_t)(ee >> 7) * 3072 + (ee & 127) * 8;
            a[u] = *(const u4*)gp; b2[u] = *(const u4*)(gp + 1024); c[u] = *(const u4*)(gp + 2048); }
#pragma unroll
        for (int u = 0; u < 4; ++u) { const int e = eb + u * st; if (e >= SEQ * 128) break;
            u4 o4;
#pragma unroll
            for (int i = 0; i < 4; ++i) o4[i] = pg8_pk2(bf2f(a[u][i] & 0xffffu) + bf2f(b2[u][i] & 0xffffu) + bf2f(c[u][i] & 0xffffu), bf2f(a[u][i] >> 16) + bf2f(b2[u][i] >> 16) + bf2f(c[u][i] >> 16));
            *(u4*)(merged + (size_t)(e >> 7) * 1024 + (e & 127) * 8) = o4; }
    }
}
DI void ph_resid_norm(const float* f_, const float* gpost, const float* xin, float* xout, const float* gnext, u16* hb, int rows, int tid) {
    typedef float f4 __attribute__((ext_vector_type(4)));
    const u16* f = (const u16*)f_;
    const int lane = tid & 63, wv = tid >> 6;
    const int stride = gridDim.x * 8;
    int r = blockIdx.x * 8 + wv;
    if (r >= rows) return;
    f4 gp[4], gn[4];
#pragma unroll
    for (int i = 0; i < 4; ++i) { gp[i] = ((const f4*)gpost)[lane + 64 * i]; gn[i] = gnext ? ((const f4*)gnext)[lane + 64 * i] : (f4){0.f, 0.f, 0.f, 0.f}; }
    uint2 wn[4]; f4 xn[4];
#pragma unroll
    for (int i = 0; i < 4; ++i) { wn[i] = ((const uint2*)(f + (size_t)r * 1024) + lane)[64 * i]; xn[i] = ((const f4*)(xin + (size_t)r * 1024) + lane)[64 * i]; }
    for (; r < rows; r += stride) {
        f4 v[4], x[4]; float ss = 0.f;
#pragma unroll
        for (int i = 0; i < 4; ++i) { const uint2 w = wn[i]; v[i][0] = __uint_as_float(w.x << 16); v[i][1] = __uint_as_float(w.x & 0xffff0000u); v[i][2] = __uint_as_float(w.y << 16); v[i][3] = __uint_as_float(w.y & 0xffff0000u);
            x[i] = xn[i]; }
        const int r2 = r + stride;
        if (r2 < rows) {
#pragma unroll
            for (int i = 0; i < 4; ++i) { wn[i] = ((const uint2*)(f + (size_t)r2 * 1024) + lane)[64 * i]; xn[i] = ((const f4*)(xin + (size_t)r2 * 1024) + lane)[64 * i]; }
        }
#pragma unroll
        for (int i = 0; i < 4; ++i) ss += (v[i][0] * v[i][0] + v[i][1] * v[i][1]) + (v[i][2] * v[i][2] + v[i][3] * v[i][3]);
        ss = wave_sum(ss);
        const float rs = rsqrtf(ss * (1.f / 1024.f) + EPS);
        float s2 = 0.f;
        f4* xo = (f4*)(xout + (size_t)r * 1024) + lane;
#pragma unroll
        for (int i = 0; i < 4; ++i) { x[i] = x[i] + v[i] * rs * gp[i]; xo[64 * i] = x[i];
            s2 += (x[i][0] * x[i][0] + x[i][1] * x[i][1]) + (x[i][2] * x[i][2] + x[i][3] * x[i][3]); }
        if (gnext) {
            s2 = wave_sum(s2);
            const float r2n = rsqrtf(s2 * (1.f / 1024.f) + EPS);
            uint2* d = (uint2*)(hb + (size_t)r * 1024) + lane;
#pragma unroll
            for (int i = 0; i < 4; ++i) { uint2 w; w.x = pg8_pk2(x[i][0] * r2n * gn[i][0], x[i][1] * r2n * gn[i][1]); w.y = pg8_pk2(x[i][2] * r2n * gn[i][2], x[i][3] * r2n * gn[i][3]); d[64 * i] = w; }
        }
    }
}

template <int NV, class SF, class VF>
DI float wave_attn(float* sc, int n, SF scoref, VF vrowf, float (&out)[NV], int lane) {
#pragma unroll
    for (int j = 0; j < NV; ++j) out[j] = 0.f;
    float m = -INFINITY;
#pragma unroll 1
    for (int i = lane; i < n; i += 64) { asm volatile("" ::: "memory"); const float s = scoref(i); sc[i] = s; m = fmaxf(m, s); }
    m = wave_max(m);
    if (!(m > -INFINITY)) return 0.f;
    float sum = 0.f;
    for (int i = lane; i < n; i += 64) { const float p = __expf(sc[i] - m); sc[i] = p; sum += p; }
    sum = wave_sum(sum);
    float acc[NV];
#pragma unroll
    for (int j = 0; j < NV; ++j) acc[j] = 0.f;
#pragma unroll 4
    for (int i = 0; i < n; ++i) {
        const float p = sc[i];
        if (p != 0.f) {
            const u16* v = vrowf(i);
            if constexpr (NV == 2) { const u32 w = *(const u32*)(v + lane * 2); acc[0] = fmaf(p, bf2f(w & 0xffffu), acc[0]); acc[1] = fmaf(p, bf2f(w >> 16), acc[1]); }
            else { const uint2 w = *(const uint2*)(v + lane * 4); acc[0] = fmaf(p, bf2f(w.x & 0xffffu), acc[0]); acc[1] = fmaf(p, bf2f(w.x >> 16), acc[1]);
                   acc[2 % NV] = fmaf(p, bf2f(w.y & 0xffffu), acc[2 % NV]); acc[3 % NV] = fmaf(p, bf2f(w.y >> 16), acc[3 % NV]); }
        }
    }
    const float inv = 1.f / sum;
#pragma unroll
    for (int j = 0; j < NV; ++j) out[j] = acc[j] * inv;
    return sum;
}
DI float dot_q(const float* q, const u16* k, int n) {
    float a = 0.f;
#pragma unroll 4
    for (int d = 0; d < n; d += 8) {
        const uint4 w = *(const uint4*)(k + d);
        a = fmaf(q[d + 0], bf2f(w.x & 0xffffu), a); a = fmaf(q[d + 1], bf2f(w.x >> 16), a);
        a = fmaf(q[d + 2], bf2f(w.y & 0xffffu), a); a = fmaf(q[d + 3], bf2f(w.y >> 16), a);
        a = fmaf(q[d + 4], bf2f(w.z & 0xffffu), a); a = fmaf(q[d + 5], bf2f(w.z >> 16), a);
        a = fmaf(q[d + 6], bf2f(w.w & 0xffffu), a); a = fmaf(q[d + 7], bf2f(w.w >> 16), a);
    }
    return a;
}

namespace pg8 {
typedef short bf16x8 __attribute__((ext_vector_type(8)));
typedef float f32x4 __attribute__((ext_vector_type(4)));
typedef unsigned u32x4 __attribute__((ext_vector_type(4)));
typedef float f32x2_t __attribute__((ext_vector_type(2)));
typedef __bf16 bf16x2_t __attribute__((ext_vector_type(2)));
constexpr int BM = 256, BK = 64, HALF = 128, HTB = HALF * BK * 2, STAGE_BYTES = 8 * HTB, NXCD = 8, WGM = 8;
DI u32 pk2(float lo, float hi) { f32x2_t v = {lo, hi}; bf16x2_t b = __builtin_convertvector(v, bf16x2_t); return __builtin_bit_cast(u32, b); }
__host__ __device__ __forceinline__ int lds_byte(int r, int c) { const int st = (r >> 4) * 2 + (c >> 5), rr = r & 15, cc = c & 31, ob = rr * 64 + cc * 2; return st * 1024 + (ob ^ (((ob >> 9) & 1) << 5)); }
__host__ __device__ __forceinline__ void stage_rc(int b, int& R, int& C) { const int st = b / 1024, sb = b % 1024, swz = sb ^ (((sb >> 9) & 1) << 5); R = (st >> 1) * 16 + swz / 64; C = (st & 1) * 32 + (swz % 64) / 2; }
__host__ __device__ __forceinline__ int perm32(int rho) { const int n = rho >> 4, i = rho & 15; return 8 * (i >> 2) + 4 * n + (i & 3); }

struct Unit { const char* A; const char* B; int pm, pn; };

struct Sched1 {
    const char* A; const char* B; size_t sA, sB; int nM, nN, nwg, G, c;
    DI void init(const void* A_, int lda, const void* B_, int ldb, int M, int N, int rot) {
        A = (const char*)A_; B = (const char*)B_; sA = (size_t)BM * lda * 2; sB = (size_t)BM * ldb * 2; nM = M / BM; nN = N / BM; nwg = nM * nN; G = gridDim.x;
        c = (int)((blockIdx.x + G - (rot % G)) % G);
    }
    DI bool next(int i, Unit& u) const {
        const long L = (long)i * G + c; if (L >= nwg) return false;
        int wgid = (int)L; { const int q = nwg / NXCD, r = nwg % NXCD, xcd = wgid % NXCD, off = wgid / NXCD; wgid = (xcd < r ? xcd * (q + 1) : r * (q + 1) + (xcd - r) * q) + off; }
        const int nig = WGM * nN, gid = wgid / nig, fm = gid * WGM, gsz = (nM - fm) < WGM ? (nM - fm) : WGM;
        u.pm = fm + ((wgid % nig) % gsz); u.pn = (wgid % nig) / gsz; u.A = A + (size_t)u.pm * sA; u.B = B + (size_t)u.pn * sB; return true;
    }
};
struct SchedOne { const char* A; const char* B; int pm, pn; DI bool next(int i, Unit& u) const { if (i) return false; u.pm = pm; u.pn = pn; u.A = A; u.B = B; return true; } };
struct SchedCmp {
    const char* A; const char* B; int G, c;
    DI void init(const void* A_, const void* B_, int rot) { A = (const char*)A_; B = (const char*)B_; G = gridDim.x; c = (int)((blockIdx.x + G - (rot % G)) % G); }
    DI bool next(int i, Unit& u) const {
        const int L = i * G + c; if (L >= 32) return false;
        u.pm = L; u.pn = 0; u.A = A + (size_t)L * 256 * 512 * 2; u.B = B + (size_t)(L >> 1) * 256 * 512 * 2; return true;
    }
};

template <class F> struct EpiB16 {
    static constexpr bool PERM = true; F f;
    DI void operator()(const f32x4 (&acc)[2][2][4][2], const Unit& u, int wr, int wc, int fr, int fq) const {
        const int row0 = u.pm * BM + wr * 64 + fr, col0 = u.pn * BM + wc * 32 + 8 * fq;
#pragma unroll
        for (int ai = 0; ai < 2; ++ai)
#pragma unroll
            for (int m = 0; m < 4; ++m)
#pragma unroll
                for (int bj = 0; bj < 2; ++bj) f(row0 + ai * HALF + m * 16, col0 + bj * HALF, acc[ai][bj][m][0], acc[ai][bj][m][1]);
    }
};
template <class F> struct EpiF32 {
    static constexpr bool PERM = false; F f;
    DI void operator()(const f32x4 (&acc)[2][2][4][2], const Unit& u, int wr, int wc, int fr, int fq) const {
        const int row0 = u.pm * BM + wr * 64 + fr, col0 = u.pn * BM + wc * 32 + 4 * fq;
#pragma unroll
        for (int ai = 0; ai < 2; ++ai)
#pragma unroll
            for (int m = 0; m < 4; ++m)
#pragma unroll
                for (int bj = 0; bj < 2; ++bj)
#pragma unroll
                    for (int n = 0; n < 2; ++n) f(row0 + ai * HALF + m * 16, col0 + bj * HALF + n * 16, acc[ai][bj][m][n]);
    }
};
template <class F> DI EpiB16<F> epi_b16(F f) { return EpiB16<F>{f}; }
template <class F> DI EpiF32<F> epi_f32(F f) { return EpiF32<F>{f}; }
DI u32x4 pack8(f32x4 a, f32x4 b) { u32x4 w; w.x = pk2(a[0], a[1]); w.y = pk2(a[2], a[3]); w.z = pk2(b[0], b[1]); w.w = pk2(b[2], b[3]); return w; }

template <class Epi, class Sched, bool ALIGN_EPI = true, bool SP2 = true>
DI void gemm_phase(LAS unsigned char* lds, const int K, const int lda, const int ldb, const Sched& S, const Epi& E, const int wid_s) {
    const int tid = opaque_tid(wid_s);
    const int wid = __builtin_amdgcn_readfirstlane(tid >> 6), lane = tid & 63, wr = wid >> 2, wc = wid & 3, fr = lane & 15, fq = lane >> 4;
    const int nt = K / BK;
    unsigned voffA[2], voffB[2];
#pragma unroll
    for (int i = 0; i < 2; ++i) { int R, C; stage_rc(tid * 16 + i * 8192, R, C); const int Rb = Epi::PERM ? ((R & ~31) + perm32(R & 31)) : R;
        voffA[i] = (unsigned)(R * lda + C) * 2u; voffB[i] = (unsigned)(Rb * ldb + C) * 2u; }
    const size_t kstep = (size_t)(BK * 2);
    const size_t hstepA = (size_t)HALF * lda * 2, hstepB = (size_t)HALF * ldb * 2;
    const unsigned ldsw = (unsigned)wid * 1024u;
    const int aoff = lds_byte(wr * 64 + fr, fq * 8), boff = lds_byte(wc * 32 + fr, fq * 8);
#define PG8_SA(b, h) (((b) * 2 + (h)) * HTB)
#define PG8_SB(b, h) ((4 + (b) * 2 + (h)) * HTB)
#define PG8_STAGE(bufoff, gbase, voff) do { _Pragma("unroll") for (int _i = 0; _i < 2; ++_i) \
        __builtin_amdgcn_global_load_lds((const unsigned*)((const char*)(gbase) + (voff)[_i]), (LAS unsigned*)(lds + (bufoff) + ldsw + _i * 8192), 16, 0, 0); } while (0)
#define PG8_LDA(dst, b, h) do { _Pragma("unroll") for (int m = 0; m < 4; ++m) _Pragma("unroll") for (int k = 0; k < 2; ++k) dst[m][k] = *(const LAS bf16x8*)(lds + PG8_SA(b, h) + aoff + m * 2048 + k * 1024); } while (0)
#define PG8_LDB(dst, b, h) do { _Pragma("unroll") for (int n = 0; n < 2; ++n) _Pragma("unroll") for (int k = 0; k < 2; ++k) dst[n][k] = *(const LAS bf16x8*)(lds + PG8_SB(b, h) + boff + n * 2048 + k * 1024); } while (0)
#define PG8_MMA(ai, bj, At, Bt) do { __builtin_amdgcn_s_setprio(1); _Pragma("unroll") for (int m = 0; m < 4; ++m) _Pragma("unroll") for (int n = 0; n < 2; ++n) _Pragma("unroll") for (int k = 0; k < 2; ++k) \
        acc[ai][bj][m][n] = __builtin_amdgcn_mfma_f32_16x16x32_bf16(Bt[n][k], At[m][k], acc[ai][bj][m][n], 0, 0, 0); __builtin_amdgcn_s_setprio(0); } while (0)
#define PG8_WAIT_V(n) asm volatile("s_waitcnt vmcnt(" #n ")" ::: "memory")
#define PG8_WAIT_L(n) asm volatile("s_waitcnt lgkmcnt(" #n ")" ::: "memory")
#define PG8_BAR __builtin_amdgcn_s_barrier()
#define PG8_SCHED __builtin_amdgcn_sched_barrier(0)
    Unit cur, nxt; int ui = 0;
    if (!S.next(0, cur)) return;
    f32x4 acc[2][2][4][2];
#pragma unroll
    for (int a = 0; a < 2; ++a)
#pragma unroll
        for (int b = 0; b < 2; ++b)
#pragma unroll
            for (int m = 0; m < 4; ++m)
#pragma unroll
                for (int n = 0; n < 2; ++n) acc[a][b][m][n] = (f32x4){0.f, 0.f, 0.f, 0.f};
    bf16x8 At[4][2], B0[2][2], B1[2][2];
    const char* cA = cur.A; const char* cB = cur.B;
    if constexpr (SP2) {
        PG8_STAGE(PG8_SB(0, 0), cB, voffB); PG8_STAGE(PG8_SB(0, 1), cB + hstepB, voffB); PG8_STAGE(PG8_SA(0, 0), cA, voffA); PG8_STAGE(PG8_SA(0, 1), cA + hstepA, voffA);
        if (wr == 1) PG8_BAR;
        PG8_WAIT_V(2); PG8_BAR;
        PG8_STAGE(PG8_SB(1, 0), cB + kstep, voffB); PG8_STAGE(PG8_SA(1, 0), cA + kstep, voffA); PG8_STAGE(PG8_SB(1, 1), cB + hstepB + kstep, voffB);
        PG8_WAIT_V(6); PG8_BAR;
    } else {
        PG8_STAGE(PG8_SB(0, 0), cB, voffB); PG8_STAGE(PG8_SA(0, 0), cA, voffA); PG8_STAGE(PG8_SB(0, 1), cB + hstepB, voffB); PG8_STAGE(PG8_SA(0, 1), cA + hstepA, voffA);
        if (wr == 1) PG8_BAR;
        PG8_WAIT_V(4); PG8_BAR;
        PG8_STAGE(PG8_SB(1, 0), cB + kstep, voffB); PG8_STAGE(PG8_SA(1, 0), cA + kstep, voffA); PG8_STAGE(PG8_SB(1, 1), cB + hstepB + kstep, voffB);
        PG8_WAIT_V(6); PG8_BAR;
    }
    for (;;) {
        const bool has_next = S.next(ui + 1, nxt);
        const char* nA = has_next ? nxt.A : cA; const char* nB = has_next ? nxt.B : cB;
#pragma unroll 1
        for (int t = 0; t < nt; t += 2) {
            const bool last = (t == nt - 2);
            const char* a1 = cA + (size_t)(t + 1) * kstep;
            const char* a2 = last ? nA : cA + (size_t)(t + 2) * kstep; const char* b2 = last ? nB : cB + (size_t)(t + 2) * kstep;
            const char* a3 = a2 + kstep; const char* b3 = b2 + kstep;
            if constexpr (SP2) {
            PG8_LDB(B0, 0, 0); PG8_LDB(B1, 0, 1); PG8_SCHED; PG8_LDA(At, 0, 0); PG8_STAGE(PG8_SA(1, 1), a1 + hstepA, voffA);
            PG8_WAIT_V(8); PG8_WAIT_L(0); PG8_BAR; PG8_MMA(0, 0, At, B0); PG8_MMA(0, 1, At, B1); PG8_BAR; PG8_SCHED;
            PG8_LDA(At, 0, 1); PG8_STAGE(PG8_SB(0, 0), b2, voffB); PG8_STAGE(PG8_SB(0, 1), b2 + hstepB, voffB); PG8_STAGE(PG8_SA(0, 0), a2, voffA);
            PG8_WAIT_V(8); PG8_WAIT_L(0); PG8_BAR; PG8_MMA(1, 0, At, B0); PG8_MMA(1, 1, At, B1); PG8_BAR; PG8_SCHED;
            PG8_LDB(B0, 1, 0); PG8_LDB(B1, 1, 1); PG8_SCHED; PG8_LDA(At, 1, 0); PG8_STAGE(PG8_SA(0, 1), a2 + hstepA, voffA);
            PG8_WAIT_V(8); PG8_WAIT_L(0); PG8_BAR; PG8_MMA(0, 0, At, B0); PG8_MMA(0, 1, At, B1); PG8_BAR; PG8_SCHED;
            PG8_LDA(At, 1, 1); PG8_STAGE(PG8_SB(1, 0), b3, voffB); PG8_STAGE(PG8_SB(1, 1), b3 + hstepB, voffB); PG8_STAGE(PG8_SA(1, 0), a3, voffA);
            PG8_WAIT_V(8); PG8_WAIT_L(0); PG8_BAR; PG8_MMA(1, 0, At, B0); PG8_MMA(1, 1, At, B1); PG8_BAR; PG8_SCHED;
            } else {
            PG8_LDB(B0, 0, 0); PG8_SCHED; PG8_LDA(At, 0, 0); PG8_STAGE(PG8_SA(1, 1), a1 + hstepA, voffA);
            PG8_WAIT_L(8); PG8_BAR; PG8_WAIT_L(0); PG8_MMA(0, 0, At, B0); PG8_BAR; PG8_SCHED;
            PG8_LDB(B1, 0, 1); PG8_STAGE(PG8_SB(0, 0), b2, voffB);
            PG8_BAR; PG8_WAIT_L(0); PG8_MMA(0, 1, At, B1); PG8_BAR;
            PG8_LDA(At, 0, 1); PG8_STAGE(PG8_SA(0, 0), a2, voffA);
            PG8_BAR; PG8_WAIT_L(0); PG8_MMA(1, 0, At, B0); PG8_BAR; PG8_SCHED;
            PG8_STAGE(PG8_SB(0, 1), b2 + hstepB, voffB);
            PG8_WAIT_V(6); PG8_BAR; PG8_MMA(1, 1, At, B1); PG8_BAR;
            PG8_LDB(B0, 1, 0); PG8_SCHED; PG8_LDA(At, 1, 0); PG8_STAGE(PG8_SA(0, 1), a2 + hstepA, voffA);
            PG8_WAIT_L(8); PG8_BAR; PG8_WAIT_L(0); PG8_MMA(0, 0, At, B0); PG8_BAR; PG8_SCHED;
            PG8_LDB(B1, 1, 1); PG8_STAGE(PG8_SB(1, 0), b3, voffB);
            PG8_BAR; PG8_WAIT_L(0); PG8_MMA(0, 1, At, B1); PG8_BAR;
            PG8_LDA(At, 1, 1); PG8_STAGE(PG8_SA(1, 0), a3, voffA);
            PG8_BAR; PG8_WAIT_L(0); PG8_MMA(1, 0, At, B0); PG8_BAR; PG8_SCHED;
            PG8_STAGE(PG8_SB(1, 1), b3 + hstepB, voffB);
            PG8_WAIT_V(6); PG8_BAR; PG8_MMA(1, 1, At, B1); PG8_BAR;
            }
        }
        if constexpr (ALIGN_EPI) { if (wr == 0) PG8_BAR; }
        E(acc, cur, wr, wc, fr, fq);
        if (!has_next) break;
#pragma unroll
        for (int a = 0; a < 2; ++a)
#pragma unroll
            for (int b = 0; b < 2; ++b)
#pragma unroll
                for (int m = 0; m < 4; ++m)
#pragma unroll
                    for (int n = 0; n < 2; ++n) acc[a][b][m][n] = (f32x4){0.f, 0.f, 0.f, 0.f};
        cur = nxt; cA = nA; cB = nB; ++ui;
        if constexpr (ALIGN_EPI) { if (wr == 1) PG8_BAR; }
    }
    PG8_WAIT_V(0);
    if constexpr (!ALIGN_EPI) { if (wr == 0) PG8_BAR; }
    PG8_BAR;
#undef PG8_SA
#undef PG8_SB
#undef PG8_STAGE
#undef PG8_LDA
#undef PG8_LDB
#undef PG8_MMA
#undef PG8_WAIT_V
#undef PG8_WAIT_L
#undef PG8_BAR
#undef PG8_SCHED
}

template <class SF, class DF>
DI void conv_tile(const float* W, int ldw, int k0, int n0, SF srccol, DF dstp, float* scr, int lane) {
    const int sc = srccol(n0 + lane);
    float tv[64];
#pragma unroll
    for (int kk = 0; kk < 64; ++kk) tv[kk] = sc >= 0 ? W[(size_t)(k0 + kk) * ldw + sc] : 0.f;
#pragma unroll
    for (int kk = 0; kk < 64; ++kk) scr[kk * 65 + lane] = tv[kk];
    asm volatile("s_waitcnt lgkmcnt(0)" ::: "memory");
    const int c = lane & 7;
#pragma unroll
    for (int j = 0; j < 8; ++j) { const int n = (lane >> 3) + 8 * j; const float* s = scr + (8 * c) * 65 + n;
        u32x4 o; o.x = pk2(s[0 * 65], s[1 * 65]); o.y = pk2(s[2 * 65], s[3 * 65]); o.z = pk2(s[4 * 65], s[5 * 65]); o.w = pk2(s[6 * 65], s[7 * 65]);
        *(u32x4*)dstp(n0 + n, k0 + 8 * c) = o; }
    asm volatile("s_waitcnt lgkmcnt(0)" ::: "memory");
}
template <class SF, class DF>
DI int conv_matrix(const float* W, int ldw, int Kd, int Nd, SF srccol, DF dstp, float* scr, int lane, int gw, int ngw, int it0) {
    const int nblk = Nd / 64, nitems = (Kd / 64) * nblk;
    int first = gw - (it0 % ngw); if (first < 0) first += ngw;
    for (int it = first; it < nitems; it += ngw) conv_tile(W, ldw, (it / nblk) * 64, (it % nblk) * 64, srccol, dstp, scr, lane);
    return it0 + nitems;
}
}

namespace fa {
typedef short bf16x8 __attribute__((ext_vector_type(8)));
typedef short s16x4 __attribute__((ext_vector_type(4)));
typedef float f32x16 __attribute__((ext_vector_type(16)));
typedef float f32x4 __attribute__((ext_vector_type(4)));
typedef unsigned u32x4 __attribute__((ext_vector_type(4)));
constexpr int SHM_V = 16384;
constexpr int LDS_V = 0, LDS_K = 65536, LDS_TAB = 114688;
constexpr float LOG2E = 1.4426950408889634f;
DI int v_st(int k, int c) { return ((k >> 3) * 4 + (c >> 5)) * 512 + ((k & 7) * 32 + (c & 31)) * 2; }
DI int v_rd_base(int lane) { return ((lane & 3) << 3) | (((lane >> 2) & 3) << 6) | (((lane >> 4) & 1) << 5) | (((lane >> 5) & 1) << 8); }
constexpr int v_rd_off(int d0, int ks, int half) { return d0 * 512 + ks * 4096 + half * 2048; }
DI u32 pk2(float lo, float hi) { return pg8::pk2(lo, hi); }

struct KSrc { const u16* p; int pitch; const u16* p2; int pitch2; };
struct VSrc { const u16* p; int pitch; };
template <int DQK> DI void stage_dma(LAS unsigned char* lds, int buf, const KSrc& ks, const VSrc& vs, int kb, int wid, int lane) {
    constexpr int CPR = DQK / 8, PITCH = DQK * 2, KBYTES = 64 * PITCH;
#pragma unroll
    for (int i = 0; i < DQK / 64; ++i) {
        const int q = (i * 8 + wid) * 64 + lane, row = q / CPR, pc = q % CPR, cc = (pc & ~7) | ((pc & 7) ^ (row & 7));
        const u16* src = (DQK == 192 && cc >= 16) ? ks.p2 + (size_t)(kb + row) * ks.pitch2 + (cc - 16) * 8 : ks.p + (size_t)(kb + row) * ks.pitch + cc * 8;
        __builtin_amdgcn_global_load_lds((const unsigned*)src, (LAS unsigned*)(lds + LDS_K + buf * KBYTES + (i * 8 + wid) * 1024), 16, 0, 0);
    }
#pragma unroll
    for (int i = 0; i < 2; ++i) {
        const int q = (i * 8 + wid) * 64 + lane, st = q >> 5, key = (st >> 2) * 8 + ((q >> 2) & 7), col = (st & 3) * 32 + (q & 3) * 8;
        __builtin_amdgcn_global_load_lds((const unsigned*)(vs.p + (size_t)(kb + key) * vs.pitch + col), (LAS unsigned*)(lds + LDS_V + buf * SHM_V + (i * 8 + wid) * 1024), 16, 0, 0);
    }
}
template <int DQK> DI void qkt(f32x16& p0, f32x16& p1, LAS unsigned char* lds, int buf, int r32, int hi, const bf16x8 (&qr)[DQK / 16]) {
    constexpr int PITCH = DQK * 2, KBYTES = 64 * PITCH;
#pragma unroll
    for (int i = 0; i < 16; ++i) { p0[i] = 0.f; p1[i] = 0.f; }
    LAS unsigned char* kb[4];
#pragma unroll
    for (int dd = 0; dd < 4; ++dd) kb[dd] = lds + LDS_K + buf * KBYTES + r32 * PITCH + (((dd * 16 + hi * 8) * 2) ^ ((r32 & 7) << 4));
#pragma unroll
    for (int d0 = 0; d0 < DQK / 16; ++d0) {
        LAS unsigned char* a = kb[d0 & 3] + (d0 >> 2) * 128;
        const bf16x8 b0 = *(const LAS bf16x8*)a;
        const bf16x8 b1 = *(const LAS bf16x8*)(a + 32 * PITCH);
        p0 = __builtin_amdgcn_mfma_f32_32x32x16_bf16(b0, qr[d0], p0, 0, 0, 0);
        p1 = __builtin_amdgcn_mfma_f32_32x32x16_bf16(b1, qr[d0], p1, 0, 0, 0);
        if ((d0 & 3) == 3) __builtin_amdgcn_sched_barrier(0);
    }
}
DI float xhalf_max(float v) { auto rr = __builtin_amdgcn_permlane32_swap(__float_as_uint(v), __float_as_uint(v), false, false); return fmaxf(__uint_as_float(rr[0]), __uint_as_float(rr[1])); }
DI float xhalf_sum(float v) { auto rr = __builtin_amdgcn_permlane32_swap(__float_as_uint(v), __float_as_uint(v), false, false); return __uint_as_float(rr[0]) + __uint_as_float(rr[1]); }
DI void softmax_tile(f32x16& p0, f32x16& p1, float& m, float& l, f32x16 (&o)[4], bf16x8 (&pa)[4]) {
    float pmax = p0[0];
#pragma unroll
    for (int r = 1; r < 16; ++r) pmax = fmaxf(pmax, p0[r]);
#pragma unroll
    for (int r = 0; r < 16; ++r) pmax = fmaxf(pmax, p1[r]);
    pmax = xhalf_max(pmax);
    const float mn = fmaxf(m, pmax);
    const float alpha = __builtin_amdgcn_exp2f(m - mn);
    m = mn;
    float ps = 0.f;
#pragma unroll
    for (int r = 0; r < 16; ++r) { p0[r] = __builtin_amdgcn_exp2f(p0[r] - mn); ps += p0[r]; }
#pragma unroll
    for (int r = 0; r < 16; ++r) { p1[r] = __builtin_amdgcn_exp2f(p1[r] - mn); ps += p1[r]; }
    ps = xhalf_sum(ps);
    l = l * alpha + ps;
    if (__any(alpha < 1.f)) {
#pragma unroll
        for (int d = 0; d < 4; ++d)
#pragma unroll
            for (int r = 0; r < 16; ++r) o[d][r] *= alpha;
    }
#pragma unroll
    for (int s = 0; s < 2; ++s) {
        u32x4 w0 = {pk2(p0[8 * s + 0], p0[8 * s + 1]), pk2(p0[8 * s + 2], p0[8 * s + 3]), pk2(p0[8 * s + 4], p0[8 * s + 5]), pk2(p0[8 * s + 6], p0[8 * s + 7])};
        u32x4 w1 = {pk2(p1[8 * s + 0], p1[8 * s + 1]), pk2(p1[8 * s + 2], p1[8 * s + 3]), pk2(p1[8 * s + 4], p1[8 * s + 5]), pk2(p1[8 * s + 6], p1[8 * s + 7])};
        pa[s] = __builtin_bit_cast(bf16x8, w0); pa[2 + s] = __builtin_bit_cast(bf16x8, w1);
    }
}
DI void softmax_tile2(f32x16& p0, f32x16& p1, float cb, float& m, float& l, f32x16 (&o)[4], bf16x8 (&pa)[4]) {
    float pmax = p0[0];
#pragma unroll
    for (int r = 1; r < 16; ++r) pmax = fmaxf(pmax, p0[r]);
#pragma unroll
    for (int r = 0; r < 16; ++r) pmax = fmaxf(pmax, p1[r]);
    pmax = xhalf_max(pmax) + cb;
    const float mn = fmaxf(m, pmax);
    const float alpha = __builtin_amdgcn_exp2f(m - mn);
    m = mn;
    const float sh = mn - cb;
    float ps = 0.f;
#pragma unroll
    for (int r = 0; r < 16; ++r) { p0[r] = __builtin_amdgcn_exp2f(p0[r] - sh); ps += p0[r]; }
#pragma unroll
    for (int r = 0; r < 16; ++r) { p1[r] = __builtin_amdgcn_exp2f(p1[r] - sh); ps += p1[r]; }
    ps = xhalf_sum(ps);
    l = l * alpha + ps;
    if (__any(alpha < 1.f)) {
#pragma unroll
        for (int d = 0; d < 4; ++d)
#pragma unroll
            for (int r = 0; r < 16; ++r) o[d][r] *= alpha;
    }
#pragma unroll
    for (int s = 0; s < 2; ++s) {
        u32x4 w0 = {pk2(p0[8 * s + 0], p0[8 * s + 1]), pk2(p0[8 * s + 2], p0[8 * s + 3]), pk2(p0[8 * s + 4], p0[8 * s + 5]), pk2(p0[8 * s + 6], p0[8 * s + 7])};
        u32x4 w1 = {pk2(p1[8 * s + 0], p1[8 * s + 1]), pk2(p1[8 * s + 2], p1[8 * s + 3]), pk2(p1[8 * s + 4], p1[8 * s + 5]), pk2(p1[8 * s + 6], p1[8 * s + 7])};
        pa[s] = __builtin_bit_cast(bf16x8, w0); pa[2 + s] = __builtin_bit_cast(bf16x8, w1);
    }
}
constexpr float FA_TAU = 8.f;
DI void softmax_lazy(f32x16& p0, f32x16& p1, float& m, float& l, f32x16 (&o)[4], bf16x8 (&pa)[4]) {
    float pmax = p0[0];
#pragma unroll
    for (int r = 1; r < 16; ++r) pmax = fmaxf(pmax, p0[r]);
#pragma unroll
    for (int r = 0; r < 16; ++r) pmax = fmaxf(pmax, p1[r]);
    pmax = xhalf_max(pmax);
    const bool inval = !(m > -1e29f);
    const bool bump = inval ? (pmax > -1e29f) : (pmax > FA_TAU);
    if (__any(bump)) {
        const float mref = inval ? 0.f : m;
        const float mn = bump ? mref + pmax : m;
        const float alpha = bump ? __builtin_amdgcn_exp2f(m - mn) : 1.f;
        const float d = bump ? pmax : 0.f;
#pragma unroll
        for (int r = 0; r < 16; ++r) { p0[r] -= d; p1[r] -= d; }
        l *= alpha; m = mn;
#pragma unroll
        for (int dd = 0; dd < 4; ++dd)
#pragma unroll
            for (int r = 0; r < 16; ++r) o[dd][r] *= alpha;
    }
    float ps = 0.f;
#pragma unroll
    for (int r = 0; r < 16; ++r) { p0[r] = __builtin_amdgcn_exp2f(p0[r]); ps += p0[r]; }
#pragma unroll
    for (int r = 0; r < 16; ++r) { p1[r] = __builtin_amdgcn_exp2f(p1[r]); ps += p1[r]; }
    l += xhalf_sum(ps);
#pragma unroll
    for (int s = 0; s < 2; ++s) {
        u32x4 w0 = {pk2(p0[8 * s + 0], p0[8 * s + 1]), pk2(p0[8 * s + 2], p0[8 * s + 3]), pk2(p0[8 * s + 4], p0[8 * s + 5]), pk2(p0[8 * s + 6], p0[8 * s + 7])};
        u32x4 w1 = {pk2(p1[8 * s + 0], p1[8 * s + 1]), pk2(p1[8 * s + 2], p1[8 * s + 3]), pk2(p1[8 * s + 4], p1[8 * s + 5]), pk2(p1[8 * s + 6], p1[8 * s + 7])};
        pa[s] = __builtin_bit_cast(bf16x8, w0); pa[2 + s] = __builtin_bit_cast(bf16x8, w1);
    }
}
DI bf16x8 scale_frag(bf16x8 q, float c) {
    u32x4 w = __builtin_bit_cast(u32x4, q);
#pragma unroll
    for (int i = 0; i < 4; ++i) w[i] = pk2(__uint_as_float(w[i] << 16) * c, __uint_as_float(w[i] & 0xffff0000u) * c);
    return __builtin_bit_cast(bf16x8, w);
}
#define FA_TRRD(dst, off) asm volatile("ds_read_b64_tr_b16 %0, %1 offset:%2" : "=&v"(dst) : "v"(vb), "i"(off) : "memory")
DI void pv_tile(f32x16 (&o)[4], int vb, const bf16x8 (&pa)[4]) {
#define FA_PV_D0(d0) do { s16x4 l0, l1, l2, l3, h0, h1, h2, h3; constexpr int b_ = v_rd_off(d0, 0, 0); \
        FA_TRRD(l0, b_); FA_TRRD(h0, b_ + 2048); FA_TRRD(l1, b_ + 4096); FA_TRRD(h1, b_ + 6144); FA_TRRD(l2, b_ + 8192); FA_TRRD(h2, b_ + 10240); FA_TRRD(l3, b_ + 12288); FA_TRRD(h3, b_ + 14336); \
        asm volatile("s_waitcnt lgkmcnt(0)" ::: "memory"); __builtin_amdgcn_sched_barrier(0); \
        o[d0] = __builtin_amdgcn_mfma_f32_32x32x16_bf16((bf16x8){l0[0], l0[1], l0[2], l0[3], h0[0], h0[1], h0[2], h0[3]}, pa[0], o[d0], 0, 0, 0); \
        o[d0] = __builtin_amdgcn_mfma_f32_32x32x16_bf16((bf16x8){l1[0], l1[1], l1[2], l1[3], h1[0], h1[1], h1[2], h1[3]}, pa[1], o[d0], 0, 0, 0); \
        o[d0] = __builtin_amdgcn_mfma_f32_32x32x16_bf16((bf16x8){l2[0], l2[1], l2[2], l2[3], h2[0], h2[1], h2[2], h2[3]}, pa[2], o[d0], 0, 0, 0); \
        o[d0] = __builtin_amdgcn_mfma_f32_32x32x16_bf16((bf16x8){l3[0], l3[1], l3[2], l3[3], h3[0], h3[1], h3[2], h3[3]}, pa[3], o[d0], 0, 0, 0); } while (0)
    FA_PV_D0(0); FA_PV_D0(1); FA_PV_D0(2); FA_PV_D0(3);
#undef FA_PV_D0
}
DI void mask_tile(f32x16& p0, f32x16& p1, int dq, unsigned W) {
    const float NEG = -__builtin_inff();
#pragma unroll
    for (int r = 0; r < 16; ++r) {
        const int c = (r & 3) + 8 * (r >> 2);
        if ((unsigned)(dq - c) >= W) p0[r] = NEG;
        if ((unsigned)(dq - c - 32) >= W) p1[r] = NEG;
    }
}
DI void bias_tile(f32x16& p0, f32x16& p1, int dq, const LAS float* tab) {
#pragma unroll
    for (int r = 0; r < 16; ++r) {
        const int c = (r & 3) + 8 * (r >> 2);
        int d0 = dq - c, d1 = dq - c - 32;
        d0 = d0 < 0 ? 0 : (d0 > 127 ? 127 : d0); d1 = d1 < 0 ? 0 : (d1 > 127 ? 127 : d1);
        p0[r] += tab[d0]; p1[r] += tab[d1];
    }
}
#ifndef FA_PROBE
#define FA_PROBE 0
#endif
template <int DQK, int NBUF, class TF, class AF, class PF, class MF>
DI void fa_pass_simple(LAS unsigned char* lds, int wid_s, const bf16x8 (&qr)[DQK / 16], f32x16 (&o)[4], float& m, float& l, int nt, TF tilef, const KSrc& ks, const VSrc& vs, AF activef, PF pref, MF postf) {
    constexpr int NL = (DQK / 64 + 2) * (FA_PROBE == 1 ? 2 : 1);
    const int lane = opaque_tid(0), r32 = lane & 31, hi = lane >> 5, wid = wid_s;
    const int vb0 = (int)(unsigned)(size_t)lds + LDS_V + v_rd_base(lane);
    if (nt <= 0) return;
#pragma unroll
    for (int d0 = 0; d0 < DQK / 16; ++d0) asm volatile("" :: "v"(qr[d0]));
    stage_dma<DQK>(lds, 0, ks, vs, __builtin_amdgcn_readfirstlane(tilef(0)) * 64, wid, lane);
    if (NBUF == 3 && nt > 1) { stage_dma<DQK>(lds, 1, ks, vs, __builtin_amdgcn_readfirstlane(tilef(1)) * 64, wid, lane); asm volatile("s_waitcnt vmcnt(%0) lgkmcnt(0)\n\ts_barrier" :: "n"(NL) : "memory"); }
    else asm volatile("s_waitcnt vmcnt(0) lgkmcnt(0)\n\ts_barrier" ::: "memory");
    int buf = 0;
#pragma unroll 1
    for (int tt = 0; tt < nt; ++tt) {
        const int j = __builtin_amdgcn_readfirstlane(tilef(tt));
        const bool act = activef(j);
        const auto aux = pref(j);
        const int nb = (NBUF == 3) ? (buf == 0 ? 2 : buf - 1) : (buf ^ 1);
        const bool more = tt + (NBUF - 1) < nt;
        if (more) stage_dma<DQK>(lds, nb, ks, vs, __builtin_amdgcn_readfirstlane(tilef(tt + NBUF - 1)) * 64, wid, lane);
        if (FA_PROBE == 1 && more) stage_dma<DQK>(lds, nb, ks, vs, tilef(tt + NBUF - 1) * 64, wid, lane);
        if (act) {
            f32x16 p0, p1; bf16x8 pa[4];
            if (FA_PROBE == 3) { float m2 = m, l2 = l; f32x16 o2[4]; for (int d = 0; d < 4; ++d) o2[d] = o[d]; qkt<DQK>(p0, p1, lds, buf, r32, hi, qr); postf(p0, p1, j, aux); softmax_tile(p0, p1, m2, l2, o2, pa); asm volatile("" :: "v"(pa[0]), "v"(pa[1]), "v"(pa[2]), "v"(pa[3]), "v"(m2), "v"(l2)); }
            qkt<DQK>(p0, p1, lds, buf, r32, hi, qr);
            postf(p0, p1, j, aux);
            softmax_tile(p0, p1, m, l, o, pa);
            pv_tile(o, vb0 + buf * SHM_V, pa);
            if (FA_PROBE == 4) { f32x16 o2[4]; for (int d = 0; d < 4; ++d) o2[d] = o[d]; pv_tile(o2, vb0 + buf * SHM_V, pa); asm volatile("" :: "v"(o2[0]), "v"(o2[1]), "v"(o2[2]), "v"(o2[3])); }
        }
        if (FA_PROBE == 2) asm volatile("s_barrier" ::: "memory");
        if (NBUF == 3 && more) asm volatile("s_waitcnt vmcnt(%0) lgkmcnt(0)\n\ts_barrier" :: "n"(NL) : "memory");
        else asm volatile("s_waitcnt vmcnt(0) lgkmcnt(0)\n\ts_barrier" ::: "memory");
        buf = (NBUF == 3) ? (buf == 2 ? 0 : buf + 1) : (buf ^ 1);
    }
}
#define FA_TRRD2(dst, off) asm volatile("ds_read_b64_tr_b16 %0, %1 offset:%2" : "=&v"(dst) : "v"(vb), "i"(off) : "memory")
#define FA_KRD(dst, base, off) asm volatile("ds_read_b128 %0, %1 offset:%2" : "=&v"(dst) : "v"(base), "i"(off) : "memory")
#define FA_LGKM(n) do { asm volatile("s_waitcnt lgkmcnt(%0)" :: "n"(n) : "memory"); __builtin_amdgcn_sched_barrier(0); } while (0)
struct VFrag { s16x4 l0, h0, l1, h1, l2, h2, l3, h3; };
template <int D0> DI void pv_read(VFrag& f, int vb) { constexpr int b_ = v_rd_off(D0, 0, 0);
    FA_TRRD2(f.l0, b_); FA_TRRD2(f.h0, b_ + 2048); FA_TRRD2(f.l1, b_ + 4096); FA_TRRD2(f.h1, b_ + 6144); FA_TRRD2(f.l2, b_ + 8192); FA_TRRD2(f.h2, b_ + 10240); FA_TRRD2(f.l3, b_ + 12288); FA_TRRD2(f.h3, b_ + 14336); }
DI void pv_mma(f32x16& od, const VFrag& f, const bf16x8 (&pa)[4]) {
    od = __builtin_amdgcn_mfma_f32_32x32x16_bf16((bf16x8){f.l0[0], f.l0[1], f.l0[2], f.l0[3], f.h0[0], f.h0[1], f.h0[2], f.h0[3]}, pa[0], od, 0, 0, 0);
    od = __builtin_amdgcn_mfma_f32_32x32x16_bf16((bf16x8){f.l1[0], f.l1[1], f.l1[2], f.l1[3], f.h1[0], f.h1[1], f.h1[2], f.h1[3]}, pa[1], od, 0, 0, 0);
    od = __builtin_amdgcn_mfma_f32_32x32x16_bf16((bf16x8){f.l2[0], f.l2[1], f.l2[2], f.l2[3], f.h2[0], f.h2[1], f.h2[2], f.h2[3]}, pa[2], od, 0, 0, 0);
    od = __builtin_amdgcn_mfma_f32_32x32x16_bf16((bf16x8){f.l3[0], f.l3[1], f.l3[2], f.l3[3], f.h3[0], f.h3[1], f.h3[2], f.h3[3]}, pa[3], od, 0, 0, 0);
}
DI void pv_pipe(f32x16 (&o)[4], int vb, const bf16x8 (&pa)[4]) {
    VFrag f0, f1, f2;
    pv_read<0>(f0, vb); pv_read<1>(f1, vb);
    FA_LGKM(8); pv_mma(o[0], f0, pa); __builtin_amdgcn_sched_barrier(0); pv_read<2>(f2, vb);
    FA_LGKM(8); pv_mma(o[1], f1, pa); __builtin_amdgcn_sched_barrier(0); pv_read<3>(f0, vb);
    FA_LGKM(8); pv_mma(o[2], f2, pa); __builtin_amdgcn_sched_barrier(0);
    FA_LGKM(0); pv_mma(o[3], f0, pa); __builtin_amdgcn_sched_barrier(0);
}
struct KFrag { bf16x8 a0, a1, b0, b1; };
template <int S> DI void qk_read(KFrag& f, const int (&kbm)[4], const int (&kbe)[4]) {
    if constexpr (S < 4) { constexpr int dA = 2 * S, dB = 2 * S + 1;
        FA_KRD(f.a0, kbm[dA & 3], (dA >> 2) * 128); FA_KRD(f.a1, kbm[dA & 3], (dA >> 2) * 128 + 32 * 256);
        FA_KRD(f.b0, kbm[dB & 3], (dB >> 2) * 128); FA_KRD(f.b1, kbm[dB & 3], (dB >> 2) * 128 + 32 * 256); }
    else { constexpr int eA = 2 * S - 8, eB = 2 * S - 7;
        FA_KRD(f.a0, kbe[eA], 0); FA_KRD(f.a1, kbe[eA], 32 * 128);
        FA_KRD(f.b0, kbe[eB], 0); FA_KRD(f.b1, kbe[eB], 32 * 128); }
}
template <int S, int NQ> DI void qk_mma(f32x16& p0, f32x16& p1, const KFrag& f, const bf16x8 (&qr)[NQ]) {
    p0 = __builtin_amdgcn_mfma_f32_32x32x16_bf16(f.a0, qr[2 * S], p0, 0, 0, 0); p1 = __builtin_amdgcn_mfma_f32_32x32x16_bf16(f.a1, qr[2 * S], p1, 0, 0, 0);
    p0 = __builtin_amdgcn_mfma_f32_32x32x16_bf16(f.b0, qr[2 * S + 1], p0, 0, 0, 0); p1 = __builtin_amdgcn_mfma_f32_32x32x16_bf16(f.b1, qr[2 * S + 1], p1, 0, 0, 0);
}
template <int DQK> DI void qk_pipe(f32x16& p0, f32x16& p1, int ldsK, int r32, int hi, const bf16x8 (&qr)[DQK / 16], float ini) {
    constexpr int NS = DQK / 32;
    int kbm[4], kbe[4];
#pragma unroll
    for (int dd = 0; dd < 4; ++dd) { kbm[dd] = ldsK + r32 * 256 + (((dd * 2 + hi) ^ (r32 & 7)) << 4); kbe[dd] = ldsK + 16384 + r32 * 128 + (((dd * 2 + hi) ^ (r32 & 7)) << 4); }
#pragma unroll
    for (int i = 0; i < 16; ++i) { p0[i] = ini; p1[i] = ini; }
    KFrag f0, f1, f2;
    qk_read<0>(f0, kbm, kbe); qk_read<1>(f1, kbm, kbe);
    FA_LGKM(4); qk_mma<0>(p0, p1, f0, qr); __builtin_amdgcn_sched_barrier(0); qk_read<2>(f2, kbm, kbe);
    FA_LGKM(4); qk_mma<1>(p0, p1, f1, qr); __builtin_amdgcn_sched_barrier(0); qk_read<3>(f0, kbm, kbe);
    if constexpr (NS == 4) {
        FA_LGKM(4); qk_mma<2>(p0, p1, f2, qr); __builtin_amdgcn_sched_barrier(0);
        FA_LGKM(0); qk_mma<3>(p0, p1, f0, qr); __builtin_amdgcn_sched_barrier(0);
    } else {
        FA_LGKM(4); qk_mma<2>(p0, p1, f2, qr); __builtin_amdgcn_sched_barrier(0); qk_read<4>(f1, kbm, kbe);
        FA_LGKM(4); qk_mma<3>(p0, p1, f0, qr); __builtin_amdgcn_sched_barrier(0); qk_read<5>(f2, kbm, kbe);
        FA_LGKM(4); qk_mma<4>(p0, p1, f1, qr); __builtin_amdgcn_sched_barrier(0);
        FA_LGKM(0); qk_mma<5>(p0, p1, f2, qr); __builtin_amdgcn_sched_barrier(0);
    }
}
DI void fa_pin(int&) {}
DI void fa_pin(u64& a) { asm volatile("" : "+v"(a)); }
template <int DQK, class TF, class AF, class PF, class CF, class MF>
DI void fa_pass(LAS unsigned char* lds, int wid_s, const bf16x8 (&qr)[DQK / 16], f32x16 (&o)[4], float& m, float& l, int nt, TF tilef, const KSrc& ks, const VSrc& vs, AF activef, PF pref, CF cbf, MF postf) {
    static_assert(DQK == 128 || DQK == 192, "fa_pass: DQK 128 or 192");
    constexpr int NL = DQK / 64 + 2, KBYTES = 64 * DQK * 2;
    const int lane = opaque_tid(0), r32 = lane & 31, hi = lane >> 5, wid = wid_s;
    const int vb0 = (int)(unsigned)(size_t)lds + LDS_V + v_rd_base(lane);
    if (nt <= 0) return;
#pragma unroll
    for (int d0 = 0; d0 < DQK / 16; ++d0) asm volatile("" :: "v"(qr[d0]));
    unsigned offK[2], offE = 0u, offV[2];
#pragma unroll
    for (int i = 0; i < 2; ++i) {
        { const int q = (i * 8 + wid) * 64 + lane, row = q >> 4, pc = q & 15, cc = (pc & 8) | ((pc & 7) ^ (row & 7)); offK[i] = (unsigned)(row * ks.pitch + cc * 8) * 2u; }
        { const int q = (i * 8 + wid) * 64 + lane, st = q >> 5, key = (st >> 2) * 8 + ((q >> 2) & 7), col = (st & 3) * 32 + (q & 3) * 8; offV[i] = (unsigned)(key * vs.pitch + col) * 2u; }
    }
    if (DQK == 192) { const int q = wid * 64 + lane, row = q >> 3, pc = q & 7, cc = pc ^ (row & 7); offE = (unsigned)(row * ks.pitch2 + cc * 8) * 2u; }
#define FA_DMA(tau, kb_, vb_) do { const int kbase_ = __builtin_amdgcn_readfirstlane(tilef(tau)) * 64; \
        const char* kp_ = (const char*)(ks.p + (size_t)kbase_ * ks.pitch); const char* vp_ = (const char*)(vs.p + (size_t)kbase_ * vs.pitch); \
        _Pragma("unroll") for (int i_ = 0; i_ < 2; ++i_) __builtin_amdgcn_global_load_lds((const unsigned*)(kp_ + offK[i_]), (LAS unsigned*)(lds + LDS_K + (kb_) * KBYTES + (i_ * 8 + wid) * 1024), 16, 0, 0); \
        if (DQK == 192) { const char* ep_ = (const char*)(ks.p2 + (size_t)kbase_ * ks.pitch2); __builtin_amdgcn_global_load_lds((const unsigned*)(ep_ + offE), (LAS unsigned*)(lds + LDS_K + (kb_) * KBYTES + 16384 + wid * 1024), 16, 0, 0); } \
        _Pragma("unroll") for (int i_ = 0; i_ < 2; ++i_) __builtin_amdgcn_global_load_lds((const unsigned*)(vp_ + offV[i_]), (LAS unsigned*)(lds + LDS_V + (vb_) * SHM_V + (i_ * 8 + wid) * 1024), 16, 0, 0); } while (0)
#define FA_BAR() asm volatile("s_waitcnt lgkmcnt(0)\n\ts_barrier" ::: "memory")
    FA_DMA(0, 0, 0);
    if (nt > 1) { FA_DMA(1, 1, 1); asm volatile("s_waitcnt vmcnt(%0)" :: "n"(NL) : "memory"); } else asm volatile("s_waitcnt vmcnt(0)" ::: "memory");
    FA_BAR();
    if (wid >= 4) FA_BAR();
    int kb = 0, vb = 0;
    bool act_prev = false; bf16x8 pa[4];
    int vb_prev = 0;
#pragma unroll 1
    for (int tt = 0; tt < nt; ++tt) {
        const int j = __builtin_amdgcn_readfirstlane(tilef(tt));
        const bool act = activef(j);
        auto aux = pref(j);
        const bool more = tt + 2 < nt;
        __builtin_amdgcn_s_setprio(1);
        if (act_prev) pv_pipe(o, vb0 + vb_prev * SHM_V, pa);
        f32x16 p0, p1;
        if (act) qk_pipe<DQK>(p0, p1, (int)(unsigned)(size_t)lds + LDS_K + kb * KBYTES, r32, hi, qr, cbf(j) - (m > -1e29f ? m : 0.f));
        __builtin_amdgcn_s_setprio(0);
        asm volatile("s_waitcnt vmcnt(0)" ::: "memory");
        fa_pin(aux);
        FA_BAR();
        if (more) { const int kb2 = kb == 0 ? 2 : kb - 1, vb2 = (vb + 2) & 3; FA_DMA(tt + 2, kb2, vb2); }
        if (act) { postf(p0, p1, j, aux); softmax_lazy(p0, p1, m, l, o, pa); }
        FA_BAR();
        act_prev = act; vb_prev = vb;
        kb = kb == 2 ? 0 : kb + 1; vb = (vb + 1) & 3;
    }
    if (act_prev) pv_pipe(o, vb0 + vb_prev * SHM_V, pa);
    FA_BAR();
    if (wid < 4) FA_BAR();
#undef FA_DMA
#undef FA_BAR
}
DI void write_o(const f32x16 (&o)[4], float l, u16* dst, int pitch) {
    const float inv = l > 0.f ? 1.f / l : 0.f;
    const int lane = opaque_tid(0), rr = lane & 31, hi = lane >> 5;
    u16* rowp = dst + (size_t)rr * pitch + 4 * hi;
#pragma unroll
    for (int d0 = 0; d0 < 4; ++d0)
#pragma unroll
        for (int g4 = 0; g4 < 4; ++g4) {
            uint2 w; w.x = pk2(o[d0][4 * g4 + 0] * inv, o[d0][4 * g4 + 1] * inv); w.y = pk2(o[d0][4 * g4 + 2] * inv, o[d0][4 * g4 + 3] * inv);
            *(uint2*)(rowp + d0 * 32 + 8 * g4) = w;
        }
}
}


DI bool split_arrive_merge(unsigned char* glds, int wid_s, unsigned char* ws, int pslot, int chunk, unsigned* cntb, fa::f32x16 (&o)[4], float& m, float& l) {
    using namespace fa;
    const int lane = opaque_tid(0), rr = lane & 31, hi = lane >> 5, row = wid_s * 32 + rr;
    unsigned char* mine = ws + WS_PART + (size_t)(pslot * 2 + chunk) * PART_BYTES;
    const unsigned char* other = ws + WS_PART + (size_t)(pslot * 2 + (chunk ^ 1)) * PART_BYTES;
    {
        const float inv = l > 0.f ? 1.f / l : 0.f;
        u64* po = (u64*)(mine + (size_t)row * 256 + 8 * hi);
#pragma unroll
        for (int d0 = 0; d0 < 4; ++d0)
#pragma unroll
            for (int g4 = 0; g4 < 4; ++g4) {
                const u64 w = (u64)pk2(o[d0][4 * g4 + 0] * inv, o[d0][4 * g4 + 1] * inv) | ((u64)pk2(o[d0][4 * g4 + 2] * inv, o[d0][4 * g4 + 3] * inv) << 32);
                po[d0 * 8 + 2 * g4] = w;
            }
        if (hi == 0) *(u64*)(mine + 65536 + (size_t)row * 8) = (u64)__float_as_uint(m) | ((u64)__float_as_uint(l) << 32);
    }
    asm volatile("s_waitcnt vmcnt(0)" ::: "memory");
    __syncthreads();
    volatile LAS unsigned* flag = (volatile LAS unsigned*)(glds + LDS_MISC + 24);
    if (wid_s == 0 && lane == 0) {
        __builtin_amdgcn_fence(__ATOMIC_RELEASE, "agent");
        asm volatile("s_waitcnt vmcnt(0)" ::: "memory");
        *flag = __hip_atomic_fetch_add(cntb + pslot, 1u, __ATOMIC_RELAXED, __HIP_MEMORY_SCOPE_AGENT);
    }
    __syncthreads();
    if (__builtin_amdgcn_readfirstlane(*flag) == 0u) return false;
    __builtin_amdgcn_fence(__ATOMIC_ACQUIRE, "agent");
    asm volatile("s_waitcnt vmcnt(0)" ::: "memory");
    const u64 ml = *(const u64*)(other + 65536 + (size_t)row * 8);
    const float m2 = __uint_as_float((u32)ml), l2 = __uint_as_float((u32)(ml >> 32));
    const float M = fmaxf(m, m2);
    const float a1 = __fmul_rn(__builtin_amdgcn_exp2f(m - M), l), a2 = __fmul_rn(__builtin_amdgcn_exp2f(m2 - M), l2), den = __fadd_rn(a1, a2);
    const float r1 = den > 0.f ? a1 / den : 0.f, r2 = den > 0.f ? a2 / den : 0.f;
    const float inv = l > 0.f ? 1.f / l : 0.f;
    const u64* qo = (const u64*)(other + (size_t)row * 256 + 8 * hi);
#pragma unroll
    for (int d0 = 0; d0 < 4; ++d0)
#pragma unroll
        for (int g4 = 0; g4 < 4; ++g4) {
            const u64 w = qo[d0 * 8 + 2 * g4];
            const u32 s0 = pk2(o[d0][4 * g4 + 0] * inv, o[d0][4 * g4 + 1] * inv), s1 = pk2(o[d0][4 * g4 + 2] * inv, o[d0][4 * g4 + 3] * inv);
            o[d0][4 * g4 + 0] = __fadd_rn(__fmul_rn(bf2f(s0 & 0xffffu), r1), __fmul_rn(bf2f((u32)w & 0xffffu), r2));
            o[d0][4 * g4 + 1] = __fadd_rn(__fmul_rn(bf2f(s0 >> 16), r1), __fmul_rn(bf2f(((u32)w) >> 16), r2));
            o[d0][4 * g4 + 2] = __fadd_rn(__fmul_rn(bf2f(s1 & 0xffffu), r1), __fmul_rn(bf2f((u32)(w >> 32) & 0xffffu), r2));
            o[d0][4 * g4 + 3] = __fadd_rn(__fmul_rn(bf2f(s1 >> 16), r1), __fmul_rn(bf2f((u32)(w >> 48)), r2));
        }
    m = M; l = den > 0.f ? 1.f : 0.f;
    return true;
}

DI void mla_unit(unsigned char* glds, int wid_s, int h, int qb, int chunk, unsigned* cnt) {
    using namespace fa;
    LAS unsigned char* lds = (LAS unsigned char*)glds; const int tid = opaque_tid(wid_s); unsigned char* const ws = (unsigned char*)(GAS unsigned char*)ldp(glds, 21);
    const int lane = tid & 63, wid = wid_s, r32 = lane & 31, hi = lane >> 5;
    const int row0 = qb * 256 + wid * 32, row = row0 + r32;
    u16* mqn = (u16*)(ws + WS_MQN); const u16* mqr = (const u16*)(ws + WS_MQR);
    bf16x8 qr[12];
#pragma unroll
    for (int d0 = 0; d0 < 8; ++d0) qr[d0] = *(const bf16x8*)(mqn + (size_t)row * 1024 + h * 128 + d0 * 16 + hi * 8);
#pragma unroll
    for (int d0 = 0; d0 < 4; ++d0) qr[8 + d0] = *(const bf16x8*)(mqr + (size_t)row * 512 + h * 64 + d0 * 16 + hi * 8);
    f32x16 o[4];
#pragma unroll
    for (int d = 0; d < 4; ++d)
#pragma unroll
        for (int r = 0; r < 16; ++r) o[d][r] = 0.f;
    float m = -1e30f, l = 0.f;
    const KSrc ks{(const u16*)(ws + WS_MKN) + h * 128, 1024, (const u16*)(ws + WS_MKR), 64};
    const VSrc vs{(const u16*)(ws + WS_MV) + h * 128, 1024};
    constexpr float C2 = 0.07216878364870322f * LOG2E;
#pragma unroll
    for (int d0 = 0; d0 < 12; ++d0) qr[d0] = scale_frag(qr[d0], C2);
    const int ntt = 4 * (qb + 1), tmid = ntt / 2 + 1, t_lo = chunk == 1 ? tmid : 0, t_hi = chunk == 0 ? tmid : ntt;
    fa_pass<192>(lds, wid_s, qr, o, m, l, t_hi - t_lo, [&](int t) { return t_lo + t; }, ks, vs,
        [&](int j) { return j * 64 <= row0 + 31; },
        [](int) { return 0; }, [](int) { return 0.f; },
        [&](f32x16& p0, f32x16& p1, int j, int) {
            if (j * 64 + 63 > row0) mask_tile(p0, p1, row - j * 64 - 4 * hi, 0x80000000u);
        });
    if (chunk >= 0 && !split_arrive_merge(glds, wid_s, ws, h * 8 + (qb & 7), chunk, cnt, o, m, l)) return;
    write_o(o, l, mqn + (size_t)row0 * 1024 + h * 128, 1024);
}
DI void dsa_unit(unsigned char* glds, int wid_s, int h, int qb, int chunk, unsigned* cnt) {
    using namespace fa;
    LAS unsigned char* lds = (LAS unsigned char*)glds; const int tid = opaque_tid(wid_s); unsigned char* const ws = (unsigned char*)(GAS unsigned char*)ldp(glds, 21); const float* relb = (const float*)(GAS unsigned char*)ldp(glds, 3);
    const int lane = tid & 63, wid = wid_s, r32 = lane & 31, hi = lane >> 5;
    const int row0 = qb * 256 + wid * 32, row = row0 + r32;
    u16* proj = (u16*)(ws + WS_PROJ);
    LAS float* tab = (LAS float*)(lds + LDS_TAB);
    if (tid < 128) tab[tid] = relb[relbucket(tid) * 16 + h] * LOG2E;
    bf16x8 qr[8];
#pragma unroll
    for (int d0 = 0; d0 < 8; ++d0) qr[d0] = *(const bf16x8*)(proj + (size_t)row * PP + C_DSAQ + h * 128 + d0 * 16 + hi * 8);
    f32x16 o[4];
#pragma unroll
    for (int d = 0; d < 4; ++d)
#pragma unroll
        for (int r = 0; r < 16; ++r) o[d][r] = 0.f;
    float m = -1e30f, l = 0.f;
    const KSrc ks{proj + C_DSAK + h * 128, PP, nullptr, 0};
    const VSrc vs{proj + C_DSAV + h * 128, PP};
    const u32* mrow = (const u32*)(ws + WS_BITM) + (size_t)row * 128;
    constexpr float C2 = 0.08838834764831845f * LOG2E;
#pragma unroll
    for (int d0 = 0; d0 < 8; ++d0) qr[d0] = scale_frag(qr[d0], C2);
    const int ntt = 4 * (qb + 1), tmid = ntt / 2 + 1, t_lo = chunk == 1 ? tmid : 0, t_hi = chunk == 0 ? tmid : ntt;
    fa_pass<128>(lds, wid_s, qr, o, m, l, t_hi - t_lo, [&](int t) { return t_lo + t; }, ks, vs,
        [&](int j) { return j * 64 <= row0 + 31; },
        [&](int j) { u64 w; const u32* ap = mrow + 2 * j; asm volatile("global_load_dwordx2 %0, %1, off" : "=v"(w) : "v"(ap) : "memory"); return w; },
        [&](int j) { return row0 - (j * 64 + 63) >= 127 ? tab[127] : 0.f; },
        [&](f32x16& p0, f32x16& p1, int j, u64 mw64) {
            uint2 mw; mw.x = (u32)mw64; mw.y = (u32)(mw64 >> 32);
            if (!(row0 - (j * 64 + 63) >= 127)) bias_tile(p0, p1, row - j * 64 - 4 * hi, tab);
            const u32 w0 = mw.x >> (4 * hi), w1 = mw.y >> (4 * hi);
            const float NEG = -__builtin_inff();
#pragma unroll
            for (int r = 0; r < 16; ++r) { const int c = (r & 3) + 8 * (r >> 2); if (!((w0 >> c) & 1u)) p0[r] = NEG; if (!((w1 >> c) & 1u)) p1[r] = NEG; }
        });
    if (chunk >= 0 && !split_arrive_merge(glds, wid_s, ws, 64 + h * 8 + (qb & 7), chunk, cnt, o, m, l)) return;
    write_o(o, l, (u16*)(ws + WS_MV) + (size_t)row0 * 1024 + h * 128, 1024);
}

DI void cross_unit(unsigned char* glds, int wid_s, int bb, int h, int qb) {
    using namespace fa;
    LAS unsigned char* lds = (LAS unsigned char*)glds; const int tid = opaque_tid(wid_s); unsigned char* const ws = (unsigned char*)(GAS unsigned char*)ldp(glds, 21);
    const int lane = tid & 63, wid = wid_s, r32 = lane & 31, hi = lane >> 5;
    const int row0 = bb * SEQ + qb * 256 + wid * 32, row = row0 + r32;
    u16* cq = (u16*)(ws + WS_CQ); const u16* ckv = (const u16*)(ws + WS_CKV) + (size_t)bb * 256 * 2048;
    bf16x8 qr[16];
#pragma unroll
    for (int d0 = 0; d0 < 16; ++d0) qr[d0] = *(const bf16x8*)(cq + (size_t)row * 1024 + h * 256 + d0 * 16 + hi * 8);
    constexpr float C2 = 0.0625f * LOG2E;
    const KSrc ks{ckv + h * 256, 2048, nullptr, 0};
#pragma unroll 1
    for (int half = 0; half < 2; ++half) {
        f32x16 o[4];
#pragma unroll
        for (int d = 0; d < 4; ++d)
#pragma unroll
            for (int r = 0; r < 16; ++r) o[d][r] = 0.f;
        float m = -1e30f, l = 0.f;
        const VSrc vs{ckv + 1024 + h * 256 + half * 128, 2048};
        fa_pass_simple<256, 2>(lds, wid_s, qr, o, m, l, 4, [](int t) { return t; }, ks, vs,
            [](int) { return true; }, [](int) { return 0; },
            [&](f32x16& p0, f32x16& p1, int, int) {
#pragma unroll
                for (int r = 0; r < 16; ++r) { p0[r] *= C2; p1[r] *= C2; } });
        write_o(o, l, cq + (size_t)row0 * 1024 + h * 256 + half * 128, 1024);
    }
}

template <bool FIRST> DI void nsa_accum(const fa::f32x16 (&o)[4], float l, u16* proj, int t0w, int g, int hg, int gi, u16* dst, int dpitch) {
    const int lane = opaque_tid(0), rr = lane & 31, hh = lane >> 5;
    const u16* gp = proj + (size_t)(t0w + rr) * PP + C_NGATE + gi * 8 + g * 4 + hg;
    const float gate = sigmoidf_(bf2f(*gp));
    const float inv = l > 0.f ? gate / l : 0.f;
    u64* orow = (u64*)(dst + (size_t)(t0w + rr) * dpitch + (g * 4 + hg) * 128 + 4 * hh);
#pragma unroll
    for (int d = 0; d < 4; ++d)
#pragma unroll
        for (int g4 = 0; g4 < 4; ++g4) {
            float a0 = 0.f, a1 = 0.f, a2 = 0.f, a3 = 0.f;
            if (!FIRST) { const u64 w = orow[d * 8 + 2 * g4]; a0 = bf2f((u32)w & 0xffffu); a1 = bf2f(((u32)w) >> 16); a2 = bf2f((u32)(w >> 32) & 0xffffu); a3 = bf2f((u32)(w >> 48)); }
            const u64 w2 = (u64)fa::pk2(a0 + o[d][4 * g4] * inv, a1 + o[d][4 * g4 + 1] * inv) | ((u64)fa::pk2(a2 + o[d][4 * g4 + 2] * inv, a3 + o[d][4 * g4 + 3] * inv) << 32);
            orow[d * 8 + 2 * g4] = w2;
        }
}
DI void nsa_final(const fa::f32x16 (&o)[4], float l, u16* proj, int t0w, int g, int hg, const u16* ow, int owpitch, u16* nsao) {
    const int lane = opaque_tid(0), rr = lane & 31, hh = lane >> 5;
    const u16* gp = proj + (size_t)(t0w + rr) * PP + C_NGATE + 1 * 8 + g * 4 + hg;
    const float gate = sigmoidf_(bf2f(*gp));
    const float inv = l > 0.f ? gate / l : 0.f;
    u64* orow = (u64*)(nsao + (size_t)(t0w + rr) * 1024 + (g * 4 + hg) * 128 + 4 * hh);
    const u64* wrow = (const u64*)(ow + (size_t)(t0w + rr) * owpitch + (g * 4 + hg) * 128 + 4 * hh);
#pragma unroll
    for (int d = 0; d < 4; ++d)
#pragma unroll
        for (int g4 = 0; g4 < 4; ++g4) {
            const u64 a = orow[d * 8 + 2 * g4], c = wrow[d * 8 + 2 * g4];
            const float s0 = bf2f((u32)a & 0xffffu) + bf2f((u32)c & 0xffffu), s1 = bf2f(((u32)a) >> 16) + bf2f(((u32)c) >> 16);
            const float s2 = bf2f((u32)(a >> 32) & 0xffffu) + bf2f((u32)(c >> 32) & 0xffffu), s3 = bf2f((u32)(a >> 48)) + bf2f((u32)(c >> 48));
            orow[d * 8 + 2 * g4] = (u64)fa::pk2(s0 + o[d][4 * g4] * inv, s1 + o[d][4 * g4 + 1] * inv) | ((u64)fa::pk2(s2 + o[d][4 * g4 + 2] * inv, s3 + o[d][4 * g4 + 3] * inv) << 32);
        }
}

DI void nsa_unit(unsigned char* glds, int wid_s, int g, int n, int chunk, unsigned* cntb, unsigned* selfb) {
    using namespace fa;
    LAS unsigned char* lds = (LAS unsigned char*)glds; const int tid = opaque_tid(wid_s); unsigned char* const ws = (unsigned char*)(GAS unsigned char*)ldp(glds, 21); const float* relb = (const float*)(GAS unsigned char*)ldp(glds, 3);
    const int lane = tid & 63, r32 = lane & 31, hi = lane >> 5, hg = wid_s >> 1, qh = wid_s & 1;
    const int q = qh * 32 + r32, t = 64 * n + q, t0w = 64 * n + 32 * qh;
    u16* proj = (u16*)(ws + WS_PROJ);
    u16* const nsao = (u16*)(ws + WS_SCORE);
    LAS float* tab = (LAS float*)(lds + LDS_TAB);
    LAS u32* imp = (LAS u32*)(lds + LDS_TAB + 2048);
    LAS u32* selm = (LAS u32*)(lds + LDS_TAB + 2048 + 16384);
    LAS int* tlist = (LAS int*)(lds + LDS_TAB + 2048 + 16384 + 512);
    tab[tid] = relb[relbucket(tid & 127) * 16 + 8 + g * 4 + (tid >> 7)] * LOG2E;
#pragma unroll
    for (int k = 0; k < 8; ++k) imp[tid + 512 * k] = 0u;
    if (tid < 128) selm[tid] = 0u;
    u16* qrow = proj + (size_t)t * PP + C_NSAQ + (g * 4 + hg) * 128;
    bf16x8 qr[8];
#pragma unroll
    for (int d0 = 0; d0 < 8; ++d0) qr[d0] = *(const bf16x8*)(qrow + d0 * 16 + hi * 8);
    constexpr float C2 = 0.08838834764831845f * LOG2E;
#pragma unroll
    for (int d0 = 0; d0 < 8; ++d0) qr[d0] = scale_frag(qr[d0], C2);
    const LAS float* mytab = tab + hg * 128;
    f32x16 o[4];
#define NSA_ZERO_O() do { _Pragma("unroll") for (int d = 0; d < 4; ++d) _Pragma("unroll") for (int r = 0; r < 16; ++r) o[d][r] = 0.f; } while (0)
    float m = -1e30f, l = 0.f; int nts = 0;
    if (chunk != 1) {
    const int cmaxq = t >= 31 ? ((t - 31) >> 4) : -1;
    const int ntc = (4 * n + 3 + 63) >> 6;
    const KSrc kc{(const u16*)(ws + WS_KCMP) + g * 128, 256, nullptr, 0};
    const VSrc vc{(const u16*)(ws + WS_VCMP) + g * 128, 256};
    m = -1e30f; l = 0.f;
    NSA_ZERO_O();
    fa_pass<128>(lds, wid_s, qr, o, m, l, ntc, [](int tt) { return tt; }, kc, vc,
        [](int) { return true; }, [](int) { return 0; }, [](int) { return 0.f; },
        [&](f32x16& p0, f32x16& p1, int j, int) {
            mask_tile(p0, p1, cmaxq - 64 * j - 4 * hi, 0x80000000u);
        });
    nsa_accum<true>(o, l, proj, t0w, g, hg, 0, nsao, 1024);
    if (n < 16) {
        if (tid < 64) { selm[tid * 2] = (2u << n) - 1u; selm[tid * 2 + 1] = 0u; }
    } else {
    {
        const float invl = l > 0.f ? 1.f / l : 0.f;
        const unsigned impb = (unsigned)(size_t)imp;
        fa_pass<128>(lds, wid_s, qr, o, m, l, ntc, [](int tt) { return tt; }, kc, vc,
            [](int) { return true; }, [](int) { return 0; }, [](int) { return 0.f; },
            [&](f32x16& p0, f32x16& p1, int j, int) {
                mask_tile(p0, p1, cmaxq - 64 * j - 4 * hi, 0x80000000u);
#pragma unroll
                for (int r = 0; r < 16; ++r) { p0[r] = __builtin_amdgcn_exp2f(p0[r]) * invl; p1[r] = __builtin_amdgcn_exp2f(p1[r]) * invl; }
#pragma unroll
                for (int gi = 0; gi < 4; ++gi) {
                    const int jj0 = 16 * j + 2 * gi + hi, jj1 = jj0 + 8;
                    const float G0 = (p0[4 * gi] + p0[4 * gi + 1]) + (p0[4 * gi + 2] + p0[4 * gi + 3]), G1 = (p1[4 * gi] + p1[4 * gi + 1]) + (p1[4 * gi + 2] + p1[4 * gi + 3]);
                    constexpr float FX = 67108864.f;
#define NSA_LADD(idx, val) asm volatile("ds_add_u32 %0, %1" :: "v"(impb + (unsigned)(idx) * 4u), "v"((u32)(val)) : "memory")
                    if (G0 != 0.f) { NSA_LADD(jj0 * 64 + q, G0 * FX + 0.5f);
                                     if (p0[4 * gi + 3] != 0.f) NSA_LADD((jj0 + 1) * 64 + q, p0[4 * gi + 3] * FX + 0.5f); }
                    if (G1 != 0.f) { NSA_LADD(jj1 * 64 + q, G1 * FX + 0.5f);
                                     if (jj1 + 1 < 64 && p1[4 * gi + 3] != 0.f) NSA_LADD((jj1 + 1) * 64 + q, p1[4 * gi + 3] * FX + 0.5f); }
#undef NSA_LADD
                }
                const float NEG = -__builtin_inff();
#pragma unroll
                for (int r = 0; r < 16; ++r) { p0[r] = NEG; p1[r] = NEG; }
            });
    }
    {
#pragma unroll
        for (int k = 0; k < 8; ++k) {
            const int id = tid + 512 * k, jj = id >> 6;
            u32 key = 0u;
            if (jj <= n) { const u32 v = (jj == 0 || jj == n || jj == n - 1) ? 0x3ffffffu : min(imp[id] >> 5, 0x3fffffeu); key = (v << 6) | (u32)(63 - jj); }
            imp[id] = key;
        }
        __syncthreads();
        u32 tk[8]; int cn[8];
#pragma unroll
        for (int e = 0; e < 8; ++e) { tk[e] = imp[(wid_s + 8 * e) * 64 + lane]; cn[e] = 0; }
#pragma unroll 8
        for (int j2 = 0; j2 < 64; ++j2) {
            const u32 x = imp[j2 * 64 + lane];
#pragma unroll
            for (int e = 0; e < 8; ++e) cn[e] += (x > tk[e]) ? 1 : 0;
        }
#pragma unroll
        for (int e = 0; e < 8; ++e) { const int jj = wid_s + 8 * e;
            if (tk[e] != 0u && cn[e] < 16) __hip_atomic_fetch_or(selm + lane * 2 + (jj >> 5), 1u << (jj & 31), __ATOMIC_RELAXED, __HIP_MEMORY_SCOPE_WORKGROUP); }
    }
    }
    __syncthreads();
    {
        u32 u0 = selm[lane * 2], u1 = selm[lane * 2 + 1];
#pragma unroll
        for (int off = 32; off; off >>= 1) { u0 |= __shfl_xor(u0, off); u1 |= __shfl_xor(u1, off); }
        const u64 un = ((u64)u1 << 32) | u0;
        nts = __builtin_amdgcn_readfirstlane(__popcll(un));
        if (wid_s == 0 && ((un >> lane) & 1ull)) tlist[__popcll(un & ((1ull << lane) - 1ull))] = lane;
    }
    __syncthreads();
    if (chunk == 0) {
        u32* sx = (u32*)(ws + WS_SELX) + (size_t)(g * 32 + (n & 31)) * 256;
        if (tid < 128) __hip_atomic_store(sx + tid, selm[tid], __ATOMIC_RELAXED, __HIP_MEMORY_SCOPE_AGENT);
        else if (tid < 192) __hip_atomic_store(sx + tid, (u32)tlist[tid - 128], __ATOMIC_RELAXED, __HIP_MEMORY_SCOPE_AGENT);
        else if (tid == 192) __hip_atomic_store(sx + 192, (u32)nts, __ATOMIC_RELAXED, __HIP_MEMORY_SCOPE_AGENT);
        asm volatile("s_waitcnt vmcnt(0)" ::: "memory");
        __syncthreads();
        if (tid == 0) __hip_atomic_store(selfb + g * 32 + (n & 31), 1u, __ATOMIC_RELAXED, __HIP_MEMORY_SCOPE_AGENT);
    }
    }
    if (chunk != 0) {
        const KSrc ks{proj + C_NKW + g * 128, PP, nullptr, 0};
        const VSrc vs{proj + C_NVW + g * 128, PP};
        const int j0 = n >= 8 ? n - 8 : 0;
        m = -1e30f; l = 0.f;
        NSA_ZERO_O();
        fa_pass<128>(lds, wid_s, qr, o, m, l, n - j0 + 1, [&](int tt) { return j0 + tt; }, ks, vs,
            [](int) { return true; }, [](int) { return 0; },
            [&](int j) { return t0w - (64 * j + 63) >= 127 ? mytab[127] : 0.f; },
            [&](f32x16& p0, f32x16& p1, int j, int) {
                const int dq = t - 64 * j - 4 * hi;
                if (!(t0w - (64 * j + 63) >= 127)) bias_tile(p0, p1, dq, mytab);
                if (!(64 * j + 63 <= t0w && t0w + 31 - 64 * j < 512)) mask_tile(p0, p1, dq, 512u);
            });
        if (chunk < 0) nsa_accum<false>(o, l, proj, t0w, g, hg, 2, nsao, 1024);
        else nsa_accum<true>(o, l, proj, t0w, g, hg, 2, (u16*)(ws + WS_MKN), 1024);
    }
    if (chunk == 1) {
        if (tid == 0) { unsigned sp = 0;
            while (__hip_atomic_load(selfb + g * 32 + (n & 31), __ATOMIC_RELAXED, __HIP_MEMORY_SCOPE_AGENT) == 0u) { __builtin_amdgcn_s_sleep(8); if (++sp > (1u << 20)) break; }
            __builtin_amdgcn_fence(__ATOMIC_ACQUIRE, "agent"); asm volatile("s_waitcnt vmcnt(0)" ::: "memory"); }
        __syncthreads();
        const u32* sx = (const u32*)(ws + WS_SELX) + (size_t)(g * 32 + (n & 31)) * 256;
        if (tid < 128) selm[tid] = sx[tid]; else if (tid < 192) tlist[tid - 128] = (int)sx[tid];
        nts = __builtin_amdgcn_readfirstlane((int)sx[192]);
        __syncthreads();
    }
    const u32 ms0 = selm[q * 2], ms1 = selm[q * 2 + 1];
    {
        const KSrc ks{proj + C_NKS + g * 128, PP, nullptr, 0};
        const VSrc vs{proj + C_NVS + g * 128, PP};
        m = -1e30f; l = 0.f;
        NSA_ZERO_O();
        const int half = (nts + 1) >> 1, t_lo = chunk == 1 ? half : 0, t_hi = chunk == 0 ? half : nts;
        fa_pass<128>(lds, wid_s, qr, o, m, l, t_hi - t_lo, [&](int tt) { return tlist[t_lo + tt]; }, ks, vs,
            [&](int j) { const u32 w = j < 32 ? ms0 : ms1; return __any((w >> (j & 31)) & 1u) != 0; },
            [](int) { return 0; },
            [&](int j) { return t0w - (64 * j + 63) >= 127 ? mytab[127] : 0.f; },
            [&](f32x16& p0, f32x16& p1, int j, int) {
                const int dq = t - 64 * j - 4 * hi;
                if (!(t0w - (64 * j + 63) >= 127)) bias_tile(p0, p1, dq, mytab);
                if (j == n) mask_tile(p0, p1, dq, 0x80000000u);
                const u32 w = j < 32 ? ms0 : ms1;
                if (!((w >> (j & 31)) & 1u)) { const float NEG = -__builtin_inff();
#pragma unroll
                    for (int r = 0; r < 16; ++r) { p0[r] = NEG; p1[r] = NEG; } }
            });
        if (chunk >= 0) { if (!split_arrive_merge(glds, wid_s, ws, 128 + g * 32 + (n & 31), chunk, cntb, o, m, l)) return; nsa_final(o, l, proj, t0w, g, hg, (const u16*)(ws + WS_MKN), 1024, nsao); }
        else nsa_accum<false>(o, l, proj, t0w, g, hg, 1, nsao, 1024);
    }
#undef NSA_ZERO_O
}

__device__ const unsigned short ATT4_ITEMS[192] = {240, 248, 241, 249, 242, 250, 243, 251, 244, 252, 245, 253, 246, 254, 247, 255, 224, 232, 225, 233, 226, 234, 227, 235, 228, 236, 229, 237, 230, 238, 231, 239, 112, 113, 114, 115, 116, 117, 118, 119, 208, 216, 209, 217, 210, 218, 211, 219, 212, 220, 213, 221, 214, 222, 215, 223, 192, 200, 193, 201, 194, 202, 195, 203, 196, 204, 197, 205, 198, 206, 199, 207, 96, 97, 98, 99, 100, 101, 102, 103, 176, 184, 177, 185, 178, 186, 179, 187, 180, 188, 181, 189, 182, 190, 183, 191, 160, 168, 161, 169, 162, 170, 163, 171, 164, 172, 165, 173, 166, 174, 167, 175, 80, 81, 82, 83, 84, 85, 86, 87, 144, 152, 145, 153, 146, 154, 147, 155, 148, 156, 149, 157, 150, 158, 151, 159, 128, 136, 129, 137, 130, 138, 131, 139, 132, 140, 133, 141, 134, 142, 135, 143, 64, 65, 66, 67, 68, 69, 70, 71, 48, 49, 50, 51, 52, 53, 54, 55, 32, 33, 34, 35, 36, 37, 38, 39, 16, 17, 18, 19, 20, 21, 22, 23, 0, 1, 2, 3, 4, 5, 6, 7};
constexpr int N_ATT4 = 192;
__device__ const unsigned short ATT5_ITEMS[384] = {2544, 2545, 2528, 2529, 2512, 2513, 2496, 2497, 2480, 2481, 2464, 2465, 3040, 3041, 3056, 3057, 2448, 2449, 3008, 3009, 3024, 3025, 2432, 2433, 2976, 2977, 2992, 2993, 2416, 2417, 2944, 2945, 2960, 2961, 2400, 2401, 2912, 2913, 2928, 2929, 2384, 2385, 2880, 2881, 2896, 2897, 2368, 2369, 2848, 2849, 2864, 2865, 2352, 2353, 2816, 2817, 2832, 2833, 2336, 2337, 2320, 2321, 2304, 2305, 3058, 3059, 2784, 2785, 2800, 2801, 3026, 3027, 3042, 3043, 2752, 2753, 2768, 2769, 2994, 2995, 3010, 3011, 2720, 2721, 2736, 2737, 2962, 2963, 2978, 2979, 2688, 2689, 2704, 2705, 2930, 2931, 2946, 2947, 2656, 2657, 2672, 2673, 2898, 2899, 2914, 2915, 2624, 2625, 2640, 2641, 2866, 2867, 2882, 2883, 2592, 2593, 2608, 2609, 2834, 2835, 2850, 2851, 2560, 2561, 2576, 2577, 2802, 2803, 2818, 2819, 2770, 2771, 2786, 2787, 2738, 2739, 2754, 2755, 2706, 2707, 2722, 2723, 2674, 2675, 2690, 2691, 2642, 2643, 2658, 2659, 2610, 2611, 2626, 2627, 2288, 2289, 1264, 1265, 1266, 1267, 1268, 1269, 1270, 1271, 1272, 1273, 1274, 1275, 1276, 1277, 1278, 1279, 2578, 2579, 2594, 2595, 2272, 2273, 2562, 2563, 2256, 2257, 1248, 1249, 1250, 1251, 1252, 1253, 1254, 1255, 1256, 1257, 1258, 1259, 1260, 1261, 1262, 1263, 2240, 2241, 2224, 2225, 1232, 1233, 1234, 1235, 1236, 1237, 1238, 1239, 1240, 1241, 1242, 1243, 1244, 1245, 1246, 1247, 2208, 2209, 1136, 1137, 1138, 1139, 1140, 1141, 1142, 1143, 2192, 2193, 1216, 1217, 1218, 1219, 1220, 1221, 1222, 1223, 1224, 1225, 1226, 1227, 1228, 1229, 1230, 1231, 2176, 2177, 1200, 1201, 1202, 1203, 1204, 1205, 1206, 1207, 1208, 1209, 1210, 1211, 1212, 1213, 1214, 1215, 2160, 2161, 1120, 1121, 1122, 1123, 1124, 1125, 1126, 1127, 1184, 1185, 1186, 1187, 1188, 1189, 1190, 1191, 1192, 1193, 1194, 1195, 1196, 1197, 1198, 1199, 2144, 2145, 1168, 1169, 1170, 1171, 1172, 1173, 1174, 1175, 1176, 1177, 1178, 1179, 1180, 1181, 1182, 1183, 2128, 2129, 1104, 1105, 1106, 1107, 1108, 1109, 1110, 1111, 1152, 1153, 1154, 1155, 1156, 1157, 1158, 1159, 1160, 1161, 1162, 1163, 1164, 1165, 1166, 1167, 2112, 2113, 2096, 2097, 1088, 1089, 1090, 1091, 1092, 1093, 1094, 1095, 2080, 2081, 2064, 2065, 1072, 1073, 1074, 1075, 1076, 1077, 1078, 1079, 2048, 2049, 1056, 1057, 1058, 1059, 1060, 1061, 1062, 1063, 1040, 1041, 1042, 1043, 1044, 1045, 1046, 1047, 1024, 1025, 1026, 1027, 1028, 1029, 1030, 1031};
constexpr int N_ATT5 = 384;
constexpr int SPLIT_QB = 8, SPLIT_N = 32;

DI size_t score_off(int rb) { const int m = rb >> 1; return (size_t)2048 * ((rb & 1) ? (m + 1) * (m + 1) : m * (m + 1)); }
DI void idx_score_unit(unsigned char* glds, int wid_s, int rb, int kq) {
    using namespace fa;
    LAS unsigned char* lds = (LAS unsigned char*)glds; const int tid = opaque_tid(wid_s); unsigned char* const ws = (unsigned char*)(GAS unsigned char*)ldp(glds, 21);
    const int lane = tid & 63, r32 = lane & 31, hi = lane >> 5;
    const u16* proj = (const u16*)(ws + WS_PROJ);
    const int ntile = (rb >> 1) + 1, width = 64 * ntile;
    bf16x8 kn[2][4];
    { const int j0 = kq * 8 + wid_s, jc = j0 < ntile ? j0 : 0;
#pragma unroll
      for (int half = 0; half < 2; ++half)
#pragma unroll
          for (int ks = 0; ks < 4; ++ks) kn[half][ks] = *(const bf16x8*)(proj + (size_t)(64 * jc + 32 * half + r32) * PP + C_IDXK + ks * 16 + hi * 8); }
    u32x4 qv[4];
#pragma unroll
    for (int i = 0; i < 4; ++i) { const int id = tid + 512 * i, row = id >> 6, c = id & 63; qv[i] = *(const u32x4*)(proj + (size_t)(32 * rb + row) * PP + C_IDXQ + c * 8); }
    float iwv = 0.f;
    if (tid < 256) { const int row = tid >> 3, hh = tid & 7; iwv = bf2f(proj[(size_t)(32 * rb + row) * PP + C_IDXW + hh]); }
    __syncthreads();
#pragma unroll
    for (int i = 0; i < 4; ++i) { const int id = tid + 512 * i, row = id >> 6, c = id & 63;
        *(LAS u32x4*)(lds + row * 1024 + (((c & ~7) | ((c & 7) ^ (row & 7))) << 4)) = qv[i]; }
    if (tid < 256) ((LAS float*)(lds + 32768))[tid] = iwv;
    __syncthreads();
    float* sc = (float*)(ws + WS_SCORE) + score_off(rb) + (size_t)r32 * width + 4 * hi;
    LAS unsigned char* qbase = lds + r32 * 1024;
    const int sw = r32 & 7;
#pragma unroll 1
    for (int j = kq * 8 + wid_s; j < ntile; j += 32) {
        asm volatile("" ::: "memory");
        bf16x8 kf[2][4];
#pragma unroll
        for (int half = 0; half < 2; ++half)
#pragma unroll
            for (int ks = 0; ks < 4; ++ks) kf[half][ks] = kn[half][ks];
        { const int jn = j + 32 < ntile ? j + 32 : j;
#pragma unroll
          for (int half = 0; half < 2; ++half)
#pragma unroll
              for (int ks = 0; ks < 4; ++ks) kn[half][ks] = *(const bf16x8*)(proj + (size_t)(64 * jn + 32 * half + r32) * PP + C_IDXK + ks * 16 + hi * 8); }
        f32x16 a0, a1;
#pragma unroll
        for (int r = 0; r < 16; ++r) { a0[r] = 0.f; a1[r] = 0.f; }
#pragma unroll 2
        for (int h = 0; h < 8; ++h) {
            const float iwh = ((const LAS float*)(lds + 32768))[r32 * 8 + h];
            f32x16 p0, p1;
#pragma unroll
            for (int r = 0; r < 16; ++r) { p0[r] = 0.f; p1[r] = 0.f; }
#pragma unroll
            for (int ks = 0; ks < 4; ++ks) {
                const bf16x8 qf = *(const LAS bf16x8*)(qbase + h * 128 + (((ks * 2 + hi) ^ sw) << 4));
                p0 = __builtin_amdgcn_mfma_f32_32x32x16_bf16(kf[0][ks], qf, p0, 0, 0, 0);
                p1 = __builtin_amdgcn_mfma_f32_32x32x16_bf16(kf[1][ks], qf, p1, 0, 0, 0);
            }
#pragma unroll
            for (int r = 0; r < 16; ++r) { a0[r] = fmaf(iwh, fmaxf(p0[r], 0.f), a0[r]); a1[r] = fmaf(iwh, fmaxf(p1[r], 0.f), a1[r]); }
        }
#pragma unroll
        for (int g4 = 0; g4 < 4; ++g4) {
            *(f32x4*)(sc + 64 * j + 8 * g4) = (f32x4){a0[4 * g4], a0[4 * g4 + 1], a0[4 * g4 + 2], a0[4 * g4 + 3]};
            *(f32x4*)(sc + 64 * j + 32 + 8 * g4) = (f32x4){a1[4 * g4], a1[4 * g4 + 1], a1[4 * g4 + 2], a1[4 * g4 + 3]};
        }
    }
}

DI int wave_total_i(int v) {
    v += __builtin_amdgcn_update_dpp(0, v, 0x111, 0xf, 0xf, false);
    v += __builtin_amdgcn_update_dpp(0, v, 0x112, 0xf, 0xf, false);
    v += __builtin_amdgcn_update_dpp(0, v, 0x114, 0xf, 0xf, false);
    v += __builtin_amdgcn_update_dpp(0, v, 0x118, 0xf, 0xf, false);
    v += __builtin_amdgcn_update_dpp(0, v, 0x142, 0xa, 0xf, false);
    v += __builtin_amdgcn_update_dpp(0, v, 0x143, 0xc, 0xf, false);
    return __builtin_amdgcn_readlane(v, 63);
}
DI void tk_cnt_ge8(int& cl, const u32* u, u32 cand) {
    asm("v_cmp_le_u32_e32 vcc, %9, %1\n\tv_addc_co_u32_e32 %0, vcc, 0, %0, vcc\n\tv_cmp_le_u32_e32 vcc, %9, %2\n\tv_addc_co_u32_e32 %0, vcc, 0, %0, vcc\n\t"
        "v_cmp_le_u32_e32 vcc, %9, %3\n\tv_addc_co_u32_e32 %0, vcc, 0, %0, vcc\n\tv_cmp_le_u32_e32 vcc, %9, %4\n\tv_addc_co_u32_e32 %0, vcc, 0, %0, vcc\n\t"
        "v_cmp_le_u32_e32 vcc, %9, %5\n\tv_addc_co_u32_e32 %0, vcc, 0, %0, vcc\n\tv_cmp_le_u32_e32 vcc, %9, %6\n\tv_addc_co_u32_e32 %0, vcc, 0, %0, vcc\n\t"
        "v_cmp_le_u32_e32 vcc, %9, %7\n\tv_addc_co_u32_e32 %0, vcc, 0, %0, vcc\n\tv_cmp_le_u32_e32 vcc, %9, %8\n\tv_addc_co_u32_e32 %0, vcc, 0, %0, vcc"
        : "+v"(cl) : "v"(u[0]), "v"(u[1]), "v"(u[2]), "v"(u[3]), "v"(u[4]), "v"(u[5]), "v"(u[6]), "v"(u[7]), "s"(cand) : "vcc"); }
DI void tk_cnt_gt(int& cl, u32 u, u32 thr) { asm("v_cmp_lt_u32_e32 vcc, %2, %1\n\tv_addc_co_u32_e32 %0, vcc, 0, %0, vcc" : "+v"(cl) : "v"(u), "s"(thr) : "vcc"); }
template <int K, int NK> struct TopkMask {
    static DI void run(const u32 (&u)[NK], u32 Tv, int exact, int need, int& run_, int lane, u32& w0, u32& w1) {
        int pred;
        if (exact) pred = u[K] >= Tv ? 1 : 0;
        else { const bool gt = u[K] > Tv, eq = u[K] == Tv; const u64 beq = __ballot(eq);
               const int rank = run_ + __popcll(beq & ((1ull << lane) - 1ull)); run_ += __popcll(beq); pred = (gt || (eq && rank < need)) ? 1 : 0; }
        asm volatile("v_cmp_ne_u32_e32 vcc, 0, %2\n\ts_nop 4\n\tv_writelane_b32 %0, vcc_lo, %3\n\tv_writelane_b32 %1, vcc_hi, %3" : "+v"(w0), "+v"(w1) : "v"(pred), "n"(K) : "vcc");
        TopkMask<K + 1, NK>::run(u, Tv, exact, need, run_, lane, w0, w1);
    }
};
template <int NK> struct TopkMask<NK, NK> { static DI void run(const u32 (&)[NK], u32, int, int, int&, int, u32&, u32&) {} };
template <int NK> DI void topk_row(const float* srow, int n, u32* mrow, int lane) {
    u32 u[NK];
#pragma unroll
    for (int k = 0; k < NK; ++k) { const int i = 64 * k + lane; const float sv = srow[i] + 0.f;
        const u32 bts = __float_as_uint(sv); const u32 key = bts ^ ((u32)((int)bts >> 31) | 0x80000000u);
        u[k] = key & ~(u32)((n - 1 - i) >> 31); }
    u32 kmax = 0u;
#pragma unroll
    for (int k = 0; k < NK; ++k) kmax = kmax > u[k] ? kmax : u[k];
#pragma unroll
    for (int off = 32; off; off >>= 1) { const u32 t = (u32)__shfl_xor((int)kmax, off); kmax = kmax > t ? kmax : t; }
    u32 lo = 0u, hi = __builtin_amdgcn_readfirstlane(kmax) + 1u; int clo = n, chi = 0;
    u32 Tv = 0u; int exact = 0, it = 0;
#pragma unroll 1
    while (hi - lo > 1u) {
        u32 mid;
        if (it & 1) mid = lo + ((hi - lo) >> 1);
        else { const float fr = (float)(clo - 256) * __builtin_amdgcn_rcpf((float)(clo - chi)); mid = lo + (u32)((float)(hi - lo) * fr); }
        if (mid <= lo) mid = lo + 1u; if (mid >= hi) mid = hi - 1u;
        ++it;
        const u32 cand = __builtin_amdgcn_readfirstlane(mid); int cl = 0;
#pragma unroll
        for (int k = 0; k < NK; k += 8) tk_cnt_ge8(cl, u + k, cand);
        const int cnt = wave_total_i(cl);
        if (cnt == 256) { Tv = cand; exact = 1; break; }
        if (cnt > 256) { lo = cand; clo = cnt; } else { hi = cand; chi = cnt; }
    }
    if (!exact) Tv = lo;
    int need = 0x7fffffff, run = 0;
    if (!exact) { int cl = 0; const u32 thr = __builtin_amdgcn_readfirstlane(Tv);
#pragma unroll
        for (int k = 0; k < NK; ++k) tk_cnt_gt(cl, u[k], thr);
        need = 256 - wave_total_i(cl); }
    u32 w0 = 0u, w1 = 0u;
    TopkMask<0, NK>::run(u, Tv, exact, need, run, lane, w0, w1);
    uint2 w; w.x = lane < NK ? w0 : 0u; w.y = lane < NK ? w1 : 0u;
    *(uint2*)(mrow + 2 * lane) = w;
}
__global__ void __launch_bounds__(512, 2) mega(Params p) {
    extern __shared__ __attribute__((aligned(16))) unsigned char lds[];
    LAS unsigned char* llds = (LAS unsigned char*)lds;
    volatile LAS unsigned* xbw = (volatile LAS unsigned*)(lds + LDS_MISC);
    const int wid_s = __builtin_amdgcn_readfirstlane((int)(threadIdx.x >> 6));
    if (threadIdx.x == 0) {
        xbw[0] = 0u; xbw[1] = 0u; xbw[2] = 0u; xbw[3] = 0u;
        volatile LAS u64* pt = (volatile LAS u64*)(lds + LDS_MISC + 64);
        pt[0] = (u64)p.x; pt[1] = (u64)p.mem; pt[2] = (u64)p.pos; pt[3] = (u64)p.rel_bias; pt[4] = (u64)p.gains; pt[5] = (u64)p.w_in; pt[6] = (u64)p.qnorm; pt[7] = (u64)p.kvnorm;
        pt[8] = (u64)p.w_uq; pt[9] = (u64)p.w_ukv; pt[10] = (u64)p.cmp_pos; pt[11] = (u64)p.cmp_w1; pt[12] = (u64)p.cmp_w2; pt[13] = (u64)p.w_branch; pt[14] = (u64)p.w_out;
        pt[15] = (u64)p.cwq; pt[16] = (u64)p.cwkv; pt[17] = (u64)p.cwo; pt[18] = (u64)p.w1; pt[19] = (u64)p.w2; pt[20] = (u64)p.out; pt[21] = (u64)p.ws;
    }
    __syncthreads();
    XcdBarrier bar = xcd_barrier_post((unsigned*)(p.ws + WS_CTL) + 4096, xbw);
    using pg8::f32x4; using pg8::u32x4;
#define LP(T_, idx) ((T_)(GAS unsigned char*)ldp(lds, idx))
#define P_X LP(const float*, 0)
#define P_MEM LP(const float*, 1)
#define P_POS LP(const int*, 2)
#define P_RELB LP(const float*, 3)
#define P_GAINS LP(const float*, 4)
#define P_WIN LP(const float*, 5)
#define P_QNORM LP(const float*, 6)
#define P_KVNORM LP(const float*, 7)
#define P_WUQ LP(const float*, 8)
#define P_WUKV LP(const float*, 9)
#define P_CPOS LP(const float*, 10)
#define P_CW1 LP(const float*, 11)
#define P_CW2 LP(const float*, 12)
#define P_WBR LP(const float*, 13)
#define P_WOUT LP(const float*, 14)
#define P_CWQ LP(const float*, 15)
#define P_CWKV LP(const float*, 16)
#define P_CWO LP(const float*, 17)
#define P_W1 LP(const float*, 18)
#define P_W2 LP(const float*, 19)
#define P_OUT LP(float*, 20)
#define HB ((u16*)(ws + WS_HB))
#define MEMN ((u16*)(ws + WS_MEMN))
#define CKV ((u16*)(ws + WS_CKV))
#define MERGED ((u16*)(ws + WS_MERGED))
#define PROJ ((u16*)(ws + WS_PROJ))
#define GATES ((u16*)(ws + WS_GATES))
#define QNRM ((u16*)(ws + WS_QNRM))
#define KVNRM ((u16*)(ws + WS_KVNRM))
#define MQN ((u16*)(ws + WS_MQN))
#define MQR ((u16*)(ws + WS_MQR))
#define MKN ((u16*)(ws + WS_MKN))
#define MV ((u16*)(ws + WS_MV))
#define MKR ((u16*)(ws + WS_MKR))
#define CB ((u16*)(ws + WS_CBK))
#define CPART ((float*)(ws + WS_CPART))
#define KCMP ((u16*)(ws + WS_KCMP))
#define VCMP ((u16*)(ws + WS_VCMP))
#define BITM ((u32*)(ws + WS_BITM))
#define F32 ((float*)(ws + WS_F32))
#define CQ ((u16*)(ws + WS_CQ))
#define U ((u16*)(ws + WS_U))

    int ph = 0;
#define PH_BEGIN(kind) if (ph >= p.ph_lo && ph < p.ph_hi) { constexpr int nrep_ = PROBE_REP_H[kind]; for (int rep_ = 0; rep_ < nrep_; ++rep_) { const int tid = opaque_tid(wid_s), lane = tid & 63, wv = tid >> 6; float* wsl = (float*)(lds + wv * WSLOT); unsigned char* const ws = LP(unsigned char*, 21); (void)lane; (void)wsl; (void)ws;
#define PH_END   if (ph + 1 < p.ph_hi || rep_ + 1 < nrep_) xcd_barrier(bar); } } ++ph;

    for (int l = 0; l < DEPTH; ++l) {
#define GL (P_GAINS + (size_t)l * 7 * 1024)
#define XIN ((l == 0) ? P_X : (const float*)P_OUT)
        PH_BEGIN(0)
            {
                float* scr = (float*)(lds + wv * 16896);
                const int gw = blockIdx.x * 8 + wv, ngw = gridDim.x * 8;
                int it0 = 0;
                { const float* W = P_WIN + (size_t)l * 1024 * D_IN; u16* WT = (u16*)(ws + WT_IN);
                  it0 = pg8::conv_matrix(W, D_IN, 1024, 10240, [&](int n) { return n < PP ? proj_src(n) : 6944 + (n - PP); },
                                         [&](int n, int k) { return WT + (size_t)n * 1024 + k; }, scr, lane, gw, ngw, it0); }
                { const float* W = P_WUQ + (size_t)l * 384 * 1536; u16* WT = (u16*)(ws + WT_UQ);
                  it0 = pg8::conv_matrix(W, 1536, 384, 1536, [&](int n) { return n < 1024 ? (n >> 7) * 192 + (n & 127) : ((n - 1024) >> 6) * 192 + 128 + ((n - 1024) & 63); },
                                         [&](int n, int k) { return WT + (size_t)n * 384 + k; }, scr, lane, gw, ngw, it0); }
                { const float* W = P_WUKV + (size_t)l * 256 * 2048; u16* WT = (u16*)(ws + WT_UKV);
                  it0 = pg8::conv_matrix(W, 2048, 256, 2048, [&](int n) { return n; }, [&](int n, int k) { return WT + (size_t)n * 256 + k; }, scr, lane, gw, ngw, it0); }
                for (int kv = 0; kv < 2; ++kv) { const float* W = P_CW1 + ((size_t)l * 2 + kv) * 4096 * 256; u16* WT = (u16*)(ws + WT_C1);
                  it0 = pg8::conv_matrix(W, 256, 4096, 256, [&](int n) { return n; },
                                         [&](int n, int k) { return WT + ((size_t)((kv * 8 + (k >> 9)) * 256 + n)) * 512 + (k & 511); }, scr, lane, gw, ngw, it0); }
                for (int i = 0; i < 3; ++i) { const float* W = P_WBR + ((size_t)l * 3 + i) * 1024 * 1024; u16* WT = (u16*)(ws + WT_BR) + (size_t)i * 1024 * 1024;
                  it0 = pg8::conv_matrix(W, 1024, 1024, 1024, [&](int n) { return n; }, [&](int n, int k) { return WT + (size_t)n * 1024 + k; }, scr, lane, gw, ngw, it0); }
                { const float* W = P_WOUT + (size_t)l * 1024 * 1024; u16* WT = (u16*)(ws + WT_OUT);
                  it0 = pg8::conv_matrix(W, 1024, 1024, 1024, [&](int n) { return n; }, [&](int n, int k) { return WT + (size_t)n * 1024 + k; }, scr, lane, gw, ngw, it0); }
                { const float* W = P_CWKV + (size_t)l * 1024 * 2048; u16* WT = (u16*)(ws + WT_CKV);
                  it0 = pg8::conv_matrix(W, 2048, 1024, 2048, [&](int n) { return n; }, [&](int n, int k) { return WT + (size_t)n * 1024 + k; }, scr, lane, gw, ngw, it0); }
            }
            if (l == 0) ph_norm_rows(XIN, GL, HB, T, tid);
            ph_norm_rows(P_MEM, GL + 3 * 1024, MEMN, 1024, tid);
            if (l == 0) {
                float2* rt = (float2*)(ws + WS_ROPE); const int* posp = P_POS;
                for (int e = blockIdx.x * 512 + tid; e < T * 32; e += gridDim.x * 512) {
                    const float invf = powf(10000.f, -(float)(e & 31) * (1.f / 32.f));
                    float sn, cs; sincosf((float)posp[e >> 5] * invf, &sn, &cs);
                    rt[e] = make_float2(cs, sn);
                }
            }
        PH_END
        for (int b = 0; b < NB; ++b) {
            if (b == 0) {
            PH_BEGIN(1)
                {
                    pg8::Sched1 S; S.init(HB + (size_t)b * SEQ * 1024, 1024, ws + WT_IN, 1024, SEQ, PP, 0);
                    auto E = pg8::epi_b16([&](int row, int col, f32x4 v0, f32x4 v1) { *(u32x4*)(PROJ + (size_t)row * PP + col) = pg8::pack8(v0, v1); });
                    pg8::gemm_phase(llds, 1024, 1024, 1024, S, E, wid_s);
                }
                if (b == 0) {
                    pg8::Sched1 S; S.init(MEMN, 1024, ws + WT_CKV, 1024, 1024, 2048, 192);
                    auto E = pg8::epi_b16([&](int row, int col, f32x4 v0, f32x4 v1) { *(u32x4*)(CKV + (size_t)row * 2048 + col) = pg8::pack8(v0, v1); });
                    pg8::gemm_phase(llds, 1024, 1024, 1024, S, E, wid_s);
                }
            PH_END
            }
            PH_BEGIN(2)
                if (b > 0) h7_sum(GATES, MERGED + (size_t)(b - 1) * SEQ * 1024, tid);
                {
                    const float* qg = P_QNORM + l * 384; const float* kg = P_KVNORM + l * 256;
                    {
                        const int rbase = blockIdx.x * 8 + wv, nr = (SEQ - rbase + (int)gridDim.x * 8 - 1) / ((int)gridDim.x * 8);
                        for (int r0 = rbase; r0 < SEQ; r0 += 2 * gridDim.x * 8) {
                            float vq[2][6], vk[2][4], x1[2], x2[2]; float2 csn[2];
#pragma unroll
                            for (int u = 0; u < 2; ++u) {
                                const int r = r0 + u * gridDim.x * 8; const bool ok = r < SEQ; const u16* pr = PROJ + (size_t)(ok ? r : r0) * PP;
#pragma unroll
                                for (int i = 0; i < 6; ++i) vq[u][i] = bf2f(pr[C_QLAT + lane + 64 * i]);
#pragma unroll
                                for (int i = 0; i < 4; ++i) vk[u][i] = bf2f(pr[C_KVLAT + lane + 64 * i]);
                                x1[u] = bf2f(pr[C_KROPE + (lane & 31)]); x2[u] = bf2f(pr[C_KROPE + 32 + (lane & 31)]);
                                csn[u] = ((const float2*)(ws + WS_ROPE))[(size_t)(b * SEQ + (ok ? r : r0)) * 32 + (lane & 31)];
                            }
#pragma unroll
                            for (int u = 0; u < 2; ++u) {
                                const int r = r0 + u * gridDim.x * 8; if (r >= SEQ) break;
                                float ss = 0.f;
#pragma unroll
                                for (int i = 0; i < 6; ++i) ss += vq[u][i] * vq[u][i];
                                ss = wave_sum(ss); float rs = rsqrtf(ss * (1.f / 384.f) + EPS);
#pragma unroll
                                for (int i = 0; i < 6; ++i) QNRM[(size_t)r * 384 + lane + 64 * i] = (u16)f2bf(vq[u][i] * rs * qg[lane + 64 * i]);
                                ss = 0.f;
#pragma unroll
                                for (int i = 0; i < 4; ++i) ss += vk[u][i] * vk[u][i];
                                ss = wave_sum(ss); rs = rsqrtf(ss * (1.f / 256.f) + EPS);
#pragma unroll
                                for (int i = 0; i < 4; ++i) KVNRM[(size_t)r * 256 + lane + 64 * i] = (u16)f2bf(vk[u][i] * rs * kg[lane + 64 * i]);
                                if (lane < 32) {
                                    MKR[(size_t)r * 64 + lane] = (u16)f2bf(x1[u] * csn[u].x - x2[u] * csn[u].y);
                                    MKR[(size_t)r * 64 + 32 + lane] = (u16)f2bf(x2[u] * csn[u].x + x1[u] * csn[u].y);
                                }
                            }
                        }
                        (void)nr;
                    }
                    const float* cpos = P_CPOS + (size_t)l * 2 * 32 * 128;
#pragma unroll 2
                    for (int g8 = blockIdx.x * 512 + tid; g8 < 512 * 512; g8 += gridDim.x * 512) {
                        const int row = g8 >> 9, col = (g8 & 511) * 8, c = row >> 1, gg = row & 1, ll = col >> 7, d = col & 127;
                        u32x4 ok = {0u, 0u, 0u, 0u}, ov = {0u, 0u, 0u, 0u};
                        if (row < 510) {
                            const u16* pr = PROJ + (size_t)(16 * c + ll) * PP + gg * 128 + d;
                            const u32x4 kk = *(const u32x4*)(pr + C_NKC), vv = *(const u32x4*)(pr + C_NVC);
                            const f32x4* pk_ = (const f32x4*)(cpos + ll * 128 + d); const f32x4* pv_ = (const f32x4*)(cpos + 32 * 128 + ll * 128 + d);
                            const f32x4 k0 = pk_[0], k1 = pk_[1], v0 = pv_[0], v1 = pv_[1];
                            ok[0] = pg8::pk2(bf2f(kk[0] & 0xffffu) + k0[0], bf2f(kk[0] >> 16) + k0[1]); ok[1] = pg8::pk2(bf2f(kk[1] & 0xffffu) + k0[2], bf2f(kk[1] >> 16) + k0[3]);
                            ok[2] = pg8::pk2(bf2f(kk[2] & 0xffffu) + k1[0], bf2f(kk[2] >> 16) + k1[1]); ok[3] = pg8::pk2(bf2f(kk[3] & 0xffffu) + k1[2], bf2f(kk[3] >> 16) + k1[3]);
                            ov[0] = pg8::pk2(bf2f(vv[0] & 0xffffu) + v0[0], bf2f(vv[0] >> 16) + v0[1]); ov[1] = pg8::pk2(bf2f(vv[1] & 0xffffu) + v0[2], bf2f(vv[1] >> 16) + v0[3]);
                            ov[2] = pg8::pk2(bf2f(vv[2] & 0xffffu) + v1[0], bf2f(vv[2] >> 16) + v1[1]); ov[3] = pg8::pk2(bf2f(vv[3] & 0xffffu) + v1[2], bf2f(vv[3] >> 16) + v1[3]);
                        }
                        const size_t de = ((size_t)(col >> 9) * 512 + row) * 512 + (col & 511);
                        *(u32x4*)(CB + de) = ok; *(u32x4*)(CB + (size_t)8 * 512 * 512 + de) = ov;
                    }
                }
            PH_END
            PH_BEGIN(3)
                {
                    pg8::Sched1 S; S.init(QNRM, 384, ws + WT_UQ, 384, SEQ, 1536, 32);
                    auto E = pg8::epi_b16([&](int row, int col, f32x4 v0, f32x4 v1) {
                        u16* d = col < 1024 ? MQN + (size_t)row * 1024 + col : MQR + (size_t)row * 512 + (col - 1024);
                        *(u32x4*)d = pg8::pack8(v0, v1); });
                    pg8::gemm_phase(llds, 384, 384, 384, S, E, wid_s);
                    pg8::Unit u0;
                    if (S.next(0, u0) && u0.pn >= 4) {
                        asm volatile("s_waitcnt vmcnt(0)" ::: "memory");
                        __syncthreads();
                        const float2* rt = (const float2*)(ws + WS_ROPE) + (size_t)(b * SEQ + 256 * u0.pm) * 32;
                        u16* qt = MQR + (size_t)(256 * u0.pm) * 512 + (u0.pn - 4) * 256;
#pragma unroll 2
                        for (int e = opaque_tid(wid_s); e < 256 * 16; e += 512) {
                            const int row = e >> 4, hh = (e >> 2) & 3, f0 = (e & 3) * 8;
                            u16* q = qt + (size_t)row * 512 + hh * 64 + f0;
                            const u32x4 a = *(const u32x4*)q, c2 = *(const u32x4*)(q + 32);
                            const f32x4* tp = (const f32x4*)(rt + row * 32 + f0);
                            u32x4 oa, oc;
#pragma unroll
                            for (int i = 0; i < 4; ++i) {
                                const f32x4 cs = tp[i];
                                const float x1a = bf2f(a[i] & 0xffffu), x1b = bf2f(a[i] >> 16), x2a = bf2f(c2[i] & 0xffffu), x2b = bf2f(c2[i] >> 16);
                                oa[i] = pg8::pk2(x1a * cs[0] - x2a * cs[1], x1b * cs[2] - x2b * cs[3]);
                                oc[i] = pg8::pk2(x2a * cs[0] + x1a * cs[1], x2b * cs[2] + x1b * cs[3]);
                            }
                            *(u32x4*)q = oa; *(u32x4*)(q + 32) = oc;
                        }
                    }
                }
                {
                    pg8::Sched1 S; S.init(KVNRM, 256, ws + WT_UKV, 256, SEQ, 2048, 128);
                    auto E = pg8::epi_b16([&](int row, int col, f32x4 v0, f32x4 v1) {
                        u16* d = ((col & 128) ? MV : MKN) + (size_t)row * 1024 + (col >> 8) * 128 + (col & 127);
                        *(u32x4*)d = pg8::pack8(v0, v1); });
                    pg8::gemm_phase(llds, 256, 256, 256, S, E, wid_s);
                }
                {
                    pg8::SchedCmp S; S.init(CB, ws + WT_C1, 0);
                    auto E = pg8::epi_f32([&](int row, int col, f32x4 v) { *(f32x4*)(CPART + (size_t)row * 256 + col) = v; });
                    pg8::gemm_phase(llds, 512, 512, 512, S, E, wid_s);
                }
                {
                    unsigned* qctr3 = (unsigned*)(ws + WS_CTL) + 16384 + 64 * (16 + l * NB + b);
                    volatile LAS int* qslot3 = (volatile LAS int*)(lds + LDS_MISC + 16);
                    for (;;) {
                        __syncthreads();
                        if (opaque_tid(wid_s) == 0) *qslot3 = (int)atomicAdd(qctr3, 1u);
                        __syncthreads();
                        const int u = __builtin_amdgcn_readfirstlane(*qslot3);
                        if (u >= 480) break;
                        idx_score_unit(lds, wid_s, 127 - (u >> 2), u & 3);
                    }
                    __syncthreads();
                }
            PH_END
            PH_BEGIN(4)
                {
                    unsigned* qctr = (unsigned*)(ws + WS_CTL) + 16384 + 64 * (l * NB + b);
                    volatile LAS int* qslot = (volatile LAS int*)(lds + LDS_MISC + 16);
                    unsigned* cntb = (unsigned*)(ws + WS_CTL) + 65536 + 256 * (l * NB + b);
                    for (;;) {
                        __syncthreads();
                        if (opaque_tid(wid_s) == 0) *qslot = (int)atomicAdd(qctr, 1u);
                        __syncthreads();
                        const int item = __builtin_amdgcn_readfirstlane(*qslot);
                        if (item >= 512 + 64 + N_ATT4 + 192) break;
                        constexpr int Q_GATE = N_ATT4, Q_CMP = N_ATT4 + 192, Q_TOPK = N_ATT4 + 192 + 64;
                        if (item >= Q_TOPK) {
                            const int item_tk = item - Q_TOPK;
                            const int rr = 8 * (511 - item_tk) + wid_s, n = rr + 1;
                            const int lane2 = opaque_tid(0);
                            u32* mrow = BITM + (size_t)rr * 128;
                            if (n <= 256) {
                                for (int w = lane2; w < 128; w += 64) { const int lo = 32 * w; mrow[w] = (lo + 32 <= n) ? 0xffffffffu : (lo >= n ? 0u : ((1u << (n - lo)) - 1u)); }
                            } else {
                                const int rb = rr >> 5, width = 64 * ((rb >> 1) + 1);
                                const float* srow = (const float*)(ws + WS_SCORE) + score_off(rb) + (size_t)(rr & 31) * width;
                                if (n <= 512) topk_row<8>(srow, n, mrow, lane2);
                                else if (n <= 1024) topk_row<16>(srow, n, mrow, lane2);
                                else if (n <= 1536) topk_row<24>(srow, n, mrow, lane2);
                                else if (n <= 2048) topk_row<32>(srow, n, mrow, lane2);
                                else if (n <= 2560) topk_row<40>(srow, n, mrow, lane2);
                                else if (n <= 3072) topk_row<48>(srow, n, mrow, lane2);
                                else if (n <= 3584) topk_row<56>(srow, n, mrow, lane2);
                                else topk_row<64>(srow, n, mrow, lane2);
                            }
                        } else if (item >= Q_CMP) {
                            {
                                const int it32 = item - Q_CMP, kv = it32 >> 5, r0 = (it32 & 31) * 32;
                                const int tid2 = opaque_tid(wid_s), lane2 = tid2 & 63;
                                const float* W2 = P_CW2 + ((size_t)l * 2 + kv) * 256 * 128;
                                float* w2s = (float*)lds;
#pragma unroll 4
                                for (int i = 0; i < 16; ++i) ((f32x4*)w2s)[tid2 + 512 * i] = ((const f32x4*)W2)[tid2 + 512 * i];
                                float* hid = (float*)(lds + 131072 + wid_s * 1024);
                                __syncthreads();
#pragma unroll 1
                                for (int rr4 = 0; rr4 < 4; ++rr4) {
                                    const int row = r0 + wid_s * 4 + rr4;
                                    u16* dst = (kv ? VCMP : KCMP) + (size_t)row * 128;
                                    if (row >= 510) { *(u32*)(dst + lane2 * 2) = 0u; continue; }
                                    float h4[4] = {0.f, 0.f, 0.f, 0.f};
#pragma unroll
                                    for (int ch = 0; ch < 8; ++ch) { const f32x4 pv = *(const f32x4*)(CPART + ((size_t)(kv * 8 + ch) * 512 + row) * 256 + lane2 * 4);
                                        h4[0] += pv[0]; h4[1] += pv[1]; h4[2] += pv[2]; h4[3] += pv[3]; }
#pragma unroll
                                    for (int j = 0; j < 4; ++j) hid[lane2 * 4 + j] = gelu_tanh(h4[j]);
                                    float o0 = 0.f, o1 = 0.f;
#pragma unroll 8
                                    for (int j = 0; j < 256; ++j) { const float hj = hid[j]; o0 = fmaf(hj, w2s[j * 128 + lane2], o0); o1 = fmaf(hj, w2s[j * 128 + 64 + lane2], o1); }
                                    dst[lane2] = (u16)f2bf(o0); dst[64 + lane2] = (u16)f2bf(o1);
                                }
                            }
                        } else if (item < Q_GATE) {
                            const int code = ATT4_ITEMS[item], xx = (code >> 4) & 63, yy = code & 15;
                            mla_unit(lds, wid_s, yy & 7, xx, xx >= SPLIT_QB ? (yy >> 3) : -1, cntb);
                        } else {
                            const int uu = item - Q_GATE, pm = uu / 12, pn = uu % 12;
                            pg8::SchedOne S{(const char*)(HB + ((size_t)b * SEQ + 256 * pm) * 1024), (const char*)(ws + WT_IN) + (size_t)(PP + 256 * pn) * 1024 * 2, pm, pn};
                            auto E = pg8::epi_b16([&](int row, int col, f32x4 v0, f32x4 v1) {
                                f32x4 a, c2;
#pragma unroll
                                for (int j = 0; j < 4; ++j) { a[j] = sigmoidf_(v0[j]); c2[j] = sigmoidf_(v1[j]); }
                                *(u32x4*)(GATES + (size_t)row * 3072 + col) = pg8::pack8(a, c2); });
                            pg8::gemm_phase(llds, 1024, 1024, 1024, S, E, wid_s);
                        }
                    }
                    __syncthreads();
                }
            PH_END
            PH_BEGIN(5)
                {
                    float* sc = wsl;
                    float* qs = wsl + 4096;
                    {
                        unsigned* qctr = (unsigned*)(ws + WS_CTL) + 16384 + 64 * (8 + l * NB + b);
                        volatile LAS int* qslot = (volatile LAS int*)(lds + LDS_MISC + 16);
                        for (;;) {
                            __syncthreads();
                            if (opaque_tid(wid_s) == 0) *qslot = (int)atomicAdd(qctr, 1u);
                            __syncthreads();
                            const int item = __builtin_amdgcn_readfirstlane(*qslot);
                            if (item >= N_ATT5) break;
                            const int code = ATT5_ITEMS[item], ty = code >> 10, xx = (code >> 4) & 63, yy = code & 15;
                            unsigned* cntb = (unsigned*)(ws + WS_CTL) + 65536 + 256 * (l * NB + b);
                            if (ty == 1) dsa_unit(lds, wid_s, yy & 7, xx, xx >= SPLIT_QB ? (yy >> 3) : -1, cntb);
                            else nsa_unit(lds, wid_s, yy & 1, xx, xx >= SPLIT_N ? ((yy >> 1) & 1) : -1, cntb, (unsigned*)(ws + WS_CTL) + 72000 + 64 * (l * NB + b));
                        }
                        __syncthreads();
                    }
                }
            PH_END
            PH_BEGIN(6)
                for (int i = 0; i < 3; ++i) {
                    const u16* A = i == 0 ? MQN : (i == 1 ? (const u16*)(ws + WS_MV) : (const u16*)(ws + WS_SCORE));
                    const int lda = 1024;
                    pg8::Sched1 S; S.init(A, lda, ws + WT_BR + (size_t)i * 2 * MiB, 1024, SEQ, 1024, 64 * i);
                    auto E = pg8::epi_b16([&](int row, int col, f32x4 v0, f32x4 v1) {
                        u16* gp = GATES + (size_t)row * 3072 + i * 1024 + col; const u32x4 gq = *(const u32x4*)gp;
                        const f32x4 a = {bf2f(gq.x & 0xffffu), bf2f(gq.x >> 16), bf2f(gq.y & 0xffffu), bf2f(gq.y >> 16)};
                        const f32x4 c2 = {bf2f(gq.z & 0xffffu), bf2f(gq.z >> 16), bf2f(gq.w & 0xffffu), bf2f(gq.w >> 16)};
                        *(u32x4*)gp = pg8::pack8(a * v0, c2 * v1); });
                    pg8::gemm_phase(llds, 1024, lda, 1024, S, E, wid_s);
                }
                if (b + 1 < NB) {
                    pg8::Sched1 S; S.init(HB + (size_t)(b + 1) * SEQ * 1024, 1024, ws + WT_IN, 1024, SEQ, PP, 192);
                    auto E = pg8::epi_b16([&](int row, int col, f32x4 v0, f32x4 v1) { *(u32x4*)(PROJ + (size_t)row * PP + col) = pg8::pack8(v0, v1); });
                    pg8::gemm_phase(llds, 1024, 1024, 1024, S, E, wid_s);
                }
            PH_END
            if (b == NB - 1) {
            PH_BEGIN(7)
                h7_sum(GATES, MERGED + (size_t)b * SEQ * 1024, tid);
            PH_END
            }
        }
        PH_BEGIN(8)
            { pg8::Sched1 S; S.init(MERGED, 1024, ws + WT_OUT, 1024, T, 1024, 0);
              auto E = pg8::epi_b16([&](int row, int col, f32x4 v0, f32x4 v1) { *(u32x4*)((u16*)F32 + (size_t)row * 1024 + col) = pg8::pack8(v0, v1); });
              pg8::gemm_phase(llds, 1024, 1024, 1024, S, E, wid_s); }
        PH_END
        PH_BEGIN(9)
            {
                float* scr = (float*)(lds + wv * 16896);
                const int gw = blockIdx.x * 8 + wv, ngw = gridDim.x * 8;
                int it0 = 0;
                { const float* W = P_CWQ + (size_t)l * 1024 * 1024; u16* WT = (u16*)(ws + WT_CQ);
                  it0 = pg8::conv_matrix(W, 1024, 1024, 1024, [&](int n) { return n; }, [&](int n, int k) { return WT + (size_t)n * 1024 + k; }, scr, lane, gw, ngw, it0); }
                { const float* W = P_CWO + (size_t)l * 1024 * 1024; u16* WT = (u16*)(ws + WT_CO);
                  it0 = pg8::conv_matrix(W, 1024, 1024, 1024, [&](int n) { return n; }, [&](int n, int k) { return WT + (size_t)n * 1024 + k; }, scr, lane, gw, ngw, it0); }
                { const float* W = P_W1 + (size_t)l * 1024 * 4096; u16* WT = (u16*)(ws + WT_W1);
                  it0 = pg8::conv_matrix(W, 4096, 1024, 4096, [&](int n) { return n; }, [&](int n, int k) { return WT + (size_t)n * 1024 + k; }, scr, lane, gw, ngw, it0); }
                { const float* W = P_W2 + (size_t)l * 4096 * 1024; u16* WT = (u16*)(ws + WT_W2);
                  it0 = pg8::conv_matrix(W, 1024, 4096, 1024, [&](int n) { return n; }, [&](int n, int k) { return WT + (size_t)n * 4096 + k; }, scr, lane, gw, ngw, it0); }
            }
            ph_resid_norm(F32, GL + 1 * 1024, XIN, P_OUT, GL + 2 * 1024, HB, T, tid);
        PH_END
        PH_BEGIN(10)
            { pg8::Sched1 S; S.init(HB, 1024, ws + WT_CQ, 1024, T, 1024, 0);
              auto E = pg8::epi_b16([&](int row, int col, f32x4 v0, f32x4 v1) { *(u32x4*)(CQ + (size_t)row * 1024 + col) = pg8::pack8(v0, v1); });
              pg8::gemm_phase(llds, 1024, 1024, 1024, S, E, wid_s);
              asm volatile("s_waitcnt vmcnt(0)" ::: "memory");
              __syncthreads();
              pg8::Unit u0;
              for (int i = 0; S.next(i, u0); ++i) cross_unit(lds, wid_s, u0.pm >> 4, u0.pn, u0.pm & 15); }
        PH_END
        PH_BEGIN(12)
            { pg8::Sched1 S; S.init(CQ, 1024, ws + WT_CO, 1024, T, 1024, 0);
              auto E = pg8::epi_b16([&](int row, int col, f32x4 v0, f32x4 v1) { *(u32x4*)((u16*)F32 + (size_t)row * 1024 + col) = pg8::pack8(v0, v1); });
              pg8::gemm_phase(llds, 1024, 1024, 1024, S, E, wid_s); }
        PH_END
        PH_BEGIN(13)
            ph_resid_norm(F32, GL + 4 * 1024, P_OUT, P_OUT, GL + 5 * 1024, HB, T, tid);
        PH_END
        PH_BEGIN(14)
            { pg8::Sched1 S; S.init(HB, 1024, ws + WT_W1, 1024, T, 4096, 0);
              auto E = pg8::epi_b16([&](int row, int col, f32x4 v0, f32x4 v1) {
                  f32x4 a, c2;
#pragma unroll
                  for (int j = 0; j < 4; ++j) { const float r0 = fmaxf(v0[j], 0.f), r1 = fmaxf(v1[j], 0.f); a[j] = r0 * r0; c2[j] = r1 * r1; }
                  *(u32x4*)(U + (size_t)row * 4096 + col) = pg8::pack8(a, c2); });
              pg8::gemm_phase(llds, 1024, 1024, 1024, S, E, wid_s); }
        PH_END
        PH_BEGIN(15)
            { pg8::Sched1 S; S.init(U, 4096, ws + WT_W2, 4096, T, 1024, 0);
              auto E = pg8::epi_b16([&](int row, int col, f32x4 v0, f32x4 v1) { *(u32x4*)((u16*)F32 + (size_t)row * 1024 + col) = pg8::pack8(v0, v1); });
              pg8::gemm_phase(llds, 4096, 4096, 4096, S, E, wid_s); }
        PH_END
        PH_BEGIN(16)
            ph_resid_norm(F32, GL + 6 * 1024, P_OUT, P_OUT, (l + 1 < DEPTH) ? P_GAINS + (size_t)(l + 1) * 7 * 1024 : (const float*)nullptr, HB, T, tid);
        PH_END
    }
}

constexpr int NPHASES = DEPTH * (1 + 1 + NB * 5 + 1 + 8);

extern "C" void kernel_launch(void* const* d_in, const int* in_sizes, int n_in, void* d_out, int out_size, void* d_ws, size_t ws_size,
                              hipStream_t stream) {
    (void)in_sizes; (void)out_size;
    if (n_in != 20 || ws_size < WS_END) { fprintf(stderr, "kernel_launch: bad n_in %d or ws_size %zu < %zu\n", n_in, ws_size, (size_t)WS_END); return; }
    static int grid = 0;
    if (!grid) {
        hipError_t e = hipFuncSetAttribute((const void*)mega, hipFuncAttributeMaxDynamicSharedMemorySize, LDS_BYTES);
        if (e != hipSuccess) fprintf(stderr, "hipFuncSetAttribute: %s\n", hipGetErrorString(e));
        int dev = 0, cus = 0, per_cu = 0;
        (void)hipGetDevice(&dev);
        (void)hipDeviceGetAttribute(&cus, hipDeviceAttributeMultiprocessorCount, dev);
        (void)hipOccupancyMaxActiveBlocksPerMultiprocessor(&per_cu, mega, 512, LDS_BYTES);
        if (cus <= 0) cus = 256;
        if (per_cu < 1) { fprintf(stderr, "occupancy query says %d blocks per CU\n", per_cu); per_cu = 1; }
        grid = cus;
    }
    (void)hipMemsetAsync((unsigned char*)d_ws + WS_CTL, 0, CTL_BYTES, stream);
    Params p; memset(&p, 0, sizeof(p));
    p.x = (const float*)d_in[0]; p.mem = (const float*)d_in[1]; p.pos = (const int*)d_in[2]; p.rel_bias = (const float*)d_in[3];
    p.gains = (const float*)d_in[4]; p.w_in = (const float*)d_in[5]; p.qnorm = (const float*)d_in[6]; p.kvnorm = (const float*)d_in[7];
    p.w_uq = (const float*)d_in[8]; p.w_ukv = (const float*)d_in[9]; p.cmp_pos = (const float*)d_in[10]; p.cmp_w1 = (const float*)d_in[11];
    p.cmp_w2 = (const float*)d_in[12]; p.w_branch = (const float*)d_in[13]; p.w_out = (const float*)d_in[14]; p.cwq = (const float*)d_in[15];
    p.cwkv = (const float*)d_in[16]; p.cwo = (const float*)d_in[17]; p.w1 = (const float*)d_in[18]; p.w2 = (const float*)d_in[19];
    p.out = (float*)d_out; p.ws = (unsigned char*)d_ws;
#if MK_MULTI_LAUNCH
    for (int ph = 0; ph < NPHASES; ++ph) { p.ph_lo = ph; p.ph_hi = ph + 1; hipLaunchKernelGGL(mega, dim3(grid), dim3(512), LDS_BYTES, stream, p); }
#else
    p.ph_lo = 0; p.ph_hi = NPHASES;
    hipLaunchKernelGGL(mega, dim3(grid), dim3(512), LDS_BYTES, stream, p);
#endif
}
```
